# Optimizing an MI355X kernel written in HIP

```python
import jax, jax.numpy as jnp
from jax import lax
import numpy as np

D_MODEL = 1024
BATCH = 2
SEQ = 8192
DEPTH = 2

CHUNK = 128
A_GROUPS = 8
A_WIDTH = 512
A_HEAD = A_WIDTH // A_GROUPS
B_WIDTH = 512
CONV_WIDTH = 3
C_WIDTH = 512
POOL_WINDOWS = (2, 4, 8, 16)
C_GROUP = C_WIDTH // len(POOL_WINDOWS)
IN_TOTAL = 3 * A_WIDTH + 4 * B_WIDTH + 2 * C_WIDTH + 3 * D_MODEL
RMS_EPS = 1e-6
LN_EPS = 1e-5

kernel_name = "hybrid_gmlp_shortconv_pool_gated_merge"


def _rmsnorm(x, g):
    xf = x.astype(jnp.float32)
    y = xf * lax.rsqrt(jnp.mean(xf * xf, axis=-1, keepdims=True) + RMS_EPS)
    return (y * g.astype(jnp.float32)).astype(x.dtype)


def _layernorm(x, g, b):
    xf = x.astype(jnp.float32)
    mu = jnp.mean(xf, axis=-1, keepdims=True)
    xc = xf - mu
    var = jnp.mean(xc * xc, axis=-1, keepdims=True)
    y = xc * lax.rsqrt(var + LN_EPS)
    return (y * g.astype(jnp.float32) + b.astype(jnp.float32)).astype(x.dtype)


def _split_points():
    widths = [A_WIDTH] * 3 + [B_WIDTH] * 4 + [C_WIDTH] * 2 + [D_MODEL] * 3
    return [int(s) for s in np.cumsum(widths)[:-1]]


def _gmlp_branch(u, v, ln_g, ln_b, w_s, b_s):
    u = jax.nn.gelu(u)
    v = _layernorm(jax.nn.gelu(v), ln_g, ln_b)
    bsz, s, _ = v.shape
    vc = v.reshape(bsz, s // CHUNK, CHUNK, A_GROUPS, A_HEAD)
    causal = jnp.tril(jnp.ones((CHUNK, CHUNK), dtype=bool))
    w_m = jnp.where(causal, w_s, 0.0)
    sg = jnp.einsum('gts,bnsgc->bntgc', w_m, vc) + b_s.T[:, :, None]
    return u * sg.reshape(bsz, s, A_WIDTH)


def _shortconv_branch(xb, bg, cg, conv_w, conv_b):
    y = cg * xb
    y = lax.conv_general_dilated(
        y, conv_w[:, None, :].astype(y.dtype), window_strides=(1,),
        padding=[(CONV_WIDTH - 1, 0)], dimension_numbers=('NWC', 'WIO', 'NWC'),
        feature_group_count=B_WIDTH) + conv_b
    return bg * y


def _pool_branch(xc, w_pool, pool_scale):
    bsz, s, _ = xc.shape
    xf = xc.astype(jnp.float32).reshape(bsz, s, len(POOL_WINDOWS), C_GROUP)
    cs = jnp.cumsum(xf, axis=1)
    t_count = jnp.arange(1, s + 1, dtype=jnp.float32)
    pooled = []
    for gi, w in enumerate(POOL_WINDOWS):
        c = cs[:, :, gi]
        lag = jnp.pad(c[:, :s - w], ((0, 0), (w, 0), (0, 0)))
        cnt = jnp.minimum(t_count, float(w))[None, :, None]
        pooled.append((c - lag) / cnt)
    pooled = (jnp.stack(pooled, axis=2) - xf).astype(xc.dtype)
    y = jnp.einsum('bsgc,gcd->bsgd', pooled, w_pool).reshape(bsz, s, C_WIDTH)
    return y * pool_scale


def _hybrid_layer(x, norm_g, w_in, ln_g, ln_b, w_s, b_s, conv_w, conv_b,
                  w_pool, pool_scale, w_pa, w_pb, w_pc, w_o):
    h = _rmsnorm(x, norm_g)
    p = h @ w_in
    (u, v, z_a, x_b, b_g, c_g, z_b, x_c, z_c,
     g_a, g_b, g_c) = jnp.split(p, _split_points(), axis=-1)
    y_a = (_gmlp_branch(u, v, ln_g, ln_b, w_s, b_s) * jax.nn.silu(z_a)) @ w_pa
    y_b = (_shortconv_branch(x_b, b_g, c_g, conv_w, conv_b) * jax.nn.silu(z_b)) @ w_pb
    y_c = (_pool_branch(x_c, w_pool, pool_scale) * jax.nn.silu(z_c)) @ w_pc
    merged = (jax.nn.sigmoid(g_a) * y_a + jax.nn.sigmoid(g_b) * y_b
              + jax.nn.sigmoid(g_c) * y_c)
    return x + merged @ w_o


def setup_inputs(seed: int = 0) -> dict:
    key = jax.random.key(seed)
    ks = jax.random.split(key, 20)
    f32 = jnp.float32
    n = lambda k, shape: jax.random.normal(k, shape, dtype=f32)
    return {
        "x": n(ks[0], (BATCH, SEQ, D_MODEL)),
        "norm_g": 1.0 + 0.02 * n(ks[1], (DEPTH, D_MODEL)),
        "w_in": n(ks[2], (DEPTH, D_MODEL, IN_TOTAL)) * D_MODEL ** -0.5,
        "ln_g": 1.0 + 0.02 * n(ks[3], (DEPTH, A_WIDTH)),
        "ln_b": 0.02 * n(ks[4], (DEPTH, A_WIDTH)),
        "w_s": n(ks[5], (DEPTH, A_GROUPS, CHUNK, CHUNK)) * CHUNK ** -0.5,
        "b_s": 1.0 + 0.1 * n(ks[6], (DEPTH, A_GROUPS, CHUNK)),
        "conv_w": n(ks[7], (DEPTH, CONV_WIDTH, B_WIDTH)) * CONV_WIDTH ** -0.5,
        "conv_b": 0.02 * n(ks[8], (DEPTH, B_WIDTH)),
        "w_pool": n(ks[9], (DEPTH, len(POOL_WINDOWS), C_GROUP, C_GROUP)) * C_GROUP ** -0.5,
        "pool_scale": 1.0 + 0.02 * n(ks[10], (DEPTH, C_WIDTH)),
        "w_pa": n(ks[11], (DEPTH, A_WIDTH, D_MODEL)) * A_WIDTH ** -0.5,
        "w_pb": n(ks[12], (DEPTH, B_WIDTH, D_MODEL)) * B_WIDTH ** -0.5,
        "w_pc": n(ks[13], (DEPTH, C_WIDTH, D_MODEL)) * C_WIDTH ** -0.5,
        "w_o": n(ks[14], (DEPTH, D_MODEL, D_MODEL)) * D_MODEL ** -0.5,
        "final_g": 1.0 + 0.02 * n(ks[15], (D_MODEL,)),
    }


def reference(x, norm_g, w_in, ln_g, ln_b, w_s, b_s, conv_w, conv_b, w_pool,
              pool_scale, w_pa, w_pb, w_pc, w_o, final_g):
    for l in range(DEPTH):
        x = _hybrid_layer(x, norm_g[l], w_in[l], ln_g[l], ln_b[l], w_s[l], b_s[l],
                          conv_w[l], conv_b[l], w_pool[l], pool_scale[l],
                          w_pa[l], w_pb[l], w_pc[l], w_o[l])
    return _rmsnorm(x, final_g)
```

```cpp
#include <hip/hip_runtime.h>
#include <cstdio>
#include <cstdint>


#define P1_WGM 2
#define GAS __attribute__((address_space(1)))
#define LAS __attribute__((address_space(3)))
typedef unsigned short bf16_t;
typedef short bf16x8 __attribute__((ext_vector_type(8)));
typedef float f32x4 __attribute__((ext_vector_type(4)));
typedef float f32x2 __attribute__((ext_vector_type(2)));
typedef unsigned u32x4 __attribute__((ext_vector_type(4)));
typedef unsigned u32x2 __attribute__((ext_vector_type(2)));

constexpr int SEQ = 8192, D = 1024, M = 2 * SEQ, DEPTH = 2;
constexpr int IN_TOTAL = 7680;
constexpr int NMIX = 4608;
constexpr int PITCH = NMIX + D;
constexpr int XB_COL = NMIX;
constexpr int C_U = 0, C_ZB = 512, C_ZC = 1024, C_V = 1536, C_ZA = 2048, C_XB = 2560, C_BG = 3072, C_CG = 3584, C_XC = 4096;
constexpr int C_S = 1536, C_MERGED = 1536;
constexpr int K3 = 1536;
constexpr float RMS_EPS = 1e-6f, LN_EPS = 1e-5f;

constexpr size_t MiB = 1u << 20;
constexpr size_t WS_CTL = 0, CTL_ZERO_BYTES = 192 * 1024;
constexpr int CW_PANEL = 40960;
constexpr size_t WS_RSS = 1 * MiB;
constexpr size_t WS_LNS = 4 * MiB;
constexpr size_t WS_WMIX = 5 * MiB;
constexpr size_t WS_W3 = 23 * MiB;
constexpr size_t WS_WO = 29 * MiB;
constexpr size_t WS_WM = 33 * MiB;
constexpr size_t WS_WPOOL = WS_WM + 512 * 1024;
constexpr size_t WS_P = 34 * MiB;
constexpr size_t WS_XB8 = WS_P + (size_t)M * PITCH * 2;
constexpr size_t WS_WG8 = WS_XB8 + (size_t)M * D;
constexpr float WG8_SCALE = 64.0f;
constexpr size_t GATE_GROUP_BYTES = 8 * MiB, GATE_PLANE_BYTES = 2 * MiB;
constexpr size_t WS_END = WS_WG8 + (size_t)DEPTH * 3 * D * D;
static_assert(WS_END <= 256 * MiB, "workspace map");

constexpr int NWAVES = 8;
constexpr int RING_BYTES = 131072;
constexpr int WAVE_LDS = 17920;
constexpr int LDSCTL_OFF = 143360, MISC_OFF = LDSCTL_OFF + 320;
constexpr int LDS_BYTES = 147456;

#define RLX_AGENT __ATOMIC_RELAXED, __HIP_MEMORY_SCOPE_AGENT
#define LDS_WAIT() asm volatile("s_waitcnt lgkmcnt(0)" ::: "memory")
#define VM_WAIT() asm volatile("s_waitcnt vmcnt(0)" ::: "memory")

__device__ __forceinline__ unsigned cvt_pk_bf16(float lo, float hi) { unsigned r; asm volatile("v_cvt_pk_bf16_f32 %0, %1, %2" : "=v"(r) : "v"(lo), "v"(hi)); return r; }
__device__ __forceinline__ unsigned pk4_fp8(float a, float b, float c, float d) { int w = 0; w = __builtin_amdgcn_cvt_pk_fp8_f32(a, b, w, false); w = __builtin_amdgcn_cvt_pk_fp8_f32(c, d, w, true); return (unsigned)w; }
__device__ __forceinline__ float bf_lo(unsigned w) { return __builtin_bit_cast(float, w << 16); }
__device__ __forceinline__ float bf_hi(unsigned w) { return __builtin_bit_cast(float, w & 0xffff0000u); }
__device__ __forceinline__ float sigmoid_f(float x) { return __builtin_amdgcn_rcpf(1.0f + __builtin_amdgcn_exp2f(-1.4426950409f * x)); }
__device__ __forceinline__ float silu_f(float x) { return x * sigmoid_f(x); }
__device__ __forceinline__ f32x2 bf2(unsigned w) { return (f32x2){bf_lo(w), bf_hi(w)}; }
__device__ __forceinline__ f32x2 rcp2(f32x2 d) { return (f32x2){__builtin_amdgcn_rcpf(d.x), __builtin_amdgcn_rcpf(d.y)}; }
__device__ __forceinline__ f32x2 exp2_2(f32x2 t) { return (f32x2){__builtin_amdgcn_exp2f(t.x), __builtin_amdgcn_exp2f(t.y)}; }
__device__ __forceinline__ f32x2 silu2(f32x2 x) { return x * rcp2(exp2_2(x * -1.4426950409f) + 1.0f); }
__device__ __forceinline__ f32x2 gelu2(f32x2 x) { const f32x2 t = x * x * (-2.3022081981f * 0.044715f) + (-2.3022081981f); return x * rcp2(exp2_2(x * t) + 1.0f); }
__device__ __forceinline__ float gelu_tanh_f(float x) { return x * __builtin_amdgcn_rcpf(1.0f + __builtin_amdgcn_exp2f(x * __builtin_fmaf(x * x, -2.3022081981f * 0.044715f, -2.3022081981f))); }

namespace pg8 {
constexpr int BM = 256, BK = 64, HALF = 128, HTB = HALF * BK * 2, STAGE_BYTES = 8 * HTB, NXCD = 8, WGM = 8;
__host__ __device__ __forceinline__ int lds_byte(int r, int c) { const int st = (r >> 4) * 2 + (c >> 5), rr = r & 15, cc = c & 31, ob = rr * 64 + cc * 2; return st * 1024 + (ob ^ (((ob >> 9) & 1) << 5)); }
__host__ __device__ __forceinline__ void stage_rc(int b, int& R, int& C) { const int st = b / 1024, sb = b % 1024, swz = sb ^ (((sb >> 9) & 1) << 5); R = (st >> 1) * 16 + swz / 64; C = (st & 1) * 32 + (swz % 64) / 2; }
__host__ __device__ __forceinline__ int perm32(int rho) { const int n = rho >> 4, i = rho & 15; return 8 * (i >> 2) + 4 * n + (i & 3); }

struct Unit { const char* A; const char* B; int nt; int kind; int pm, pn; };

struct TileOrder {
    int nM, nN, nwg, G, c, wgm;
    __device__ void init(int M_, int N_, int G_, int c_, int wgm_ = WGM) { nM = M_ / BM; nN = N_ / BM; nwg = nM * nN; G = G_; c = c_; wgm = wgm_; }
    __device__ bool tile(int i, int& pm, int& pn) const {
        const long L = (long)i * G + c; if (L >= nwg) return false;
        int wgid = (int)L; { const int q = nwg / NXCD, r = nwg % NXCD, xcd = wgid % NXCD, off = wgid / NXCD; wgid = (xcd < r ? xcd * (q + 1) : r * (q + 1) + (xcd - r) * q) + off; }
        const int nig = wgm * nN, gid = wgid / nig, fm = gid * wgm, gsz = (nM - fm) < wgm ? (nM - fm) : wgm;
        pm = fm + ((wgid % nig) % gsz); pn = (wgid % nig) / gsz; return true;
    }
};

typedef int i32x4 __attribute__((ext_vector_type(4)));
typedef int i32x8 __attribute__((ext_vector_type(8)));
__device__ __forceinline__ i32x8 cat16(bf16x8 lo, bf16x8 hi) { const i32x4 a = __builtin_bit_cast(i32x4, lo), b = __builtin_bit_cast(i32x4, hi); return __builtin_shufflevector(a, b, 0, 1, 2, 3, 4, 5, 6, 7); }
template <class Epi, class Sched, bool ALIGN_EPI, bool FP8 = false>
__device__ __forceinline__ void gemm_phase(LAS unsigned char* lds, const unsigned lda2, const unsigned ldb2, const Sched& S, const Epi& E) {
    int tid = threadIdx.x; asm volatile("" : "+v"(tid));
    const int wid = __builtin_amdgcn_readfirstlane(tid >> 6), lane = tid & 63, wr = wid >> 2, wc = wid & 3, fr = lane & 15, fq = lane >> 4;
    unsigned voffA[2], voffB[2];
#pragma unroll
    for (int i = 0; i < 2; ++i) { int R, C; stage_rc(tid * 16 + i * 8192, R, C); const int Rb = (R & ~31) + perm32(R & 31);
        voffA[i] = (unsigned)R * lda2 + (unsigned)C * 2u; voffB[i] = (unsigned)Rb * ldb2 + (unsigned)C * 2u; }
    const size_t kstep = (size_t)(BK * 2);
    const size_t hA = (size_t)HALF * lda2, hB = (size_t)HALF * ldb2;
    const unsigned ldsw = (unsigned)wid * 1024u;
    const int aoff = lds_byte(wr * 64 + fr, fq * 8), boff = lds_byte(wc * 32 + fr, fq * 8);
#define PG8_SA(b, h) (((b) * 2 + (h)) * HTB)
#define PG8_SB(b, h) ((4 + (b) * 2 + (h)) * HTB)
#define PG8_STAGE(bufoff, gbase, voff) do { _Pragma("unroll") for (int _i = 0; _i < 2; ++_i) \
        __builtin_amdgcn_global_load_lds((const unsigned*)((const char*)(gbase) + (voff)[_i]), (LAS unsigned*)(lds + (bufoff) + ldsw + _i * 8192), 16, 0, 0); } while (0)
#define PG8_LDA(dst, b, h) do { _Pragma("unroll") for (int m = 0; m < 4; ++m) { if constexpr (FP8) dst##8[m] = cat16(*(const LAS bf16x8*)(lds + PG8_SA(b, h) + aoff + m * 2048), *(const LAS bf16x8*)(lds + PG8_SA(b, h) + aoff + m * 2048 + 1024)); \
        else { _Pragma("unroll") for (int k = 0; k < 2; ++k) dst[m][k] = *(const LAS bf16x8*)(lds + PG8_SA(b, h) + aoff + m * 2048 + k * 1024); } } } while (0)
#define PG8_LDB(dst, b, h) do { _Pragma("unroll") for (int n = 0; n < 2; ++n) { if constexpr (FP8) dst##8[n] = cat16(*(const LAS bf16x8*)(lds + PG8_SB(b, h) + boff + n * 2048), *(const LAS bf16x8*)(lds + PG8_SB(b, h) + boff + n * 2048 + 1024)); \
        else { _Pragma("unroll") for (int k = 0; k < 2; ++k) dst[n][k] = *(const LAS bf16x8*)(lds + PG8_SB(b, h) + boff + n * 2048 + k * 1024); } } } while (0)
#define PG8_MMA(ai, bj, At, Bt) do { __builtin_amdgcn_s_setprio(1); \
        if constexpr (FP8) { _Pragma("unroll") for (int m = 0; m < 4; ++m) _Pragma("unroll") for (int n = 0; n < 2; ++n) \
            asm volatile("v_mfma_scale_f32_16x16x128_f8f6f4 %0, %1, %2, %0, %3, %3 op_sel_hi:[0,0,0]" : "+v"(acc[ai][bj][m][n]) : "v"(Bt##8[n]), "v"(At##8[m]), "v"(sc8)); \
            asm volatile("s_nop 15\n\ts_nop 7" ::: "memory"); }   \
        else { _Pragma("unroll") for (int m = 0; m < 4; ++m) _Pragma("unroll") for (int n = 0; n < 2; ++n) _Pragma("unroll") for (int k = 0; k < 2; ++k) \
            acc[ai][bj][m][n] = __builtin_amdgcn_mfma_f32_16x16x32_bf16(Bt[n][k], At[m][k], acc[ai][bj][m][n], 0, 0, 0); } \
        __builtin_amdgcn_s_setprio(0); } while (0)
#define PG8_WAIT_V(n) asm volatile("s_waitcnt vmcnt(" #n ")" ::: "memory")
#define PG8_WAIT_L(n) asm volatile("s_waitcnt lgkmcnt(" #n ")" ::: "memory")
#define PG8_BAR __builtin_amdgcn_s_barrier()
#define PG8_SCHED __builtin_amdgcn_sched_barrier(0)
    Unit cur, nxt; int ui = 0;
    if (!S.next(0, cur)) return;
    f32x4 acc[2][2][4][2];
#pragma unroll
    for (int a = 0; a < 2; ++a)
#pragma unroll
        for (int b = 0; b < 2; ++b)
#pragma unroll
            for (int m = 0; m < 4; ++m)
#pragma unroll
                for (int n = 0; n < 2; ++n) acc[a][b][m][n] = (f32x4){0.f, 0.f, 0.f, 0.f};
    bf16x8 At[4][2], B0[2][2], B1[2][2]; i32x8 At8[4], B08[2], B18[2];
    int sc8 = 0x7f7f7f7f; asm volatile("" : "+v"(sc8));
    const char* cA = cur.A; const char* cB = cur.B;
    PG8_STAGE(PG8_SB(0, 0), cB, voffB); PG8_STAGE(PG8_SB(0, 1), cB + hB, voffB); PG8_STAGE(PG8_SA(0, 0), cA, voffA); PG8_STAGE(PG8_SA(0, 1), cA + hA, voffA);
    if (wr == 1) PG8_BAR;
    PG8_WAIT_V(2); PG8_BAR;
    PG8_STAGE(PG8_SB(1, 0), cB + kstep, voffB); PG8_STAGE(PG8_SA(1, 0), cA + kstep, voffA); PG8_STAGE(PG8_SB(1, 1), cB + hB + kstep, voffB);
    PG8_WAIT_V(6); PG8_BAR;
    for (;;) {
        const bool has_next = S.next(ui + 1, nxt);
        const char* nA = has_next ? nxt.A : cA; const char* nB = has_next ? nxt.B : cB;
        const int nt = cur.nt;
#pragma unroll 1
        for (int t = 0; t < nt; t += 2) {
            const bool last = (t == nt - 2);
            const char* a1 = cA + (size_t)(t + 1) * kstep;
            const char* a2 = last ? nA : cA + (size_t)(t + 2) * kstep; const char* b2 = last ? nB : cB + (size_t)(t + 2) * kstep;
            const char* a3 = a2 + kstep; const char* b3 = b2 + kstep;
            PG8_LDB(B0, 0, 0); PG8_LDB(B1, 0, 1); PG8_SCHED; PG8_LDA(At, 0, 0); PG8_STAGE(PG8_SA(1, 1), a1 + hA, voffA);
            PG8_WAIT_V(8); PG8_WAIT_L(0); PG8_BAR; PG8_MMA(0, 0, At, B0); PG8_MMA(0, 1, At, B1); PG8_BAR; PG8_SCHED;
            PG8_LDA(At, 0, 1); PG8_STAGE(PG8_SB(0, 0), b2, voffB); PG8_STAGE(PG8_SB(0, 1), b2 + hB, voffB); PG8_STAGE(PG8_SA(0, 0), a2, voffA);
            PG8_WAIT_V(8); PG8_WAIT_L(0); PG8_BAR; PG8_MMA(1, 0, At, B0); PG8_MMA(1, 1, At, B1); PG8_BAR; PG8_SCHED;
            PG8_LDB(B0, 1, 0); PG8_LDB(B1, 1, 1); PG8_SCHED; PG8_LDA(At, 1, 0); PG8_STAGE(PG8_SA(0, 1), a2 + hA, voffA);
            PG8_WAIT_V(8); PG8_WAIT_L(0); PG8_BAR; PG8_MMA(0, 0, At, B0); PG8_MMA(0, 1, At, B1); PG8_BAR; PG8_SCHED;
            PG8_LDA(At, 1, 1); PG8_STAGE(PG8_SB(1, 0), b3, voffB); PG8_STAGE(PG8_SB(1, 1), b3 + hB, voffB); PG8_STAGE(PG8_SA(1, 0), a3, voffA);
            PG8_WAIT_V(8); PG8_WAIT_L(0); PG8_BAR; PG8_MMA(1, 0, At, B0); PG8_MMA(1, 1, At, B1); PG8_BAR; PG8_SCHED;
        }
        if constexpr (ALIGN_EPI) { if (wr == 0) PG8_BAR; }
        E(acc, cur, wr, wc, fr, fq);
        if (!has_next) break;
        cur = nxt; cA = nA; cB = nB; ++ui;
        if constexpr (ALIGN_EPI) { if (wr == 1) PG8_BAR; }
    }
    PG8_WAIT_V(0);
    if constexpr (!ALIGN_EPI) { if (wr == 0) PG8_BAR; }
    PG8_BAR;
#undef PG8_SA
#undef PG8_SB
#undef PG8_STAGE
#undef PG8_LDA
#undef PG8_LDB
#undef PG8_MMA
#undef PG8_WAIT_V
#undef PG8_WAIT_L
#undef PG8_BAR
#undef PG8_SCHED
}
}

#define XB_TMO      128
#define XB_XCNT(j)  (256  + 64 * (j))
#define XB_XSUB(j)  (1280 + 64 * (j))
#define XB_XGEN(j)  (2304 + 64 * (j))
#define XB_TOP      3328
#define XB_TOPGEN   3392
#define XCD_BAR_WORDS 3456
#define XB_SPIN_CAP (1u << 18)
__device__ __forceinline__ unsigned xb_ld(unsigned* p)              { return __hip_atomic_load(p, __ATOMIC_RELAXED, __HIP_MEMORY_SCOPE_AGENT); }
__device__ __forceinline__ unsigned xb_add(unsigned* p, unsigned v) { return __hip_atomic_fetch_add(p, v, __ATOMIC_RELAXED, __HIP_MEMORY_SCOPE_AGENT); }
__device__ __forceinline__ unsigned xb_xcc_id() { return (unsigned)__builtin_amdgcn_s_getreg((3 << 11) | 20) & 0xFu; }
#define XB_SPIN(cond, bar) do { unsigned _sp = 0; while (cond) { __builtin_amdgcn_s_sleep(1); \
    if ((++_sp & 255u) == 0u) { if (xb_ld(&(bar)[XB_TMO])) break; if (_sp > XB_SPIN_CAP) { atomicAdd(&(bar)[XB_TMO], 1u); break; } } } } while (0)
struct XcdBarrier { unsigned* bar; unsigned x; volatile LAS unsigned* st; unsigned G; };
__device__ __forceinline__ XcdBarrier xcd_barrier_post(unsigned* bar, volatile LAS unsigned* st, unsigned G) {
    XcdBarrier b; b.bar = bar; b.x = xb_xcc_id(); b.st = st; b.G = G;
    if (threadIdx.x == 0) (void)xb_add(&bar[XB_XCNT(b.x)], 1u);
    return b;
}
__device__ __forceinline__ void xcd_barrier_complete(unsigned* bar, unsigned x, unsigned G, unsigned& nloc, unsigned& nx) {
    unsigned sum, cnt, mine, sp = 0u;
    for (;;) {
        sum = 0u; cnt = 0u; mine = 0u;
#pragma unroll
        for (unsigned j = 0; j < 16; ++j) { const unsigned c = xb_ld(&bar[XB_XCNT(j)]); sum += c; cnt += (c > 0u) ? 1u : 0u; mine = (j == x) ? c : mine; }
        if (sum == G) break;
        __builtin_amdgcn_s_sleep(1);
        if ((++sp & 255u) == 0u) { if (xb_ld(&bar[XB_TMO])) break; if (sp > XB_SPIN_CAP) { atomicAdd(&bar[XB_TMO], 1u); break; } }
    }
    nloc = mine > 0u ? mine : 1u; nx = cnt > 0u ? cnt : 1u;
}
__device__ __forceinline__ void xcd_barrier(const XcdBarrier& b, unsigned* wait_word = nullptr, unsigned wait_target = 0u, unsigned* prog_word = nullptr, bool local_ok = false) {
    asm volatile("s_waitcnt vmcnt(0)" ::: "memory");
    __syncthreads();
    if (threadIdx.x == 0) {
        unsigned* bar = b.bar;
        __builtin_amdgcn_s_waitcnt(0);
        asm volatile("buffer_inv sc1" ::: "memory");
        unsigned nloc = b.st[0], nx = b.st[1];
        if (nloc == 0u) { xcd_barrier_complete(bar, b.x, b.G, nloc, nx); b.st[0] = nloc; b.st[1] = nx; }
        const unsigned old = xb_add(&bar[XB_XSUB(b.x)], 1u);
        const unsigned gen = old / nloc;
        if (old + 1u == (gen + 1u) * nloc) {
            if (!(local_ok && nx == 1u)) { __builtin_amdgcn_fence(__ATOMIC_RELEASE, "agent"); asm volatile("s_waitcnt vmcnt(0)" ::: "memory"); }
            (void)xb_add(&bar[XB_TOP], 1u);
        }
        const unsigned tgt = (gen + 1u) * nx;
        if (wait_word) XB_SPIN(xb_ld(wait_word) < wait_target, bar);
        XB_SPIN(xb_ld(&bar[XB_TOP]) < tgt, bar);
        if (prog_word) (void)xb_add(prog_word, 1u);
        asm volatile("s_waitcnt vmcnt(0)" ::: "memory");
    }
    __syncthreads();
}

struct Args { const float* in[16]; float* out; unsigned char* ws; int ph_lo, ph_hi; };

__device__ __forceinline__ float wave_sum(float v) {
#pragma unroll
    for (int o = 1; o < 64; o <<= 1) v += __shfl_xor(v, o);
    return v;
}

__device__ __forceinline__ void p0_transpose_item(const float* W, int ldw, int k0, int n0, const float* gs, bf16_t* dst, int ldd, LAS float* scr, int lane) {
    float v[32];
    const float* wp = W + (size_t)(k0 + (lane >> 5)) * ldw + n0 + (lane & 31);
#pragma unroll
    for (int i = 0; i < 32; ++i) v[i] = wp[(size_t)(2 * i) * ldw];
    if (gs) {
#pragma unroll
        for (int i = 0; i < 32; ++i) v[i] *= gs[k0 + 2 * i + (lane >> 5)]; }
#pragma unroll
    for (int i = 0; i < 32; ++i) scr[(2 * i + (lane >> 5)) * 33 + (lane & 31)] = v[i];
    LDS_WAIT(); asm volatile("" ::: "memory");
    const int c = lane & 7;
#pragma unroll
    for (int j = 0; j < 4; ++j) { const int n = (lane >> 3) + 8 * j; const LAS float* s = scr + (8 * c) * 33 + n;
        u32x4 o; o.x = cvt_pk_bf16(s[0 * 33], s[1 * 33]); o.y = cvt_pk_bf16(s[2 * 33], s[3 * 33]); o.z = cvt_pk_bf16(s[4 * 33], s[5 * 33]); o.w = cvt_pk_bf16(s[6 * 33], s[7 * 33]);
        *(u32x4*)(dst + (size_t)n * ldd + 8 * c) = o; }
    LDS_WAIT(); asm volatile("" ::: "memory");
}

__device__ __forceinline__ void p0_transpose_item_fp8(const float* W, int ldw, int k0, int n0, const float* gs, float sc, unsigned char* dst, int ldd, LAS float* scr, int lane) {
    float v[32];
    const float* wp = W + (size_t)(k0 + (lane >> 5)) * ldw + n0 + (lane & 31);
#pragma unroll
    for (int i = 0; i < 32; ++i) v[i] = wp[(size_t)(2 * i) * ldw];
#pragma unroll
    for (int i = 0; i < 32; ++i) v[i] *= gs[k0 + 2 * i + (lane >> 5)] * sc;
#pragma unroll
    for (int i = 0; i < 32; ++i) scr[(2 * i + (lane >> 5)) * 33 + (lane & 31)] = v[i];
    LDS_WAIT(); asm volatile("" ::: "memory");
    const int n = lane >> 1, h = lane & 1; const LAS float* s = scr + (32 * h) * 33 + n;
    u32x4 o0, o1;
#pragma unroll
    for (int q = 0; q < 4; ++q) { o0[q] = pk4_fp8(s[(4 * q) * 33], s[(4 * q + 1) * 33], s[(4 * q + 2) * 33], s[(4 * q + 3) * 33]);
                                  o1[q] = pk4_fp8(s[(16 + 4 * q) * 33], s[(17 + 4 * q) * 33], s[(18 + 4 * q) * 33], s[(19 + 4 * q) * 33]); }
    unsigned char* d = dst + (size_t)n * ldd + 32 * h;
    *(u32x4*)d = o0; *(u32x4*)(d + 16) = o1;
    LDS_WAIT(); asm volatile("" ::: "memory");
}

__device__ __forceinline__ void p0_prologue(const Args& a, LAS unsigned char* lds, int gw, int NGW, int wave, int lane) {
    unsigned char* ws = a.ws;
    LAS float* scr = (LAS float*)(lds + wave * WAVE_LDS);
    constexpr int I_IN = (D / 64) * (IN_TOTAL / 32);
    constexpr int I_P = (512 / 64) * (D / 32);
    constexpr int I_O = (D / 64) * (D / 32);
    constexpr int I_LAYER = I_IN + 3 * I_P + I_O;
    for (int it = gw; it < DEPTH * I_LAYER; it += NGW) {
        const int l = it / I_LAYER; int r = it % I_LAYER;
        bf16_t* Wmix = (bf16_t*)(ws + WS_WMIX) + (size_t)l * NMIX * D;
        bf16_t* W3 = (bf16_t*)(ws + WS_W3) + (size_t)l * D * K3;
        bf16_t* WoT = (bf16_t*)(ws + WS_WO) + (size_t)l * D * D;
        if (r < I_IN) {
            const int kb = r / (IN_TOTAL / 32), nb = r % (IN_TOTAL / 32), k0 = 64 * kb, n0 = 32 * nb, seg = n0 / 512;
            const float* W = a.in[2] + (size_t)l * D * IN_TOTAL; const float* gs = a.in[1] + l * D;
            if (seg < 9) { const int dseg = (seg == 0) ? 0 : (seg == 1) ? 3 : (seg == 2) ? 4 : (seg == 3) ? 5 : (seg == 4) ? 6 : (seg == 5) ? 7 : (seg == 6) ? 1 : (seg == 7) ? 8 : 2;
                p0_transpose_item(W, IN_TOTAL, k0, n0, gs, Wmix + (size_t)(dseg * 512 + (n0 & 511)) * D + k0, D, scr, lane); }
            else { const int nn = n0 - NMIX;
                p0_transpose_item_fp8(W, IN_TOTAL, k0, n0, gs, WG8_SCALE, ws + WS_WG8 + (size_t)l * 3 * D * D + (size_t)nn * D + k0, D, scr, lane); }
            continue; }
        r -= I_IN;
        if (r < 3 * I_P) { const int br = r / I_P, q = r % I_P, kb = q / (D / 32), nb = q % (D / 32), k0 = 64 * kb, n0 = 32 * nb;
            const float* W = a.in[11 + br] + (size_t)l * 512 * D;
            p0_transpose_item(W, D, k0, n0, nullptr, W3 + (size_t)n0 * K3 + br * 512 + k0, K3, scr, lane); continue; }
        r -= 3 * I_P;
        { const int kb = r / (D / 32), nb = r % (D / 32), k0 = 64 * kb, n0 = 32 * nb;
          const float* W = a.in[14] + (size_t)l * D * D;
          p0_transpose_item(W, D, k0, n0, nullptr, WoT + (size_t)n0 * D + k0, D, scr, lane); }
    }
    { bf16_t* Wm = (bf16_t*)(ws + WS_WM); const float* w_s = a.in[5];
      for (int i = gw * 64 + lane; i < DEPTH * 8 * 128 * 128 / 2; i += NGW * 64) { const int e = 2 * i, s = e & 127, t = (e >> 7) & 127;
          const f32x2 v = *(const f32x2*)(w_s + e); ((unsigned*)Wm)[i] = cvt_pk_bf16(s <= t ? v.x : 0.f, s + 1 <= t ? v.y : 0.f); } }
    { bf16_t* Wp = (bf16_t*)(ws + WS_WPOOL); const float* w_pool = a.in[9]; const float* ps = a.in[10];
      for (int i = gw * 64 + lane; i < DEPTH * 4 * 128 * 128 / 2; i += NGW * 64) { const int e = 2 * i, c = e & 127, d = (e >> 7) & 127, lg = e >> 14;
          const float sc = ps[lg * 128 + d];
          ((unsigned*)Wp)[i] = cvt_pk_bf16(w_pool[(size_t)lg * 16384 + c * 128 + d] * sc, w_pool[(size_t)lg * 16384 + (c + 1) * 128 + d] * sc); } }
    { bf16_t* P = (bf16_t*)(ws + WS_P); float* rss = (float*)(ws + WS_RSS);
      for (int m4 = gw * 4; m4 < M; m4 += NGW * 4) {
          f32x4 v[4][4];
#pragma unroll
          for (int r = 0; r < 4; ++r) { const f32x4* xr = (const f32x4*)(a.in[0] + (size_t)(m4 + r) * D) + lane;
#pragma unroll
              for (int j = 0; j < 4; ++j) v[r][j] = xr[64 * j]; }
#pragma unroll
          for (int r = 0; r < 4; ++r) { float s = 0.f;
#pragma unroll
              for (int j = 0; j < 4; ++j) s += (v[r][j].x * v[r][j].x + v[r][j].y * v[r][j].y) + (v[r][j].z * v[r][j].z + v[r][j].w * v[r][j].w);
              s = wave_sum(s);
              u32x2* o = (u32x2*)(P + (size_t)(m4 + r) * PITCH + XB_COL) + lane;
#pragma unroll
              for (int j = 0; j < 4; ++j) { u32x2 w; w.x = cvt_pk_bf16(v[r][j].x, v[r][j].y); w.y = cvt_pk_bf16(v[r][j].z, v[r][j].w); o[64 * j] = w; }
              unsigned* o8 = (unsigned*)(ws + WS_XB8 + (size_t)(m4 + r) * D) + lane;
#pragma unroll
              for (int j = 0; j < 4; ++j) o8[64 * j] = pk4_fp8(v[r][j].x, v[r][j].y, v[r][j].z, v[r][j].w);
              if (lane < 16) rss[(size_t)(m4 + r) * 16 + lane] = (lane == 0) ? s : 0.f; }
      } }
}

__device__ __forceinline__ float row_rstd(const float* rss, int row, int fq) {
    const f32x4 p = *(const f32x4*)(rss + (size_t)row * 16 + fq * 4);
    float s = (p.x + p.y) + (p.z + p.w); s += __shfl_xor(s, 16); s += __shfl_xor(s, 32);
    return __builtin_amdgcn_rsqf(s * (1.0f / D) + RMS_EPS);
}
__device__ __forceinline__ float rstd_of(f32x4 p) { float s = (p.x + p.y) + (p.z + p.w); s += __shfl_xor(s, 16); s += __shfl_xor(s, 32); return __builtin_amdgcn_rsqf(s * (1.0f / D) + RMS_EPS); }
#define ZERO_ACC(acc) do { _Pragma("unroll") for (int _a = 0; _a < 2; ++_a) _Pragma("unroll") for (int _b = 0; _b < 2; ++_b) _Pragma("unroll") for (int _m = 0; _m < 4; ++_m) _Pragma("unroll") for (int _n = 0; _n < 2; ++_n) acc[_a][_b][_m][_n] = (f32x4){0.f, 0.f, 0.f, 0.f}; } while (0)

struct SchedP1 {
    pg8::TileOrder T; const char* P; const char* W;
    __device__ __forceinline__ bool next(int i, pg8::Unit& u) const { int pm, pn; if (!T.tile(i, pm, pn)) return false;
        u.pm = pm; u.pn = pn; u.kind = pn >> 1; u.nt = D / 64; u.A = P + ((size_t)pm * 256 * PITCH + XB_COL) * 2; u.B = W + (size_t)pn * 256 * D * 2; return true; }
};
struct EpiP1 {
    bf16_t* P; const float* rss; float* lns;
    __device__ __forceinline__ void operator()(f32x4 (&acc)[2][2][4][2], const pg8::Unit& u, int wr, int wc, int fr, int fq) const {
        const int seg = u.kind;
        const int act = (seg == 3) ? 1 : 0;
        unsigned lrow = (unsigned)(wr * 64 + fr); asm volatile("" : "+v"(lrow));
        const unsigned lp = (lrow * PITCH + (unsigned)(wc * 32) + 8u * (unsigned)fq) * 2u;
        const unsigned lr = lrow * 64u;
        const size_t up = (size_t)u.pm * 256 * PITCH + (size_t)u.pn * 256;
        const size_t ur = (size_t)u.pm * 256 * 16;
        f32x4 pr[2][4];
#pragma unroll
        for (int ai = 0; ai < 2; ++ai)
#pragma unroll
            for (int m = 0; m < 4; ++m) pr[ai][m] = *(const f32x4*)((const char*)(rss + ur + (ai * 128 + m * 16) * 16) + (lr + 16u * fq));
#pragma unroll
        for (int ai = 0; ai < 2; ++ai)
#pragma unroll
            for (int m = 0; m < 4; ++m) {
                const float rs = rstd_of(pr[ai][m]);
                float s1 = 0.f, s2 = 0.f;
#pragma unroll
                for (int bj = 0; bj < 2; ++bj) {
                    f32x4 v0 = acc[ai][bj][m][0] * rs, v1 = acc[ai][bj][m][1] * rs;
                    if (act == 1) {
#pragma unroll
                        for (int j = 0; j < 2; ++j) { const f32x2 g0 = gelu2((f32x2){v0[2 * j], v0[2 * j + 1]}), g1 = gelu2((f32x2){v1[2 * j], v1[2 * j + 1]});
                            v0[2 * j] = g0.x; v0[2 * j + 1] = g0.y; v1[2 * j] = g1.x; v1[2 * j + 1] = g1.y; } }
                    u32x4 w; w.x = cvt_pk_bf16(v0[0], v0[1]); w.y = cvt_pk_bf16(v0[2], v0[3]); w.z = cvt_pk_bf16(v1[0], v1[1]); w.w = cvt_pk_bf16(v1[2], v1[3]);
                    *(u32x4*)((char*)(P + up + (size_t)(ai * 128 + m * 16) * PITCH + bj * 128) + lp) = w;
                    if (seg == 3) {
#pragma unroll
                        for (int q = 0; q < 4; ++q) { const float lo = bf_lo(w[q]), hi = bf_hi(w[q]); s1 += lo + hi; s2 += lo * lo + hi * hi; } }
                }
                if (seg == 3) { s1 += __shfl_xor(s1, 16); s1 += __shfl_xor(s1, 32); s2 += __shfl_xor(s2, 16); s2 += __shfl_xor(s2, 32);
                    if (fq == 0) *(f32x2*)((char*)(lns + ur + (ai * 128 + m * 16) * 16 + ((u.pn - 6) * 4 + wc) * 2) + lr) = (f32x2){s1, s2}; }
            }
        ZERO_ACC(acc);
    }
};

struct SchedG {
    int x, r, n, c0, sq; const char* A8; const char* W8;
    __device__ __forceinline__ bool next(int i, pg8::Unit& u) const { if (i >= n) return false;
        int combo, pl;
        if (i < sq) { pl = 4 * i + (r & 3); combo = c0 + (r >> 2); } else { pl = r & 7; combo = c0 + (sq ? 4 : 0) + 2 * (i - sq) + (r >> 3); }
        const int gate = combo >> 2;
        u.pm = 8 * x + pl; u.pn = combo & 3; u.kind = gate; u.nt = D / 128;
        u.A = A8 + (size_t)u.pm * 256 * D; u.B = W8 + ((size_t)gate * D + (size_t)u.pn * 256) * D; return true; }
};
struct EpiP3G {
    unsigned char* S8; size_t gstride; unsigned rowb; const float* rss;
    __device__ __forceinline__ void operator()(f32x4 (&acc)[2][2][4][2], const pg8::Unit& u, int wr, int wc, int fr, int fq) const {
        unsigned lrow = (unsigned)(wr * 64 + fr); asm volatile("" : "+v"(lrow));
        const unsigned ls = lrow * rowb + (unsigned)(wc * 32) + 8u * (unsigned)fq;
        const unsigned lr = lrow * 64u;
        unsigned char* sb = S8 + (size_t)(u.pm >> 3) * GATE_GROUP_BYTES + (size_t)u.kind * gstride + (size_t)(u.pm & 7) * 256 * rowb + (size_t)u.pn * 256;
        const size_t ur = (size_t)u.pm * 256 * 16;
        f32x4 pr[2][4];
#pragma unroll
        for (int ai = 0; ai < 2; ++ai)
#pragma unroll
            for (int m = 0; m < 4; ++m) pr[ai][m] = *(const f32x4*)((const char*)(rss + ur + (ai * 128 + m * 16) * 16) + (lr + 16u * fq));
#pragma unroll
        for (int ai = 0; ai < 2; ++ai)
#pragma unroll
            for (int m = 0; m < 4; ++m) {
                const float rs = rstd_of(pr[ai][m]) * (-1.4426950409f / WG8_SCALE);
#pragma unroll
                for (int bj = 0; bj < 2; ++bj) {
                    unsigned w0 = 0u, w1 = 0u;
#pragma unroll
                    for (int h = 0; h < 2; ++h) {
                        const f32x2 q0 = rcp2(exp2_2((f32x2){acc[ai][bj][m][0][2 * h], acc[ai][bj][m][0][2 * h + 1]} * rs) * (1.0f / 255.0f) + (1.0f / 255.0f));
                        const f32x2 q1 = rcp2(exp2_2((f32x2){acc[ai][bj][m][1][2 * h], acc[ai][bj][m][1][2 * h + 1]} * rs) * (1.0f / 255.0f) + (1.0f / 255.0f));
                        w0 = __builtin_amdgcn_cvt_pk_u8_f32(q0.x, 2 * h, w0); w0 = __builtin_amdgcn_cvt_pk_u8_f32(q0.y, 2 * h + 1, w0);
                        w1 = __builtin_amdgcn_cvt_pk_u8_f32(q1.x, 2 * h, w1); w1 = __builtin_amdgcn_cvt_pk_u8_f32(q1.y, 2 * h + 1, w1); }
                    w0 |= (((w0 - 0x01010101u) & ~w0) >> 7) & 0x01010101u; w1 |= (((w1 - 0x01010101u) & ~w1) >> 7) & 0x01010101u;
                    *(u32x2*)(sb + (size_t)(ai * 128 + m * 16) * rowb + bj * 128 + ls) = (u32x2){w0, w1}; }
            }
        ZERO_ACC(acc);
    }
};
struct SchedP3Y {
    int pm, pn; const char* P; const char* W;
    __device__ __forceinline__ bool next(int i, pg8::Unit& u) const { if (i >= 3) return false;
        u.pm = pm; u.pn = pn; u.kind = i; u.nt = 512 / 64;
        u.A = P + ((size_t)pm * 256 * PITCH + (size_t)i * 512) * 2; u.B = W + ((size_t)pn * 256 * K3 + (size_t)i * 512) * 2; return true; }
};
struct EpiP3Y {
    bf16_t* P; const unsigned char* S8; size_t gstride; unsigned rowb;
    __device__ __forceinline__ void operator()(f32x4 (&acc)[2][2][4][2], const pg8::Unit& u, int wr, int wc, int fr, int fq) const {
        const int j = u.kind; const bool fin = (j == 2);
        unsigned lrow = (unsigned)(wr * 64 + fr); asm volatile("" : "+v"(lrow));
        const unsigned ls = lrow * rowb + (unsigned)(wc * 32) + 8u * (unsigned)fq;
        const unsigned lp = (lrow * PITCH + (unsigned)(wc * 32) + 8u * (unsigned)fq) * 2u;
        const unsigned char* sb = S8 + (size_t)(u.pm >> 3) * GATE_GROUP_BYTES + (size_t)(u.pm & 7) * 256 * rowb + (size_t)u.pn * 256;
        const unsigned char* pn_ = sb + (size_t)j * gstride; const unsigned char* pd_ = sb + (size_t)(fin ? 2 : j + 1) * gstride;
        bf16_t* pmg = P + (size_t)u.pm * 256 * PITCH + C_MERGED + (size_t)u.pn * 256;
#pragma unroll
        for (int ai = 0; ai < 2; ++ai)
#pragma unroll
        for (int mh = 0; mh < 2; ++mh) {
            u32x2 sn[2][2], sd[2][2];
#pragma unroll
            for (int mm = 0; mm < 2; ++mm)
#pragma unroll
                for (int bj = 0; bj < 2; ++bj) { const size_t ro = (size_t)(ai * 128 + (mh * 2 + mm) * 16) * rowb + bj * 128;
                    sn[mm][bj] = *(const u32x2*)(pn_ + ro + ls); sd[mm][bj] = *(const u32x2*)(pd_ + ro + ls); }
#pragma unroll
            for (int mm = 0; mm < 2; ++mm)
#pragma unroll
                for (int bj = 0; bj < 2; ++bj) { const int m = mh * 2 + mm;
#pragma unroll
                    for (int n = 0; n < 2; ++n) { const unsigned sdw = fin ? 0xffffffffu : sd[mm][bj][n];
#pragma unroll
                        for (int e = 0; e < 4; ++e) { const float qn = (float)((sn[mm][bj][n] >> (8 * e)) & 0xffu), qd = (float)((sdw >> (8 * e)) & 0xffu);
                            acc[ai][bj][m][n][e] *= qn * __builtin_amdgcn_rcpf(qd); } }
                    if (fin) { const f32x4 v0 = acc[ai][bj][m][0], v1 = acc[ai][bj][m][1];
                        u32x4 w; w.x = cvt_pk_bf16(v0[0], v0[1]); w.y = cvt_pk_bf16(v0[2], v0[3]); w.z = cvt_pk_bf16(v1[0], v1[1]); w.w = cvt_pk_bf16(v1[2], v1[3]);
                        *(u32x4*)((char*)(pmg + (size_t)(ai * 128 + m * 16) * PITCH + bj * 128) + lp) = w; } }
        }
    }
};

struct SchedP4 {
    pg8::TileOrder T; const char* P; const char* W;
    __device__ __forceinline__ bool next(int i, pg8::Unit& u) const { int pm, pn; if (!T.tile(i, pm, pn)) return false;
        u.pm = pm; u.pn = pn; u.kind = 0; u.nt = D / 64; u.A = P + ((size_t)pm * 256 * PITCH + C_MERGED) * 2; u.B = W + (size_t)pn * 256 * D * 2; return true; }
};
struct EpiP4 {
    bf16_t* P; float* rss_out; unsigned char* xb8;
    __device__ __forceinline__ void operator()(f32x4 (&acc)[2][2][4][2], const pg8::Unit& u, int wr, int wc, int fr, int fq) const {
        unsigned lrow = (unsigned)(wr * 64 + fr); asm volatile("" : "+v"(lrow));
        const unsigned lc = (unsigned)(wc * 32) + 8u * (unsigned)fq;
        const unsigned lp = (lrow * PITCH + lc) * 2u, lx = (lrow * D + lc) * 4u, l8 = lrow * D + lc;
        const size_t ux = (size_t)u.pm * 256 * D + (size_t)u.pn * 256;
        bf16_t* pb = P + (size_t)u.pm * 256 * PITCH + (size_t)u.pn * 256 + XB_COL;
        float* rb = rss_out + (size_t)u.pm * 256 * 16 + u.pn * 4 + wc;
#pragma unroll
        for (int ai = 0; ai < 2; ++ai)
#pragma unroll
        for (int mh = 0; mh < 2; ++mh) {
            u32x4 hv[2][2];
#pragma unroll
            for (int mm = 0; mm < 2; ++mm)
#pragma unroll
                for (int bj = 0; bj < 2; ++bj) hv[mm][bj] = *(const u32x4*)((const char*)(pb + (size_t)(ai * 128 + (mh * 2 + mm) * 16) * PITCH + bj * 128) + lp);
#pragma unroll
            for (int mm = 0; mm < 2; ++mm) {
                const int m = mh * 2 + mm; float ss = 0.f;
#pragma unroll
                for (int bj = 0; bj < 2; ++bj) { const size_t ro = (size_t)(ai * 128 + m * 16) * D + bj * 128;
                    const f32x4 v0 = (f32x4){bf_lo(hv[mm][bj].x), bf_hi(hv[mm][bj].x), bf_lo(hv[mm][bj].y), bf_hi(hv[mm][bj].y)} + acc[ai][bj][m][0], v1 = (f32x4){bf_lo(hv[mm][bj].z), bf_hi(hv[mm][bj].z), bf_lo(hv[mm][bj].w), bf_hi(hv[mm][bj].w)} + acc[ai][bj][m][1];
                    ss += (v0[0] * v0[0] + v0[1] * v0[1]) + (v0[2] * v0[2] + v0[3] * v0[3]) + (v1[0] * v1[0] + v1[1] * v1[1]) + (v1[2] * v1[2] + v1[3] * v1[3]);
                    u32x4 w; w.x = cvt_pk_bf16(v0[0], v0[1]); w.y = cvt_pk_bf16(v0[2], v0[3]); w.z = cvt_pk_bf16(v1[0], v1[1]); w.w = cvt_pk_bf16(v1[2], v1[3]);
                    *(u32x4*)((char*)(pb + (size_t)(ai * 128 + m * 16) * PITCH + bj * 128) + lp) = w;
                    *(u32x2*)((xb8 + ux + ro) + l8) = (u32x2){pk4_fp8(v0[0], v0[1], v0[2], v0[3]), pk4_fp8(v1[0], v1[1], v1[2], v1[3])};
 }
                ss += __shfl_xor(ss, 16); ss += __shfl_xor(ss, 32);
                if (fq == 0) *(float*)((char*)(rb + (ai * 128 + m * 16) * 16) + lrow * 64u) = ss;
            }
        }
        ZERO_ACC(acc);
    }
};

struct EpiP4F {

    const bf16_t* P; float* out; float* rss_out; const float* fg; unsigned* cnt; unsigned* tmo;
    __device__ __forceinline__ void operator()(f32x4 (&acc)[2][2][4][2], const pg8::Unit& u, int wr, int wc, int fr, int fq) const {
        unsigned lrow = (unsigned)(wr * 64 + fr); asm volatile("" : "+v"(lrow));
        const unsigned lc = (unsigned)(wc * 32) + 8u * (unsigned)fq;
        const unsigned lx = (lrow * D + lc) * 4u;
        const unsigned lp = (lrow * PITCH + lc) * 2u, l8 = lrow * D + lc;
        const bf16_t* pxb = P + (size_t)u.pm * 256 * PITCH + (size_t)u.pn * 256 + XB_COL;
        const size_t ux = (size_t)u.pm * 256 * D + (size_t)u.pn * 256;
        float* rb = rss_out + (size_t)u.pm * 256 * 16 + u.pn * 4 + wc;
#pragma unroll
        for (int ai = 0; ai < 2; ++ai)
#pragma unroll
        for (int mh = 0; mh < 2; ++mh) {
            f32x4 xo[2][2][2]; u32x4 hv[2][2];
#pragma unroll
            for (int mm = 0; mm < 2; ++mm)
#pragma unroll
                for (int bj = 0; bj < 2; ++bj) hv[mm][bj] = *(const u32x4*)((const char*)(pxb + (size_t)(ai * 128 + (mh * 2 + mm) * 16) * PITCH + bj * 128) + lp);
#pragma unroll
            for (int mm = 0; mm < 2; ++mm)
#pragma unroll
                for (int bj = 0; bj < 2; ++bj)
#pragma unroll
                    for (int n = 0; n < 2; ++n) xo[mm][bj][n] = (f32x4){bf_lo(hv[mm][bj][2 * n]), bf_hi(hv[mm][bj][2 * n]), bf_lo(hv[mm][bj][2 * n + 1]), bf_hi(hv[mm][bj][2 * n + 1])};
#pragma unroll
            for (int mm = 0; mm < 2; ++mm) {
                const int m = mh * 2 + mm; float ss = 0.f;
#pragma unroll
                for (int bj = 0; bj < 2; ++bj) { const f32x4 v0 = xo[mm][bj][0] + acc[ai][bj][m][0], v1 = xo[mm][bj][1] + acc[ai][bj][m][1];
                    acc[ai][bj][m][0] = v0; acc[ai][bj][m][1] = v1;
                    ss += (v0[0] * v0[0] + v0[1] * v0[1]) + (v0[2] * v0[2] + v0[3] * v0[3]) + (v1[0] * v1[0] + v1[1] * v1[1]) + (v1[2] * v1[2] + v1[3] * v1[3]); }
                ss += __shfl_xor(ss, 16); ss += __shfl_xor(ss, 32);
                if (fq == 0) __hip_atomic_store((float*)((char*)(rb + (ai * 128 + m * 16) * 16) + lrow * 64u), ss, __ATOMIC_RELAXED, __HIP_MEMORY_SCOPE_AGENT);
            }
        }
        asm volatile("s_waitcnt vmcnt(0)" ::: "memory");
        const int lane = (int)(threadIdx.x & 63); const int wid = wr * 4 + wc;
        unsigned* pc = cnt + 64 * u.pm;
        if (lane == 0) __hip_atomic_fetch_add(pc, 1u, __ATOMIC_RELAXED, __HIP_MEMORY_SCOPE_AGENT);
        if (wid == 0) {
            asm volatile("buffer_inv sc1" ::: "memory");
            unsigned sp = 0;
            while ((unsigned)__builtin_amdgcn_readfirstlane(__hip_atomic_load(pc, __ATOMIC_RELAXED, __HIP_MEMORY_SCOPE_AGENT)) < 32u) {
                __builtin_amdgcn_s_sleep(1);
                if ((++sp & 255u) == 0u) { if (__hip_atomic_load(tmo, __ATOMIC_RELAXED, __HIP_MEMORY_SCOPE_AGENT)) break; if (sp > (1u << 20)) { if (lane == 0) atomicAdd(tmo, 1u); break; } } }
            asm volatile("s_waitcnt vmcnt(0)" ::: "memory");
        }
        asm volatile("" ::: "memory"); __builtin_amdgcn_s_barrier(); asm volatile("" ::: "memory");
        const unsigned lr = lrow * 64u;
        const size_t ur = (size_t)u.pm * 256 * 16;
        f32x4 pr[2][4];
#pragma unroll
        for (int ai = 0; ai < 2; ++ai)
#pragma unroll
            for (int m = 0; m < 4; ++m) pr[ai][m] = *(const f32x4*)((const char*)(rss_out + ur + (ai * 128 + m * 16) * 16) + (lr + 16u * fq));
        f32x4 gv[2][2];
#pragma unroll
        for (int bj = 0; bj < 2; ++bj) { const float* gp = (const float*)((const char*)(fg + u.pn * 256 + bj * 128) + lc * 4u); gv[bj][0] = *(const f32x4*)gp; gv[bj][1] = *(const f32x4*)(gp + 4); }
#pragma unroll
        for (int ai = 0; ai < 2; ++ai)
#pragma unroll
            for (int m = 0; m < 4; ++m) { const float rs = rstd_of(pr[ai][m]);
#pragma unroll
                for (int bj = 0; bj < 2; ++bj) { float* xq = (float*)((char*)(out + ux + (size_t)(ai * 128 + m * 16) * D + bj * 128) + lx);
                    *(f32x4*)xq = acc[ai][bj][m][0] * rs * gv[bj][0]; *(f32x4*)(xq + 4) = acc[ai][bj][m][1] * rs * gv[bj][1]; } }
        ZERO_ACC(acc);
    }
};

#define LDG(T, uptr, lboff) (*(const T*)((const char*)(uptr) + (lboff)))
#define STG(T, uptr, lboff, val) (*(T*)((char*)(uptr) + (lboff)) = (val))
typedef short s16x4 __attribute__((ext_vector_type(4)));
__device__ __forceinline__ s16x4 lds_tr16(const LAS void* p) { return __builtin_amdgcn_ds_read_tr16_b64_v4i16((LAS s16x4*)p); }
template <int TH> __device__ __forceinline__ void mixer_a_body(bf16_t* P, const float* lns, const bf16_t* Wm, const float* ln_g, const float* ln_b, const float* b_s, LAS unsigned char* wl, int n, int g, int lane) {
    constexpr int SLEN = 64 * (TH + 1), NV = SLEN / 8, NKS = 2 * (TH + 1);
    const int T0 = n * 128;
    constexpr int VB = 136;
    constexpr int OB = 272;
    const int ck = lane & 7, rsub = lane >> 3;
    const int fr = lane & 15, fq = lane >> 4;
    const unsigned lv = (unsigned)(rsub * PITCH + ck * 8) * 2u;
    const unsigned lw = (unsigned)(fr * 128 + fq * 8) * 2u;
    const bf16_t* pv = P + (size_t)T0 * PITCH + C_V + g * 64;
    u32x4 raw[NV];
#pragma unroll
    for (int q = 0; q < NV; ++q) raw[q] = LDG(u32x4, pv + (size_t)(q * 8) * PITCH, lv);
    f32x4 st[TH + 1][4];
#pragma unroll
    for (int h = 0; h <= TH; ++h)
#pragma unroll
        for (int j = 0; j < 4; ++j) st[h][j] = LDG(f32x4, lns + (size_t)(T0 + 64 * h) * 16 + 4 * j, (unsigned)lane * 64u);
    float lg[8], lb[8];
    { const f32x4 g0 = LDG(f32x4, ln_g + g * 64, (unsigned)ck * 32u), g1 = LDG(f32x4, ln_g + g * 64 + 4, (unsigned)ck * 32u), b0 = LDG(f32x4, ln_b + g * 64, (unsigned)ck * 32u), b1 = LDG(f32x4, ln_b + g * 64 + 4, (unsigned)ck * 32u);
#pragma unroll
      for (int j = 0; j < 4; ++j) { lg[j] = g0[j]; lg[4 + j] = g1[j]; lb[j] = b0[j]; lb[4 + j] = b1[j]; } }
    float mean[TH + 1], rstd[TH + 1];
#pragma unroll
    for (int h = 0; h <= TH; ++h) { const f32x4 a = st[h][0], b = st[h][1], c = st[h][2], d = st[h][3];
        const float s1 = (a.x + a.z) + (b.x + b.z) + (c.x + c.z) + (d.x + d.z), s2 = (a.y + a.w) + (b.y + b.w) + (c.y + c.w) + (d.y + d.w);
        mean[h] = s1 * (1.f / 512.f); rstd[h] = __builtin_amdgcn_rsqf(fmaxf(s2 * (1.f / 512.f) - mean[h] * mean[h], 0.f) + LN_EPS); }
#pragma unroll
    for (int q = 0; q < NV; ++q) { const int s = q * 8 + rsub;
        const float mu = __shfl(mean[(q * 8) >> 6], s & 63), rs = __shfl(rstd[(q * 8) >> 6], s & 63);
        unsigned pk[4];
#pragma unroll
        for (int j = 0; j < 4; ++j) { const f32x2 y = (bf2(raw[q][j]) - mu) * rs * (f32x2){lg[2 * j], lg[2 * j + 1]} + (f32x2){lb[2 * j], lb[2 * j + 1]}; pk[j] = cvt_pk_bf16(y.x, y.y); }
        LAS unsigned char* wp = wl + s * VB + ck * 16;
        *(LAS u32x2*)wp = (u32x2){pk[0], pk[1]}; *(LAS u32x2*)(wp + 8) = (u32x2){pk[2], pk[3]}; }
    LDS_WAIT(); asm volatile("" ::: "memory");
    f32x4 acc[4][4];
#pragma unroll
    for (int ct = 0; ct < 4; ++ct)
#pragma unroll
        for (int tt = 0; tt < 4; ++tt) acc[ct][tt] = (f32x4){0.f, 0.f, 0.f, 0.f};
    const bf16_t* wmg = Wm + (size_t)g * 128 * 128 + (size_t)(64 * TH) * 128;
    const LAS unsigned char* trp = wl + (8 * fq + (fr >> 2)) * VB + (fr & 3) * 8;
#pragma unroll 1
    for (int ks = 0; ks < NKS; ++ks) {
        bf16x8 af[4], bfr[4];
#pragma unroll
        for (int tt = 0; tt < 4; ++tt) bfr[tt] = LDG(bf16x8, wmg + (16 * tt) * 128 + ks * 32, lw);
#pragma unroll
        for (int ct = 0; ct < 4; ++ct) { const s16x4 a0 = lds_tr16(trp + (ks * 32) * VB + ct * 32), a1 = lds_tr16(trp + (ks * 32 + 4) * VB + ct * 32);
            af[ct] = (bf16x8){a0[0], a0[1], a0[2], a0[3], a1[0], a1[1], a1[2], a1[3]}; }
#pragma unroll
        for (int ct = 0; ct < 4; ++ct)
#pragma unroll
            for (int tt = 0; tt < 4; ++tt) acc[ct][tt] = __builtin_amdgcn_mfma_f32_16x16x32_bf16(af[ct], bfr[tt], acc[ct][tt], 0, 0, 0);
    }
    LDS_WAIT(); asm volatile("" ::: "memory");
#pragma unroll
    for (int tt = 0; tt < 4; ++tt)
#pragma unroll
        for (int ct = 0; ct < 4; ++ct) *(LAS f32x4*)(wl + (16 * tt + fr) * OB + (16 * ct + 4 * fq) * 4) = acc[ct][tt];
    LDS_WAIT(); asm volatile("" ::: "memory");
    bf16_t* po = P + (size_t)(T0 + 64 * TH) * PITCH + g * 64;
    const float* bsp = b_s + g * 128 + 64 * TH;
#pragma unroll
    for (int hf = 0; hf < 2; ++hf) {
        u32x4 uu[4], zz[4]; float bs[4];
#pragma unroll
        for (int q = 0; q < 4; ++q) { uu[q] = LDG(u32x4, po + (size_t)((hf * 4 + q) * 8) * PITCH + C_U, lv); zz[q] = LDG(u32x4, po + (size_t)((hf * 4 + q) * 8) * PITCH + C_ZA, lv);
            bs[q] = LDG(float, bsp + (hf * 4 + q) * 8, (unsigned)rsub * 4u); }
#pragma unroll
        for (int q = 0; q < 4; ++q) { const int t = (hf * 4 + q) * 8 + rsub;
            const f32x4 s0 = *(const LAS f32x4*)(wl + t * OB + ck * 32), s1 = *(const LAS f32x4*)(wl + t * OB + ck * 32 + 16);
            u32x4 w;
#pragma unroll
            for (int j = 0; j < 4; ++j) { const f32x2 s2 = (j < 2 ? (f32x2){s0[2 * j], s0[2 * j + 1]} : (f32x2){s1[2 * j - 4], s1[2 * j - 3]}) + bs[q];
                const f32x2 o = gelu2(bf2(uu[q][j])) * s2 * silu2(bf2(zz[q][j]));
                w[j] = cvt_pk_bf16(o.x, o.y); }
            STG(u32x4, po + (size_t)((hf * 4 + q) * 8) * PITCH + C_U, lv, w); }
    }
    LDS_WAIT(); asm volatile("" ::: "memory");
}
__device__ __forceinline__ void mixer_a_item(bf16_t* P, const float* lns, const bf16_t* Wm, const float* ln_g, const float* ln_b, const float* b_s, LAS unsigned char* wl, int item, int lane) {
    const int th = item & 1, g = (item >> 1) & 7, n = item >> 4;
    if (th) mixer_a_body<1>(P, lns, Wm, ln_g, ln_b, b_s, wl, n, g, lane); else mixer_a_body<0>(P, lns, Wm, ln_g, ln_b, b_s, wl, n, g, lane);
}

__device__ __forceinline__ void mixer_b_item(bf16_t* P, const float* conv_w, const float* conv_b, int item, int lane) {
    const int hb = item & 1, t0 = (item >> 1) * 16;
    const bool seq_start = (t0 % SEQ) == 0;
    bf16_t* pbase = P + (size_t)t0 * PITCH + hb * 256;
    const unsigned l8 = (unsigned)lane * 8u, l16 = (unsigned)lane * 16u;
    const f32x4 w0 = LDG(f32x4, conv_w + hb * 256, l16), w1 = LDG(f32x4, conv_w + 512 + hb * 256, l16), w2 = LDG(f32x4, conv_w + 1024 + hb * 256, l16), cb = LDG(f32x4, conv_b + hb * 256, l16);
    f32x4 pm2 = (f32x4){0.f, 0.f, 0.f, 0.f}, pm1 = pm2;
#pragma unroll
    for (int hf = 0; hf < 2; ++hf) {
        u32x2 xx[10], cc[10], bb[8], zz[8];
#pragma unroll
        for (int r = (hf ? 2 : 0); r < 10; ++r) { const int dt = hf * 8 + r - 2; const bool ok = (dt >= 0) || !seq_start;
            xx[r] = ok ? LDG(u32x2, pbase + (ptrdiff_t)dt * PITCH + C_XB, l8) : (u32x2){0u, 0u}; cc[r] = ok ? LDG(u32x2, pbase + (ptrdiff_t)dt * PITCH + C_CG, l8) : (u32x2){0u, 0u}; }
#pragma unroll
        for (int r = 0; r < 8; ++r) { bb[r] = LDG(u32x2, pbase + (size_t)(hf * 8 + r) * PITCH + C_BG, l8); zz[r] = LDG(u32x2, pbase + (size_t)(hf * 8 + r) * PITCH + C_ZB, l8); }
        if (hf == 0) {
            pm2 = (f32x4){bf_lo(xx[0].x) * bf_lo(cc[0].x), bf_hi(xx[0].x) * bf_hi(cc[0].x), bf_lo(xx[0].y) * bf_lo(cc[0].y), bf_hi(xx[0].y) * bf_hi(cc[0].y)};
            pm1 = (f32x4){bf_lo(xx[1].x) * bf_lo(cc[1].x), bf_hi(xx[1].x) * bf_hi(cc[1].x), bf_lo(xx[1].y) * bf_lo(cc[1].y), bf_hi(xx[1].y) * bf_hi(cc[1].y)}; }
#pragma unroll
        for (int r = 0; r < 8; ++r) {
            const f32x4 p0 = (f32x4){bf_lo(xx[r + 2].x) * bf_lo(cc[r + 2].x), bf_hi(xx[r + 2].x) * bf_hi(cc[r + 2].x), bf_lo(xx[r + 2].y) * bf_lo(cc[r + 2].y), bf_hi(xx[r + 2].y) * bf_hi(cc[r + 2].y)};
            const f32x4 y = cb + w0 * pm2 + w1 * pm1 + w2 * p0;
            const f32x4 bg = (f32x4){bf_lo(bb[r].x), bf_hi(bb[r].x), bf_lo(bb[r].y), bf_hi(bb[r].y)};
            const f32x2 zb0 = silu2(bf2(zz[r].x)), zb1 = silu2(bf2(zz[r].y)); const f32x4 zb = (f32x4){zb0.x, zb0.y, zb1.x, zb1.y};
            const f32x4 o = bg * y * zb;
            u32x2 w; w.x = cvt_pk_bf16(o[0], o[1]); w.y = cvt_pk_bf16(o[2], o[3]); STG(u32x2, pbase + (size_t)(hf * 8 + r) * PITCH + C_ZB, l8, w);
            pm2 = pm1; pm1 = p0; }
    }
}

template <int W> __device__ __forceinline__ void mixer_c_pool(const bf16_t* pxc  , LAS bf16_t* pl, int PL_LD, int tseq, int lane) {
    constexpr int NR = 31 + W;
    unsigned xv[NR];
#pragma unroll
    for (int r = 0; r < NR; ++r) { const int dt = r - (W - 1); xv[r] = (dt >= 0 || tseq > 0) ? LDG(unsigned, pxc + (ptrdiff_t)dt * PITCH, (unsigned)lane * 4u) : 0u; }
    f32x2 s = (f32x2){0.f, 0.f};
#pragma unroll
    for (int r = 0; r < NR; ++r) {
        const int dt = r - (W - 1);
        const f32x2 xr = bf2(xv[r]);
        s += xr;
        if (r >= W) s -= bf2(xv[r - W]);
        if (dt >= 0) { const int pos = tseq + dt; const float inv = 1.0f / (float)((pos + 1 < W) ? (pos + 1) : W);
            const f32x2 o = s * inv - xr; *(LAS unsigned*)(pl + dt * PL_LD + 2 * lane) = cvt_pk_bf16(o.x, o.y); }
    }
}
__device__ __forceinline__ void mixer_c_item(bf16_t* P, const bf16_t* WpT, LAS unsigned char* wl, int item, int lane) {
    const int gi = item & 3, t0 = (item >> 2) * 32;
    constexpr int PL_LD = 136;
    constexpr int OB = 528;
    LAS bf16_t* pl = (LAS bf16_t*)wl;
    const bf16_t* pxc = P + (size_t)t0 * PITCH + C_XC + gi * 128; const int tseq = t0 % SEQ;
    if (gi == 0) mixer_c_pool<2>(pxc, pl, PL_LD, tseq, lane);
    else if (gi == 1) mixer_c_pool<4>(pxc, pl, PL_LD, tseq, lane);
    else if (gi == 2) mixer_c_pool<8>(pxc, pl, PL_LD, tseq, lane);
    else mixer_c_pool<16>(pxc, pl, PL_LD, tseq, lane);
    LDS_WAIT(); asm volatile("" ::: "memory");
    const int fr = lane & 15, fq = lane >> 4;
    const unsigned lw = (unsigned)(fr * 128 + fq * 8) * 2u;
    bf16x8 bfr[2][4];
#pragma unroll
    for (int tt = 0; tt < 2; ++tt)
#pragma unroll
        for (int ks = 0; ks < 4; ++ks) bfr[tt][ks] = *(const LAS bf16x8*)(pl + (tt * 16 + fr) * PL_LD + ks * 32 + fq * 8);
    LDS_WAIT(); asm volatile("" ::: "memory");
    const bf16_t* wg = WpT + (size_t)gi * 128 * 128;
#pragma unroll 2
    for (int dp = 0; dp < 4; ++dp) {
        bf16x8 af[2][4];
#pragma unroll
        for (int d2 = 0; d2 < 2; ++d2)
#pragma unroll
            for (int ks = 0; ks < 4; ++ks) af[d2][ks] = LDG(bf16x8, wg + (size_t)((dp * 2 + d2) * 16) * 128 + ks * 32, lw);
#pragma unroll
        for (int d2 = 0; d2 < 2; ++d2) {
            f32x4 a0 = (f32x4){0.f, 0.f, 0.f, 0.f}, a1 = a0;
#pragma unroll
            for (int ks = 0; ks < 4; ++ks) { a0 = __builtin_amdgcn_mfma_f32_16x16x32_bf16(af[d2][ks], bfr[0][ks], a0, 0, 0, 0); a1 = __builtin_amdgcn_mfma_f32_16x16x32_bf16(af[d2][ks], bfr[1][ks], a1, 0, 0, 0); }
            *(LAS f32x4*)(wl + fr * OB + ((dp * 2 + d2) * 16 + 4 * fq) * 4) = a0; *(LAS f32x4*)(wl + (16 + fr) * OB + ((dp * 2 + d2) * 16 + 4 * fq) * 4) = a1; }
    }
    LDS_WAIT(); asm volatile("" ::: "memory");
    bf16_t* pz = P + (size_t)t0 * PITCH + C_ZC + gi * 128;
    const int r4 = lane >> 4, c16 = lane & 15;
    const unsigned lz = (unsigned)(r4 * PITCH + c16 * 8) * 2u;
    u32x4 zv[8];
#pragma unroll
    for (int q = 0; q < 8; ++q) zv[q] = LDG(u32x4, pz + (size_t)(q * 4) * PITCH, lz);
#pragma unroll
    for (int q = 0; q < 8; ++q) { const int t = q * 4 + r4;
        const f32x4 s0 = *(const LAS f32x4*)(wl + t * OB + c16 * 32), s1 = *(const LAS f32x4*)(wl + t * OB + c16 * 32 + 16);
        u32x4 w;
#pragma unroll
        for (int j = 0; j < 4; ++j) { const float sa = (j < 2 ? s0[2 * j] : s1[2 * j - 4]), sb = (j < 2 ? s0[2 * j + 1] : s1[2 * j - 3]);
            { const f32x2 o = (f32x2){sa, sb} * silu2(bf2(zv[q][j])); w[j] = cvt_pk_bf16(o.x, o.y); } }
        STG(u32x4, pz + (size_t)(q * 4) * PITCH, lz, w); }
    LDS_WAIT(); asm volatile("" ::: "memory");
}

__global__ void __launch_bounds__(NWAVES * 64, 2) hybrid_fwd(Args args) {
    extern __shared__ __attribute__((aligned(16))) unsigned char lds_raw[];
    LAS unsigned char* lds = (LAS unsigned char*)lds_raw;
    volatile LAS unsigned* MISC = (volatile LAS unsigned*)(lds + MISC_OFF);
    const int tid = threadIdx.x, lane = tid & 63, wave = __builtin_amdgcn_readfirstlane(tid >> 6);
    const int G = gridDim.x; const int bx = blockIdx.x;
    const int vcu = (G % 8 == 0) ? (bx % 8) * (G / 8) + bx / 8 : bx;
    const int gw = vcu * NWAVES + wave, NGW = G * NWAVES;
    unsigned char* ws = args.ws;
    for (int u = tid; u < (LDS_BYTES - LDSCTL_OFF) / 4; u += NWAVES * 64) ((LAS unsigned*)(lds + LDSCTL_OFF))[u] = 0u;
    __syncthreads();
    const XcdBarrier bar = xcd_barrier_post((unsigned*)(ws + WS_CTL), MISC + 8, (unsigned)G);
    (void)xcd_barrier_post((unsigned*)(ws + WS_CTL) + (1 + (bx & 7)) * XCD_BAR_WORDS, MISC + 10, (unsigned)(G / 8));
    const int lo = args.ph_lo, hi = args.ph_hi;
#define IN(k) (lo <= (k) && (k) < hi)
#define SEAM(k) do { if (IN(k) && IN((k) + 1)) xcd_barrier(bar); } while (0)
#define CW_PROG 47104
#define GSEAM_W(k, nbr, tgt) GSEAM_X(k, nbr, tgt, false)
#define GSEAM_X(k, nbr, tgt, loc) do { if (IN(k) && IN((k) + 1)) { XcdBarrier gb; gb.bar = (unsigned*)(args.ws + WS_CTL) + (1 + ((int)blockIdx.x & 7)) * XCD_BAR_WORDS; gb.x = bar.x; gb.st = MISC + 10; gb.G = gridDim.x / 8; \
        unsigned* pw_ = (unsigned*)(args.ws + WS_CTL) + CW_PROG; const int nb_ = (nbr); \
        xcd_barrier(gb, nb_ >= 0 ? pw_ + 64 * nb_ : nullptr, (unsigned)(tgt), ((int)blockIdx.x >> 3) == 0 ? pw_ + 64 * ((int)blockIdx.x & 7) : nullptr, (loc)); } } while (0)
#define GSEAM(k) GSEAM_X(k, -1, 0, true)

    bf16_t* P = (bf16_t*)(ws + WS_P);
    float* rss = (float*)(ws + WS_RSS);
    float* lns = (float*)(ws + WS_LNS);

    if (IN(0)) { p0_prologue(args, lds, gw, NGW, wave, lane); }
    SEAM(0);

    for (int l = 0; l < DEPTH; ++l) {
        const int pb = 1 + 4 * l;
        const bf16_t* Wmix = (const bf16_t*)(ws + WS_WMIX) + (size_t)l * NMIX * D;
        const bf16_t* W3 = (const bf16_t*)(ws + WS_W3) + (size_t)l * D * K3;
        const bf16_t* WoT = (const bf16_t*)(ws + WS_WO) + (size_t)l * D * D;
        const float* rss_l = rss + (size_t)l * M * 16;
        if (IN(pb)) {
            const int jg = bx >> 3; const bool five = (G == 256) && (bx < 128);
            for (int pass = 0; pass < 2; ++pass) {
                if ((pass == 0) != five) {
                    SchedG S; S.x = bx & 7; S.r = jg & 15; S.n = five ? 1 : 2; S.c0 = five ? 4 : 0; S.sq = five ? 0 : 2;     S.A8 = (const char*)(ws + WS_XB8); S.W8 = (const char*)(ws + WS_WG8 + (size_t)l * 3 * D * D);
                    EpiP3G E{(unsigned char*)args.out, GATE_PLANE_BYTES, (unsigned)D, rss_l};
                    pg8::gemm_phase<EpiP3G, SchedG, true, true>(lds, D, D, S, E);
                } else {
                    SchedP1 S; S.T.init(M, NMIX, G, bx, P1_WGM); S.P = (const char*)P; S.W = (const char*)Wmix;
                    EpiP1 E{P, rss_l, lns};
                    pg8::gemm_phase<EpiP1, SchedP1, true>(lds, PITCH * 2, D * 2, S, E);
                }
            }
        }
        GSEAM_W(pb, (bx & 3) != 0 ? (bx & 7) - 1 : -1, 1 + 4 * l);
        if (IN(pb + 1)) {
            const bf16_t* Wm = (const bf16_t*)(ws + WS_WM) + (size_t)l * 8 * 128 * 128;
            const bf16_t* WpT = (const bf16_t*)(ws + WS_WPOOL) + (size_t)l * 4 * 128 * 128;
            LAS unsigned char* wl = lds + wave * WAVE_LDS;
            int ln = lane; asm volatile("" : "+v"(ln));
            { const int x = bx & 7, e = bx >> 3;
              SchedG S; S.x = x; S.r = e & 15; S.A8 = (const char*)(ws + WS_XB8); S.W8 = (const char*)(ws + WS_WG8 + (size_t)l * 3 * D * D);
              EpiP3G E{(unsigned char*)args.out, GATE_PLANE_BYTES, (unsigned)D, rss_l};
              if (G != 256) { for (int li = e * NWAVES + wave; li < 768; li += (G / 8) * NWAVES) { const int j = 256 * x + (li & 255);
                  if (li < 256) mixer_a_item(P, lns, Wm, args.in[3] + l * 512, args.in[4] + l * 512, args.in[6] + l * 1024, wl, j, ln);
                  else if (li < 512) mixer_b_item(P, args.in[7] + l * 1536, args.in[8] + l * 512, j, ln);
                  else mixer_c_item(P, WpT, wl, j, ln); } }
              else if (e < 16) {
                for (int li = e * 8 + wave; li < 512; li += 128) { const int j = 256 * x + (li & 255);
                  if (li < 256) mixer_a_item(P, lns, Wm, args.in[3] + l * 512, args.in[4] + l * 512, args.in[6] + l * 1024, wl, j, ln);
                  else mixer_b_item(P, args.in[7] + l * 1536, args.in[8] + l * 512, j, ln); }
                __syncthreads();
                S.n = 1; S.c0 = 10; S.sq = 0;
                pg8::gemm_phase<EpiP3G, SchedG, true, true>(lds, D, D, S, E); }
              else {
                S.n = 2; S.c0 = 6; S.sq = 2;
                pg8::gemm_phase<EpiP3G, SchedG, true, true>(lds, D, D, S, E);
                for (int li = 512 + (e - 16) * 8 + wave; li < 768; li += 128) mixer_c_item(P, WpT, wl, 256 * x + (li & 255), ln); } }
        }
        GSEAM(pb + 1);
        if (IN(pb + 2)) {
            pg8::TileOrder T; T.init(M, D, G, bx); int pm3, pn3;
            if (T.tile(0, pm3, pn3)) {
                SchedP3Y S; S.pm = pm3; S.pn = pn3; S.P = (const char*)P; S.W = (const char*)W3; EpiP3Y E{P, (const unsigned char*)args.out, GATE_PLANE_BYTES, (unsigned)D};
                pg8::gemm_phase<EpiP3Y, SchedP3Y, true>(lds, PITCH * 2, K3 * 2, S, E);
            }
        }
        GSEAM(pb + 2);
        if (IN(pb + 3)) {
            SchedP4 S; S.T.init(M, D, G, bx); S.P = (const char*)P; S.W = (const char*)WoT;
            if (l == 0) { EpiP4 E{P, rss + (size_t)(l + 1) * M * 16, ws + WS_XB8};
                pg8::gemm_phase<EpiP4, SchedP4, true>(lds, PITCH * 2, D * 2, S, E); }
            else { EpiP4F E{P, args.out, rss + (size_t)2 * M * 16, args.in[15], (unsigned*)(ws + WS_CTL) + CW_PANEL, (unsigned*)(ws + WS_CTL) + XB_TMO};
                pg8::gemm_phase<EpiP4F, SchedP4, true>(lds, PITCH * 2, D * 2, S, E); }
        }
        if (l + 1 < DEPTH) GSEAM_X(pb + 3, (bx & 3) != 3 ? (bx & 7) + 1 : -1, 2 + 4 * l, true);
    }
#undef IN
#undef SEAM
#undef GSEAM
}

extern "C" void kernel_launch(void* const* d_in, const int* in_sizes, int n_in, void* d_out, int out_size, void* d_ws, size_t ws_size, hipStream_t stream) {
    static int grid = 0;
    if (grid == 0) {
        if (n_in != 16 || in_sizes[0] != M * D || out_size != M * D || ws_size < WS_END) { fprintf(stderr, "kernel_launch: unexpected shapes (n_in %d, in0 %d, out %d, ws %zu); nothing launched\n", n_in, n_in > 0 ? in_sizes[0] : -1, out_size, ws_size); grid = -1; return; }
        int dev = 0, cus = 0, per_cu = 0;
        if (hipGetDevice(&dev) != hipSuccess || hipDeviceGetAttribute(&cus, hipDeviceAttributeMultiprocessorCount, dev) != hipSuccess) { grid = -1; return; }
        if (hipFuncSetAttribute((const void*)hybrid_fwd, hipFuncAttributeMaxDynamicSharedMemorySize, LDS_BYTES) != hipSuccess) { fprintf(stderr, "kernel_launch: hipFuncSetAttribute failed\n"); grid = -1; return; }
        if (hipOccupancyMaxActiveBlocksPerMultiprocessor(&per_cu, (const void*)hybrid_fwd, NWAVES * 64, LDS_BYTES) != hipSuccess || per_cu < 1) { fprintf(stderr, "kernel_launch: occupancy query reports %d blocks per CU\n", per_cu); (void)hipGetLastError(); grid = -1; return; }
        if (cus != 256) { fprintf(stderr, "kernel_launch: built for a 256-CU device (the unit assignment is written for 256 workgroups); this one has %d CUs; nothing launched\n", cus); grid = -1; return; }
        grid = cus;
    }
    if (grid < 0) return;
    if (hipMemsetAsync((char*)d_ws + WS_CTL, 0, CTL_ZERO_BYTES, stream) != hipSuccess) return;
    Args a{};
    for (int i = 0; i < 16; ++i) a.in[i] = (const float*)d_in[i];
    a.out = (float*)d_out; a.ws = (unsigned char*)d_ws;
    a.ph_lo = 0; a.ph_hi = 9;
    hipLaunchKernelGGL(hybrid_fwd, dim3(grid), dim3(NWAVES * 64), LDS_BYTES, stream, a);
}
```

```cpp
#include <hip/hip_runtime.h>
#include <cstdio>
#include <cstdint>


#define P1_WGM 2
#define GAS __attribute__((address_space(1)))
#define LAS __attribute__((address_space(3)))
typedef unsigned short bf16_t;
typedef short bf16x8 __attribute__((ext_vector_type(8)));
typedef float f32x4 __attribute__((ext_vector_type(4)));
typedef float f32x2 __attribute__((ext_vector_type(2)));
typedef unsigned u32x4 __attribute__((ext_vector_type(4)));
typedef unsigned u32x2 __attribute__((ext_vector_type(2)));

constexpr int SEQ = 8192, D = 1024, M = 2 * SEQ, DEPTH = 2;
constexpr int IN_TOTAL = 7680;
constexpr int NMIX = 4608;
constexpr int PITCH = NMIX + D;
constexpr int XB_COL = NMIX;
constexpr int C_U = 0, C_ZB = 512, C_ZC = 1024, C_V = 1536, C_ZA = 2048, C_XB = 2560, C_BG = 3072, C_CG = 3584, C_XC = 4096;
constexpr int C_S = 1536, C_MERGED = 1536;
constexpr int K3 = 1536;
constexpr float RMS_EPS = 1e-6f, LN_EPS = 1e-5f;

constexpr size_t MiB = 1u << 20;
constexpr size_t WS_CTL = 0, CTL_ZERO_BYTES = 192 * 1024;
constexpr int CW_PANEL = 40960;
constexpr size_t WS_RSS = 1 * MiB;
constexpr size_t WS_LNS = 4 * MiB;
constexpr size_t WS_WMIX = 5 * MiB;
constexpr size_t WS_W3 = 23 * MiB;
constexpr size_t WS_WO = 29 * MiB;
constexpr size_t WS_WM = 33 * MiB;
constexpr size_t WS_WPOOL = WS_WM + 512 * 1024;
constexpr size_t WS_P = 34 * MiB;
constexpr size_t WS_XB8 = WS_P + (size_t)M * PITCH * 2;
constexpr size_t WS_WG8 = WS_XB8 + (size_t)M * D;
constexpr float WG8_SCALE = 64.0f;
constexpr size_t GATE_GROUP_BYTES = 8 * MiB, GATE_PLANE_BYTES = 2 * MiB;
constexpr size_t WS_END = WS_WG8 + (size_t)DEPTH * 3 * D * D;
static_assert(WS_END <= 256 * MiB, "workspace map");

constexpr int NWAVES = 8;
constexpr int RING_BYTES = 131072;
constexpr int WAVE_LDS = 17920;
constexpr int LDSCTL_OFF = 143360, MISC_OFF = LDSCTL_OFF + 320;
constexpr int LDS_BYTES = 147456;

#define RLX_AGENT __ATOMIC_RELAXED, __HIP_MEMORY_SCOPE_AGENT
#define LDS_WAIT() asm volatile("s_waitcnt lgkmcnt(0)" ::: "memory")
#define VM_WAIT() asm volatile("s_waitcnt vmcnt(0)" ::: "memory")

__device__ __forceinline__ unsigned cvt_pk_bf16(float lo, float hi) { unsigned r; asm volatile("v_cvt_pk_bf16_f32 %0, %1, %2" : "=v"(r) : "v"(lo), "v"(hi)); return r; }
__device__ __forceinline__ unsigned pk4_fp8(float a, float b, float c, float d) { int w = 0; w = __builtin_amdgcn_cvt_pk_fp8_f32(a, b, w, false); w = __builtin_amdgcn_cvt_pk_fp8_f32(c, d, w, true); return (unsigned)w; }
__device__ __forceinline__ float bf_lo(unsigned w) { return __builtin_bit_cast(float, w << 16); }
__device__ __forceinline__ float bf_hi(unsigned w) { return __builtin_bit_cast(float, w & 0xffff0000u); }
__device__ __forceinline__ float sigmoid_f(float x) { return __builtin_amdgcn_rcpf(1.0f + __builtin_amdgcn_exp2f(-1.4426950409f * x)); }
__device__ __forceinline__ float silu_f(float x) { return x * sigmoid_f(x); }
__device__ __forceinline__ f32x2 bf2(unsigned w) { return (f32x2){bf_lo(w), bf_hi(w)}; }
__device__ __forceinline__ f32x2 rcp2(f32x2 d) { return (f32x2){__builtin_amdgcn_rcpf(d.x), __builtin_amdgcn_rcpf(d.y)}; }
__device__ __forceinline__ f32x2 exp2_2(f32x2 t) { return (f32x2){__builtin_amdgcn_exp2f(t.x), __builtin_amdgcn_exp2f(t.y)}; }
__device__ __forceinline__ f32x2 silu2(f32x2 x) { return x * rcp2(exp2_2(x * -1.4426950409f) + 1.0f); }
__device__ __forceinline__ f32x2 gelu2(f32x2 x) { const f32x2 t = x * x * (-2.3022081981f * 0.044715f) + (-2.3022081981f); return x * rcp2(exp2_2(x * t) + 1.0f); }
__device__ __forceinline__ float gelu_tanh_f(float x) { return x * __builtin_amdgcn_rcpf(1.0f + __builtin_amdgcn_exp2f(x * __builtin_fmaf(x * x, -2.3022081981f * 0.044715f, -2.3022081981f))); }

namespace pg8 {
constexpr int BM = 256, BK = 64, HALF = 128, HTB = HALF * BK * 2, STAGE_BYTES = 8 * HTB, NXCD = 8, WGM = 8;
__host__ __device__ __forceinline__ int lds_byte(int r, int c) { const int st = (r >> 4) * 2 + (c >> 5), rr = r & 15, cc = c & 31, ob = rr * 64 + cc * 2; return st * 1024 + (ob ^ (((ob >> 9) & 1) << 5)); }
__host__ __device__ __forceinline__ void stage_rc(int b, int& R, int& C) { const int st = b / 1024, sb = b % 1024, swz = sb ^ (((sb >> 9) & 1) << 5); R = (st >> 1) * 16 + swz / 64; C = (st & 1) * 32 + (swz % 64) / 2; }
__host__ __device__ __forceinline__ int perm32(int rho) { const int n = rho >> 4, i = rho & 15; return 8 * (i >> 2) + 4 * n + (i & 3); }

struct Unit { const char* A; const char* B; int nt; int kind; int pm, pn; };

struct TileOrder {
    int nM, nN, nwg, G, c, wgm;
    __device__ void init(int M_, int N_, int G_, int c_, int wgm_ = WGM) { nM = M_ / BM; nN = N_ / BM; nwg = nM * nN; G = G_; c = c_; wgm = wgm_; }
    __device__ bool tile(int i, int& pm, int& pn) const {
        const long L = (long)i * G + c; if (L >= nwg) return false;
        int wgid = (int)L; { const int q = nwg / NXCD, r = nwg % NXCD, xcd = wgid % NXCD, off = wgid / NXCD; wgid = (xcd < r ? xcd * (q + 1) : r * (q + 1) + (xcd - r) * q) + off; }
        const int nig = wgm * nN, gid = wgid / nig, fm = gid * wgm, gsz = (nM - fm) < wgm ? (nM - fm) : wgm;
        pm = fm + ((wgid % nig) % gsz); pn = (wgid % nig) / gsz; return true;
    }
};

typedef int i32x4 __attribute__((ext_vector_type(4)));
typedef int i32x8 __attribute__((ext_vector_type(8)));
__device__ __forceinline__ i32x8 cat16(bf16x8 lo, bf16x8 hi) { const i32x4 a = __builtin_bit_cast(i32x4, lo), b = __builtin_bit_cast(i32x4, hi); return __builtin_shufflevector(a, b, 0, 1, 2, 3, 4, 5, 6, 7); }
template <class Epi, class Sched, bool ALIGN_EPI, bool FP8 = false>
__device__ __forceinline__ void gemm_phase(LAS unsigned char* lds, const unsigned lda2, const unsigned ldb2, const Sched& S, const Epi& E) {
    int tid = threadIdx.x; asm volatile("" : "+v"(tid));
    const int wid = __builtin_amdgcn_readfirstlane(tid >> 6), lane = tid & 63, wr = wid >> 2, wc = wid & 3, fr = lane & 15, fq = lane >> 4;
    unsigned voffA[2], voffB[2];
#pragma unroll
    for (int i = 0; i < 2; ++i) { int R, C; stage_rc(tid * 16 + i * 8192, R, C); const int Rb = (R & ~31) + perm32(R & 31);
        voffA[i] = (unsigned)R * lda2 + (unsigned)C * 2u; voffB[i] = (unsigned)Rb * ldb2 + (unsigned)C * 2u; }
    const size_t kstep = (size_t)(BK * 2);
    const size_t hA = (size_t)HALF * lda2, hB = (size_t)HALF * ldb2;
    const unsigned ldsw = (unsigned)wid * 1024u;
    const int aoff = lds_byte(wr * 64 + fr, fq * 8), boff = lds_byte(wc * 32 + fr, fq * 8);
#define PG8_SA(b, h) (((b) * 2 + (h)) * HTB)
#define PG8_SB(b, h) ((4 + (b) * 2 + (h)) * HTB)
#define PG8_STAGE(bufoff, gbase, voff) do { _Pragma("unroll") for (int _i = 0; _i < 2; ++_i) \
        __builtin_amdgcn_global_load_lds((const unsigned*)((const char*)(gbase) + (voff)[_i]), (LAS unsigned*)(lds + (bufoff) + ldsw + _i * 8192), 16, 0, 0); } while (0)
#define PG8_LDA(dst, b, h) do { _Pragma("unroll") for (int m = 0; m < 4; ++m) { if constexpr (FP8) dst##8[m] = cat16(*(const LAS bf16x8*)(lds + PG8_SA(b, h) + aoff + m * 2048), *(const LAS bf16x8*)(lds + PG8_SA(b, h) + aoff + m * 2048 + 1024)); \
        else { _Pragma("unroll") for (int k = 0; k < 2; ++k) dst[m][k] = *(const LAS bf16x8*)(lds + PG8_SA(b, h) + aoff + m * 2048 + k * 1024); } } } while (0)
#define PG8_LDB(dst, b, h) do { _Pragma("unroll") for (int n = 0; n < 2; ++n) { if constexpr (FP8) dst##8[n] = cat16(*(const LAS bf16x8*)(lds + PG8_SB(b, h) + boff + n * 2048), *(const LAS bf16x8*)(lds + PG8_SB(b, h) + boff + n * 2048 + 1024)); \
        else { _Pragma("unroll") for (int k = 0; k < 2; ++k) dst[n][k] = *(const LAS bf16x8*)(lds + PG8_SB(b, h) + boff + n * 2048 + k * 1024); } } } while (0)
#define PG8_MMA(ai, bj, At, Bt) do { __builtin_amdgcn_s_setprio(1); \
        if constexpr (FP8) { _Pragma("unroll") for (int m = 0; m < 4; ++m) _Pragma("unroll") for (int n = 0; n < 2; ++n) \
            asm volatile("v_mfma_scale_f32_16x16x128_f8f6f4 %0, %1, %2, %0, %3, %3 op_sel_hi:[0,0,0]" : "+v"(acc[ai][bj][m][n]) : "v"(Bt##8[n]), "v"(At##8[m]), "v"(sc8)); \
            asm volatile("s_nop 15\n\ts_nop 7" ::: "memory"); }   \
        else { _Pragma("unroll") for (int m = 0; m < 4; ++m) _Pragma("unroll") for (int n = 0; n < 2; ++n) _Pragma("unroll") for (int k = 0; k < 2; ++k) \
            acc[ai][bj][m][n] = __builtin_amdgcn_mfma_f32_16x16x32_bf16(Bt[n][k], At[m][k], acc[ai][bj][m][n], 0, 0, 0); } \
        __builtin_amdgcn_s_setprio(0); } while (0)
#define PG8_WAIT_V(n) asm volatile("s_waitcnt vmcnt(" #n ")" ::: "memory")
#define PG8_WAIT_L(n) asm volatile("s_waitcnt lgkmcnt(" #n ")" ::: "memory")
#define PG8_BAR __builtin_amdgcn_s_barrier()
#define PG8_SCHED __builtin_amdgcn_sched_barrier(0)
    Unit cur, nxt; int ui = 0;
    if (!S.next(0, cur)) return;
    f32x4 acc[2][2][4][2];
#pragma unroll
    for (int a = 0; a < 2; ++a)
#pragma unroll
        for (int b = 0; b < 2; ++b)
#pragma unroll
            for (int m = 0; m < 4; ++m)
#pragma unroll
                for (int n = 0; n < 2; ++n) acc[a][b][m][n] = (f32x4){0.f, 0.f, 0.f, 0.f};
    bf16x8 At[4][2], B0[2][2], B1[2][2]; i32x8 At8[4], B08[2], B18[2];
    int sc8 = 0x7f7f7f7f; asm volatile("" : "+v"(sc8));
    const char* cA = cur.A; const char* cB = cur.B;
    PG8_STAGE(PG8_SB(0, 0), cB, voffB); PG8_STAGE(PG8_SB(0, 1), cB + hB, voffB); PG8_STAGE(PG8_SA(0, 0), cA, voffA); PG8_STAGE(PG8_SA(0, 1), cA + hA, voffA);
    if (wr == 1) PG8_BAR;
    PG8_WAIT_V(2); PG8_BAR;
    PG8_STAGE(PG8_SB(1, 0), cB + kstep, voffB); PG8_STAGE(PG8_SA(1, 0), cA + kstep, voffA); PG8_STAGE(PG8_SB(1, 1), cB + hB + kstep, voffB);
    PG8_WAIT_V(6); PG8_BAR;
    for (;;) {
        const bool has_next = S.next(ui + 1, nxt);
        const char* nA = has_next ? nxt.A : cA; const char* nB = has_next ? nxt.B : cB;
        const int nt = cur.nt;
#pragma unroll 1
        for (int t = 0; t < nt; t += 2) {
            const bool last = (t == nt - 2);
            const char* a1 = cA + (size_t)(t + 1) * kstep;
            const char* a2 = last ? nA : cA + (size_t)(t + 2) * kstep; const char* b2 = last ? nB : cB + (size_t)(t + 2) * kstep;
            const char* a3 = a2 + kstep; const char* b3 = b2 + kstep;
            PG8_LDB(B0, 0, 0); PG8_LDB(B1, 0, 1); PG8_SCHED; PG8_LDA(At, 0, 0); PG8_STAGE(PG8_SA(1, 1), a1 + hA, voffA);
            PG8_WAIT_V(8); PG8_WAIT_L(0); PG8_BAR; PG8_MMA(0, 0, At, B0); PG8_MMA(0, 1, At, B1); PG8_BAR; PG8_SCHED;
            PG8_LDA(At, 0, 1); PG8_STAGE(PG8_SB(0, 0), b2, voffB); PG8_STAGE(PG8_SB(0, 1), b2 + hB, voffB); PG8_STAGE(PG8_SA(0, 0), a2, voffA);
            PG8_WAIT_V(8); PG8_WAIT_L(0); PG8_BAR; PG8_MMA(1, 0, At, B0); PG8_MMA(1, 1, At, B1); PG8_BAR; PG8_SCHED;
            PG8_LDB(B0, 1, 0); PG8_LDB(B1, 1, 1); PG8_SCHED; PG8_LDA(At, 1, 0); PG8_STAGE(PG8_SA(0, 1), a2 + hA, voffA);
            PG8_WAIT_V(8); PG8_WAIT_L(0); PG8_BAR; PG8_MMA(0, 0, At, B0); PG8_MMA(0, 1, At, B1); PG8_BAR; PG8_SCHED;
            PG8_LDA(At, 1, 1); PG8_STAGE(PG8_SB(1, 0), b3, voffB); PG8_STAGE(PG8_SB(1, 1), b3 + hB, voffB); PG8_STAGE(PG8_SA(1, 0), a3, voffA);
            PG8_WAIT_V(8); PG8_WAIT_L(0); PG8_BAR; PG8_MMA(1, 0, At, B0); PG8_MMA(1, 1, At, B1); PG8_BAR; PG8_SCHED;
        }
        if constexpr (ALIGN_EPI) { if (wr == 0) PG8_BAR; }
        E(acc, cur, wr, wc, fr, fq);
        if (!has_next) break;
        cur = nxt; cA = nA; cB = nB; ++ui;
        if constexpr (ALIGN_EPI) { if (wr == 1) PG8_BAR; }
    }
    PG8_WAIT_V(0);
    if constexpr (!ALIGN_EPI) { if (wr == 0) PG8_BAR; }
    PG8_BAR;
#undef PG8_SA
#undef PG8_SB
#undef PG8_STAGE
#undef PG8_LDA
#undef PG8_LDB
#undef PG8_MMA
#undef PG8_WAIT_V
#undef PG8_WAIT_L
#undef PG8_BAR
#undef PG8_SCHED
}
}

#define XB_TMO      128
#define XB_XCNT(j)  (256  + 64 * (j))
#define XB_XSUB(j)  (1280 + 64 * (j))
#define XB_XGEN(j)  (2304 + 64 * (j))
#define XB_TOP      3328
#define XB_TOPGEN   3392
#define XCD_BAR_WORDS 3456
#define XB_SPIN_CAP (1u << 18)
__device__ __forceinline__ unsigned xb_ld(unsigned* p)              { return __hip_atomic_load(p, __ATOMIC_RELAXED, __HIP_MEMORY_SCOPE_AGENT); }
__device__ __forceinline__ unsigned xb_add(unsigned* p, unsigned v) { return __hip_atomic_fetch_add(p, v, __ATOMIC_RELAXED, __HIP_MEMORY_SCOPE_AGENT); }
__device__ __forceinline__ unsigned xb_xcc_id() { return (unsigned)__builtin_amdgcn_s_getreg((3 << 11) | 20) & 0xFu; }
#define XB_SPIN(cond, bar) do { unsigned _sp = 0; while (cond) { __builtin_amdgcn_s_sleep(1); \
    if ((++_sp & 255u) == 0u) { if (xb_ld(&(bar)[XB_TMO])) break; if (_sp > XB_SPIN_CAP) { atomicAdd(&(bar)[XB_TMO], 1u); break; } } } } while (0)
struct XcdBarrier { unsigned* bar; unsigned x; volatile LAS unsigned* st; unsigned G; };
__device__ __forceinline__ XcdBarrier xcd_barrier_post(unsigned* bar, volatile LAS unsigned* st, unsigned G) {
    XcdBarrier b; b.bar = bar; b.x = xb_xcc_id(); b.st = st; b.G = G;
    if (threadIdx.x == 0) (void)xb_add(&bar[XB_XCNT(b.x)], 1u);
    return b;
}
__device__ __forceinline__ void xcd_barrier_complete(unsigned* bar, unsigned x, unsigned G, unsigned& nloc, unsigned& nx) {
    unsigned sum, cnt, mine, sp = 0u;
    for (;;) {
        sum = 0u; cnt = 0u; mine = 0u;
#pragma unroll
        for (unsigned j = 0; j < 16; ++j) { const unsigned c = xb_ld(&bar[XB_XCNT(j)]); sum += c; cnt += (c > 0u) ? 1u : 0u; mine = (j == x) ? c : mine; }
        if (sum == G) break;
        __builtin_amdgcn_s_sleep(1);
        if ((++sp & 255u) == 0u) { if (xb_ld(&bar[XB_TMO])) break; if (sp > XB_SPIN_CAP) { atomicAdd(&bar[XB_TMO], 1u); break; } }
    }
    nloc = mine > 0u ? mine : 1u; nx = cnt > 0u ? cnt : 1u;
}
__device__ __forceinline__ void xcd_barrier(const XcdBarrier& b, unsigned* wait_word = nullptr, unsigned wait_target = 0u, unsigned* prog_word = nullptr, bool local_ok = false) {
    asm volatile("s_waitcnt vmcnt(0)" ::: "memory");
    __syncthreads();
    if (threadIdx.x == 0) {
        unsigned* bar = b.bar;
        __builtin_amdgcn_s_waitcnt(0);
        asm volatile("buffer_inv sc1" ::: "memory");
        unsigned nloc = b.st[0], nx = b.st[1];
        if (nloc == 0u) { xcd_barrier_complete(bar, b.x, b.G, nloc, nx); b.st[0] = nloc; b.st[1] = nx; }
        const unsigned old = xb_add(&bar[XB_XSUB(b.x)], 1u);
        const unsigned gen = old / nloc;
        if (old + 1u == (gen + 1u) * nloc) {
            if (!(local_ok && nx == 1u)) { __builtin_amdgcn_fence(__ATOMIC_RELEASE, "agent"); asm volatile("s_waitcnt vmcnt(0)" ::: "memory"); }
            (void)xb_add(&bar[XB_TOP], 1u);
        }
        const unsigned tgt = (gen + 1u) * nx;
        if (wait_word) XB_SPIN(xb_ld(wait_word) < wait_target, bar);
        XB_SPIN(xb_ld(&bar[XB_TOP]) < tgt, bar);
        if (prog_word) (void)xb_add(prog_word, 1u);
        asm volatile("s_waitcnt vmcnt(0)" ::: "memory");
    }
    __syncthreads();
}

struct Args { const float* in[16]; float* out; unsigned char* ws; int ph_lo, ph_hi; };

__device__ __forceinline__ float wave_sum(float v) {
#pragma unroll
    for (int o = 1; o < 64; o <<= 1) v += __shfl_xor(v, o);
    return v;
}

__device__ __forceinline__ void p0_transpose_item(const float* W, int ldw, int k0, int n0, const float* gs, bf16_t* dst, int ldd, LAS float* scr, int lane) {
    float v[32];
    const float* wp = W + (size_t)(k0 + (lane >> 5)) * ldw + n0 + (lane & 31);
#pragma unroll
    for (int i = 0; i < 32; ++i) v[i] = wp[(size_t)(2 * i) * ldw];
    if (gs) {
#pragma unroll
        for (int i = 0; i < 32; ++i) v[i] *= gs[k0 + 2 * i + (lane >> 5)]; }
#pragma unroll
    for (int i = 0; i < 32; ++i) scr[(2 * i + (lane >> 5)) * 33 + (lane & 31)] = v[i];
    LDS_WAIT(); asm volatile("" ::: "memory");
    const int c = lane & 7;
#pragma unroll
    for (int j = 0; j < 4; ++j) { const int n = (lane >> 3) + 8 * j; const LAS float* s = scr + (8 * c) * 33 + n;
        u32x4 o; o.x = cvt_pk_bf16(s[0 * 33], s[1 * 33]); o.y = cvt_pk_bf16(s[2 * 33], s[3 * 33]); o.z = cvt_pk_bf16(s[4 * 33], s[5 * 33]); o.w = cvt_pk_bf16(s[6 * 33], s[7 * 33]);
        *(u32x4*)(dst + (size_t)n * ldd + 8 * c) = o; }
    LDS_WAIT(); asm volatile("" ::: "memory");
}

__device__ __forceinline__ void p0_transpose_item_fp8(const float* W, int ldw, int k0, int n0, const float* gs, float sc, unsigned char* dst, int ldd, LAS float* scr, int lane) {
    float v[32];
    const float* wp = W + (size_t)(k0 + (lane >> 5)) * ldw + n0 + (lane & 31);
#pragma unroll
    for (int i = 0; i < 32; ++i) v[i] = wp[(size_t)(2 * i) * ldw];
#pragma unroll
    for (int i = 0; i < 32; ++i) v[i] *= gs[k0 + 2 * i + (lane >> 5)] * sc;
#pragma unroll
    for (int i = 0; i < 32; ++i) scr[(2 * i + (lane >> 5)) * 33 + (lane & 31)] = v[i];
    LDS_WAIT(); asm volatile("" ::: "memory");
    const int n = lane >> 1, h = lane & 1; const LAS float* s = scr + (32 * h) * 33 + n;
    u32x4 o0, o1;
#pragma unroll
    for (int q = 0; q < 4; ++q) { o0[q] = pk4_fp8(s[(4 * q) * 33], s[(4 * q + 1) * 33], s[(4 * q + 2) * 33], s[(4 * q + 3) * 33]);
                                  o1[q] = pk4_fp8(s[(16 + 4 * q) * 33], s[(17 + 4 * q) * 33], s[(18 + 4 * q) * 33], s[(19 + 4 * q) * 33]); }
    unsigned char* d = dst + (size_t)n * ldd + 32 * h;
    *(u32x4*)d = o0; *(u32x4*)(d + 16) = o1;
    LDS_WAIT(); asm volatile("" ::: "memory");
}

__device__ __forceinline__ void p0_prologue(const Args& a, LAS unsigned char* lds, int gw, int NGW, int wave, int lane) {
    unsigned char* ws = a.ws;
    LAS float* scr = (LAS float*)(lds + wave * WAVE_LDS);
    constexpr int I_IN = (D / 64) * (IN_TOTAL / 32);
    constexpr int I_P = (512 / 64) * (D / 32);
    constexpr int I_O = (D / 64) * (D / 32);
    constexpr int I_LAYER = I_IN + 3 * I_P + I_O;
    for (int it = gw; it < DEPTH * I_LAYER; it += NGW) {
        const int l = it / I_LAYER; int r = it % I_LAYER;
        bf16_t* Wmix = (bf16_t*)(ws + WS_WMIX) + (size_t)l * NMIX * D;
        bf16_t* W3 = (bf16_t*)(ws + WS_W3) + (size_t)l * D * K3;
        bf16_t* WoT = (bf16_t*)(ws + WS_WO) + (size_t)l * D * D;
        if (r < I_IN) {
            const int kb = r / (IN_TOTAL / 32), nb = r % (IN_TOTAL / 32), k0 = 64 * kb, n0 = 32 * nb, seg = n0 / 512;
            const float* W = a.in[2] + (size_t)l * D * IN_TOTAL; const float* gs = a.in[1] + l * D;
            if (seg < 9) { const int dseg = (seg == 0) ? 0 : (seg == 1) ? 3 : (seg == 2) ? 4 : (seg == 3) ? 5 : (seg == 4) ? 6 : (seg == 5) ? 7 : (seg == 6) ? 1 : (seg == 7) ? 8 : 2;
                p0_transpose_item(W, IN_TOTAL, k0, n0, gs, Wmix + (size_t)(dseg * 512 + (n0 & 511)) * D + k0, D, scr, lane); }
            else { const int nn = n0 - NMIX;
                p0_transpose_item_fp8(W, IN_TOTAL, k0, n0, gs, WG8_SCALE, ws + WS_WG8 + (size_t)l * 3 * D * D + (size_t)nn * D + k0, D, scr, lane); }
            continue; }
        r -= I_IN;
        if (r < 3 * I_P) { const int br = r / I_P, q = r % I_P, kb = q / (D / 32), nb = q % (D / 32), k0 = 64 * kb, n0 = 32 * nb;
            const float* W = a.in[11 + br] + (size_t)l * 512 * D;
            p0_transpose_item(W, D, k0, n0, nullptr, W3 + (size_t)n0 * K3 + br * 512 + k0, K3, scr, lane); continue; }
        r -= 3 * I_P;
        { const int kb = r / (D / 32), nb = r % (D / 32), k0 = 64 * kb, n0 = 32 * nb;
          const float* W = a.in[14] + (size_t)l * D * D;
          p0_transpose_item(W, D, k0, n0, nullptr, WoT + (size_t)n0 * D + k0, D, scr, lane); }
    }
    { bf16_t* Wm = (bf16_t*)(ws + WS_WM); const float* w_s = a.in[5];
      for (int i = gw * 64 + lane; i < DEPTH * 8 * 128 * 128 / 2; i += NGW * 64) { const int e = 2 * i, s = e & 127, t = (e >> 7) & 127;
          const f32x2 v = *(const f32x2*)(w_s + e); ((unsigned*)Wm)[i] = cvt_pk_bf16(s <= t ? v.x : 0.f, s + 1 <= t ? v.y : 0.f); } }
    { bf16_t* Wp = (bf16_t*)(ws + WS_WPOOL); const float* w_pool = a.in[9]; const float* ps = a.in[10];
      for (int i = gw * 64 + lane; i < DEPTH * 4 * 128 * 128 / 2; i += NGW * 64) { const int e = 2 * i, c = e & 127, d = (e >> 7) & 127, lg = e >> 14;
          const float sc = ps[lg * 128 + d];
          ((unsigned*)Wp)[i] = cvt_pk_bf16(w_pool[(size_t)lg * 16384 + c * 128 + d] * sc, w_pool[(size_t)lg * 16384 + (c + 1) * 128 + d] * sc); } }
    { bf16_t* P = (bf16_t*)(ws + WS_P); float* rss = (float*)(ws + WS_RSS);
      for (int m4 = gw * 4; m4 < M; m4 += NGW * 4) {
          f32x4 v[4][4];
#pragma unroll
          for (int r = 0; r < 4; ++r) { const f32x4* xr = (const f32x4*)(a.in[0] + (size_t)(m4 + r) * D) + lane;
#pragma unroll
              for (int j = 0; j < 4; ++j) v[r][j] = xr[64 * j]; }
#pragma unroll
          for (int r = 0; r < 4; ++r) { float s = 0.f;
#pragma unroll
              for (int j = 0; j < 4; ++j) s += (v[r][j].x * v[r][j].x + v[r][j].y * v[r][j].y) + (v[r][j].z * v[r][j].z + v[r][j].w * v[r][j].w);
              s = wave_sum(s);
              u32x2* o = (u32x2*)(P + (size_t)(m4 + r) * PITCH + XB_COL) + lane;
#pragma unroll
              for (int j = 0; j < 4; ++j) { u32x2 w; w.x = cvt_pk_bf16(v[r][j].x, v[r][j].y); w.y = cvt_pk_bf16(v[r][j].z, v[r][j].w); o[64 * j] = w; }
              unsigned* o8 = (unsigned*)(ws + WS_XB8 + (size_t)(m4 + r) * D) + lane;
#pragma unroll
              for (int j = 0; j < 4; ++j) o8[64 * j] = pk4_fp8(v[r][j].x, v[r][j].y, v[r][j].z, v[r][j].w);
              if (lane < 16) rss[(size_t)(m4 + r) * 16 + lane] = (lane == 0) ? s : 0.f; }
      } }
}

__device__ __forceinline__ float row_rstd(const float* rss, int row, int fq) {
    const f32x4 p = *(const f32x4*)(rss + (size_t)row * 16 + fq * 4);
    float s = (p.x + p.y) + (p.z + p.w); s += __shfl_xor(s, 16); s += __shfl_xor(s, 32);
    return __builtin_amdgcn_rsqf(s * (1.0f / D) + RMS_EPS);
}
__device__ __forceinline__ float rstd_of(f32x4 p) { float s = (p.x + p.y) + (p.z + p.w); s += __shfl_xor(s, 16); s += __shfl_xor(s, 32); return __builtin_amdgcn_rsqf(s * (1.0f / D) + RMS_EPS); }
#define ZERO_ACC(acc) do { _Pragma("unroll") for (int _a = 0; _a < 2; ++_a) _Pragma("unroll") for (int _b = 0; _b < 2; ++_b) _Pragma("unroll") for (int _m = 0; _m < 4; ++_m) _Pragma("unroll") for (int _n = 0; _n < 2; ++_n) acc[_a][_b][_m][_n] = (f32x4){0.f, 0.f, 0.f, 0.f}; } while (0)

struct SchedP1 {
    pg8::TileOrder T; const char* P; const char* W;
    __device__ __forceinline__ bool next(int i, pg8::Unit& u) const { int pm, pn; if (!T.tile(i, pm, pn)) return false;
        u.pm = pm; u.pn = pn; u.kind = pn >> 1; u.nt = D / 64; u.A = P + ((size_t)pm * 256 * PITCH + XB_COL) * 2; u.B = W + (size_t)pn * 256 * D * 2; return true; }
};
struct EpiP1 {
    bf16_t* P; const float* rss; float* lns;
    __device__ __forceinline__ void operator()(f32x4 (&acc)[2][2][4][2], const pg8::Unit& u, int wr, int wc, int fr, int fq) const {
        const int seg = u.kind;
        const int act = (seg == 3) ? 1 : 0;
        unsigned lrow = (unsigned)(wr * 64 + fr); asm volatile("" : "+v"(lrow));
        const unsigned lp = (lrow * PITCH + (unsigned)(wc * 32) + 8u * (unsigned)fq) * 2u;
        const unsigned lr = lrow * 64u;
        const size_t up = (size_t)u.pm * 256 * PITCH + (size_t)u.pn * 256;
        const size_t ur = (size_t)u.pm * 256 * 16;
        f32x4 pr[2][4];
#pragma unroll
        for (int ai = 0; ai < 2; ++ai)
#pragma unroll
            for (int m = 0; m < 4; ++m) pr[ai][m] = *(const f32x4*)((const char*)(rss + ur + (ai * 128 + m * 16) * 16) + (lr + 16u * fq));
#pragma unroll
        for (int ai = 0; ai < 2; ++ai)
#pragma unroll
            for (int m = 0; m < 4; ++m) {
                const float rs = rstd_of(pr[ai][m]);
                float s1 = 0.f, s2 = 0.f;
#pragma unroll
                for (int bj = 0; bj < 2; ++bj) {
                    f32x4 v0 = acc[ai][bj][m][0] * rs, v1 = acc[ai][bj][m][1] * rs;
                    if (act == 1) {
#pragma unroll
                        for (int j = 0; j < 2; ++j) { const f32x2 g0 = gelu2((f32x2){v0[2 * j], v0[2 * j + 1]}), g1 = gelu2((f32x2){v1[2 * j], v1[2 * j + 1]});
                            v0[2 * j] = g0.x; v0[2 * j + 1] = g0.y; v1[2 * j] = g1.x; v1[2 * j + 1] = g1.y; } }
                    u32x4 w; w.x = cvt_pk_bf16(v0[0], v0[1]); w.y = cvt_pk_bf16(v0[2], v0[3]); w.z = cvt_pk_bf16(v1[0], v1[1]); w.w = cvt_pk_bf16(v1[2], v1[3]);
                    *(u32x4*)((char*)(P + up + (size_t)(ai * 128 + m * 16) * PITCH + bj * 128) + lp) = w;
                    if (seg == 3) {
#pragma unroll
                        for (int q = 0; q < 4; ++q) { const float lo = bf_lo(w[q]), hi = bf_hi(w[q]); s1 += lo + hi; s2 += lo * lo + hi * hi; } }
                }
                if (seg == 3) { s1 += __shfl_xor(s1, 16); s1 += __shfl_xor(s1, 32); s2 += __shfl_xor(s2, 16); s2 += __shfl_xor(s2, 32);
                    if (fq == 0) *(f32x2*)((char*)(lns + ur + (ai * 128 + m * 16) * 16 + ((u.pn - 6) * 4 + wc) * 2) + lr) = (f32x2){s1, s2}; }
            }
        ZERO_ACC(acc);
    }
};

struct SchedG {
    int x, r, n, c0, sq; const char* A8; const char* W8;
    __device__ __forceinline__ bool next(int i, pg8::Unit& u) const { if (i >= n) return false;
        int combo, pl;
        if (i < sq) { pl = 4 * i + (r & 3); combo = c0 + (r >> 2); } else { pl = r & 7; combo = c0 + (sq ? 4 : 0) + 2 * (i - sq) + (r >> 3); }
        const int gate = combo >> 2;
        u.pm = 8 * x + pl; u.pn = combo & 3; u.kind = gate; u.nt = D / 128;
        u.A = A8 + (size_t)u.pm * 256 * D; u.B = W8 + ((size_t)gate * D + (size_t)u.pn * 256) * D; return true; }
};
struct EpiP3G {
    unsigned char* S8; size_t gstride; unsigned rowb; const float* rss;
    __device__ __forceinline__ void operator()(f32x4 (&acc)[2][2][4][2], const pg8::Unit& u, int wr, int wc, int fr, int fq) const {
        unsigned lrow = (unsigned)(wr * 64 + fr); asm volatile("" : "+v"(lrow));
        const unsigned ls = lrow * rowb + (unsigned)(wc * 32) + 8u * (unsigned)fq;
        const unsigned lr = lrow * 64u;
        unsigned char* sb = S8 + (size_t)(u.pm >> 3) * GATE_GROUP_BYTES + (size_t)u.kind * gstride + (size_t)(u.pm & 7) * 256 * rowb + (size_t)u.pn * 256;
        const size_t ur = (size_t)u.pm * 256 * 16;
        f32x4 pr[2][4];
#pragma unroll
        for (int ai = 0; ai < 2; ++ai)
#pragma unroll
            for (int m = 0; m < 4; ++m) pr[ai][m] = *(const f32x4*)((const char*)(rss + ur + (ai * 128 + m * 16) * 16) + (lr + 16u * fq));
#pragma unroll
        for (int ai = 0; ai < 2; ++ai)
#pragma unroll
            for (int m = 0; m < 4; ++m) {
                const float rs = rstd_of(pr[ai][m]) * (-1.4426950409f / WG8_SCALE);
#pragma unroll
                for (int bj = 0; bj < 2; ++bj) { const f32x4 v0 = acc[ai][bj][m][0] * rs, v1 = acc[ai][bj][m][1] * rs;
                    unsigned w0 = 0u, w1 = 0u;
#pragma unroll
                    for (int j = 0; j < 4; ++j) { w0 = __builtin_amdgcn_cvt_pk_u8_f32(__builtin_amdgcn_rcpf(__builtin_fmaf(__builtin_amdgcn_exp2f(v0[j]), 1.0f / 255.0f, 1.0f / 255.0f)), j, w0);
                                                  w1 = __builtin_amdgcn_cvt_pk_u8_f32(__builtin_amdgcn_rcpf(__builtin_fmaf(__builtin_amdgcn_exp2f(v1[j]), 1.0f / 255.0f, 1.0f / 255.0f)), j, w1); }
                    w0 |= (((w0 - 0x01010101u) & ~w0) >> 7) & 0x01010101u; w1 |= (((w1 - 0x01010101u) & ~w1) >> 7) & 0x01010101u;
                    *(u32x2*)(sb + (size_t)(ai * 128 + m * 16) * rowb + bj * 128 + ls) = (u32x2){w0, w1}; }
            }
        ZERO_ACC(acc);
    }
};
struct SchedP3Y {
    int pm, pn; const char* P; const char* W;
    __device__ __forceinline__ bool next(int i, pg8::Unit& u) const { if (i >= 3) return false;
        u.pm = pm; u.pn = pn; u.kind = i; u.nt = 512 / 64;
        u.A = P + ((size_t)pm * 256 * PITCH + (size_t)i * 512) * 2; u.B = W + ((size_t)pn * 256 * K3 + (size_t)i * 512) * 2; return true; }
};
struct EpiP3Y {
    bf16_t* P; const unsigned char* S8; size_t gstride; unsigned rowb;
    __device__ __forceinline__ void operator()(f32x4 (&acc)[2][2][4][2], const pg8::Unit& u, int wr, int wc, int fr, int fq) const {
        const int j = u.kind; const bool fin = (j == 2);
        unsigned lrow = (unsigned)(wr * 64 + fr); asm volatile("" : "+v"(lrow));
        const unsigned ls = lrow * rowb + (unsigned)(wc * 32) + 8u * (unsigned)fq;
        const unsigned lp = (lrow * PITCH + (unsigned)(wc * 32) + 8u * (unsigned)fq) * 2u;
        const unsigned char* sb = S8 + (size_t)(u.pm >> 3) * GATE_GROUP_BYTES + (size_t)(u.pm & 7) * 256 * rowb + (size_t)u.pn * 256;
        const unsigned char* pn_ = sb + (size_t)j * gstride; const unsigned char* pd_ = sb + (size_t)(fin ? 2 : j + 1) * gstride;
        bf16_t* pmg = P + (size_t)u.pm * 256 * PITCH + C_MERGED + (size_t)u.pn * 256;
#pragma unroll
        for (int ai = 0; ai < 2; ++ai)
#pragma unroll
        for (int mh = 0; mh < 2; ++mh) {
            u32x2 sn[2][2], sd[2][2];
#pragma unroll
            for (int mm = 0; mm < 2; ++mm)
#pragma unroll
                for (int bj = 0; bj < 2; ++bj) { const size_t ro = (size_t)(ai * 128 + (mh * 2 + mm) * 16) * rowb + bj * 128;
                    sn[mm][bj] = *(const u32x2*)(pn_ + ro + ls); sd[mm][bj] = *(const u32x2*)(pd_ + ro + ls); }
#pragma unroll
            for (int mm = 0; mm < 2; ++mm)
#pragma unroll
                for (int bj = 0; bj < 2; ++bj) { const int m = mh * 2 + mm;
#pragma unroll
                    for (int n = 0; n < 2; ++n) { const unsigned sdw = fin ? 0xffffffffu : sd[mm][bj][n];
#pragma unroll
                        for (int e = 0; e < 4; ++e) { const float qn = (float)((sn[mm][bj][n] >> (8 * e)) & 0xffu), qd = (float)((sdw >> (8 * e)) & 0xffu);
                            acc[ai][bj][m][n][e] *= qn * __builtin_amdgcn_rcpf(qd); } }
                    if (fin) { const f32x4 v0 = acc[ai][bj][m][0], v1 = acc[ai][bj][m][1];
                        u32x4 w; w.x = cvt_pk_bf16(v0[0], v0[1]); w.y = cvt_pk_bf16(v0[2], v0[3]); w.z = cvt_pk_bf16(v1[0], v1[1]); w.w = cvt_pk_bf16(v1[2], v1[3]);
                        *(u32x4*)((char*)(pmg + (size_t)(ai * 128 + m * 16) * PITCH + bj * 128) + lp) = w; } }
        }
    }
};

struct SchedP4 {
    pg8::TileOrder T; const char* P; const char* W;
    __device__ __forceinline__ bool next(int i, pg8::Unit& u) const { int pm, pn; if (!T.tile(i, pm, pn)) return false;
        u.pm = pm; u.pn = pn; u.kind = 0; u.nt = D / 64; u.A = P + ((size_t)pm * 256 * PITCH + C_MERGED) * 2; u.B = W + (size_t)pn * 256 * D * 2; return true; }
};
struct EpiP4 {
    bf16_t* P; float* rss_out; unsigned char* xb8;
    __device__ __forceinline__ void operator()(f32x4 (&acc)[2][2][4][2], const pg8::Unit& u, int wr, int wc, int fr, int fq) const {
        unsigned lrow = (unsigned)(wr * 64 + fr); asm volatile("" : "+v"(lrow));
        const unsigned lc = (unsigned)(wc * 32) + 8u * (unsigned)fq;
        const unsigned lp = (lrow * PITCH + lc) * 2u, lx = (lrow * D + lc) * 4u, l8 = lrow * D + lc;
        const size_t ux = (size_t)u.pm * 256 * D + (size_t)u.pn * 256;
        bf16_t* pb = P + (size_t)u.pm * 256 * PITCH + (size_t)u.pn * 256 + XB_COL;
        float* rb = rss_out + (size_t)u.pm * 256 * 16 + u.pn * 4 + wc;
#pragma unroll
        for (int ai = 0; ai < 2; ++ai)
#pragma unroll
        for (int mh = 0; mh < 2; ++mh) {
            u32x4 hv[2][2];
#pragma unroll
            for (int mm = 0; mm < 2; ++mm)
#pragma unroll
                for (int bj = 0; bj < 2; ++bj) hv[mm][bj] = *(const u32x4*)((const char*)(pb + (size_t)(ai * 128 + (mh * 2 + mm) * 16) * PITCH + bj * 128) + lp);
#pragma unroll
            for (int mm = 0; mm < 2; ++mm) {
                const int m = mh * 2 + mm; float ss = 0.f;
#pragma unroll
                for (int bj = 0; bj < 2; ++bj) { const size_t ro = (size_t)(ai * 128 + m * 16) * D + bj * 128;
                    const f32x4 v0 = (f32x4){bf_lo(hv[mm][bj].x), bf_hi(hv[mm][bj].x), bf_lo(hv[mm][bj].y), bf_hi(hv[mm][bj].y)} + acc[ai][bj][m][0], v1 = (f32x4){bf_lo(hv[mm][bj].z), bf_hi(hv[mm][bj].z), bf_lo(hv[mm][bj].w), bf_hi(hv[mm][bj].w)} + acc[ai][bj][m][1];
                    ss += (v0[0] * v0[0] + v0[1] * v0[1]) + (v0[2] * v0[2] + v0[3] * v0[3]) + (v1[0] * v1[0] + v1[1] * v1[1]) + (v1[2] * v1[2] + v1[3] * v1[3]);
                    u32x4 w; w.x = cvt_pk_bf16(v0[0], v0[1]); w.y = cvt_pk_bf16(v0[2], v0[3]); w.z = cvt_pk_bf16(v1[0], v1[1]); w.w = cvt_pk_bf16(v1[2], v1[3]);
                    *(u32x4*)((char*)(pb + (size_t)(ai * 128 + m * 16) * PITCH + bj * 128) + lp) = w;
                    *(u32x2*)((xb8 + ux + ro) + l8) = (u32x2){pk4_fp8(v0[0], v0[1], v0[2], v0[3]), pk4_fp8(v1[0], v1[1], v1[2], v1[3])};
 }
                ss += __shfl_xor(ss, 16); ss += __shfl_xor(ss, 32);
                if (fq == 0) *(float*)((char*)(rb + (ai * 128 + m * 16) * 16) + lrow * 64u) = ss;
            }
        }
        ZERO_ACC(acc);
    }
};

struct EpiP4F {

    const bf16_t* P; float* out; float* rss_out; const float* fg; unsigned* cnt; unsigned* tmo;
    __device__ __forceinline__ void operator()(f32x4 (&acc)[2][2][4][2], const pg8::Unit& u, int wr, int wc, int fr, int fq) const {
        unsigned lrow = (unsigned)(wr * 64 + fr); asm volatile("" : "+v"(lrow));
        const unsigned lc = (unsigned)(wc * 32) + 8u * (unsigned)fq;
        const unsigned lx = (lrow * D + lc) * 4u;
        const unsigned lp = (lrow * PITCH + lc) * 2u, l8 = lrow * D + lc;
        const bf16_t* pxb = P + (size_t)u.pm * 256 * PITCH + (size_t)u.pn * 256 + XB_COL;
        const size_t ux = (size_t)u.pm * 256 * D + (size_t)u.pn * 256;
        float* rb = rss_out + (size_t)u.pm * 256 * 16 + u.pn * 4 + wc;
#pragma unroll
        for (int ai = 0; ai < 2; ++ai)
#pragma unroll
        for (int mh = 0; mh < 2; ++mh) {
            f32x4 xo[2][2][2]; u32x4 hv[2][2];
#pragma unroll
            for (int mm = 0; mm < 2; ++mm)
#pragma unroll
                for (int bj = 0; bj < 2; ++bj) hv[mm][bj] = *(const u32x4*)((const char*)(pxb + (size_t)(ai * 128 + (mh * 2 + mm) * 16) * PITCH + bj * 128) + lp);
#pragma unroll
            for (int mm = 0; mm < 2; ++mm)
#pragma unroll
                for (int bj = 0; bj < 2; ++bj)
#pragma unroll
                    for (int n = 0; n < 2; ++n) xo[mm][bj][n] = (f32x4){bf_lo(hv[mm][bj][2 * n]), bf_hi(hv[mm][bj][2 * n]), bf_lo(hv[mm][bj][2 * n + 1]), bf_hi(hv[mm][bj][2 * n + 1])};
#pragma unroll
            for (int mm = 0; mm < 2; ++mm) {
                const int m = mh * 2 + mm; float ss = 0.f;
#pragma unroll
                for (int bj = 0; bj < 2; ++bj) { const f32x4 v0 = xo[mm][bj][0] + acc[ai][bj][m][0], v1 = xo[mm][bj][1] + acc[ai][bj][m][1];
                    acc[ai][bj][m][0] = v0; acc[ai][bj][m][1] = v1;
                    ss += (v0[0] * v0[0] + v0[1] * v0[1]) + (v0[2] * v0[2] + v0[3] * v0[3]) + (v1[0] * v1[0] + v1[1] * v1[1]) + (v1[2] * v1[2] + v1[3] * v1[3]); }
                ss += __shfl_xor(ss, 16); ss += __shfl_xor(ss, 32);
                if (fq == 0) __hip_atomic_store((float*)((char*)(rb + (ai * 128 + m * 16) * 16) + lrow * 64u), ss, __ATOMIC_RELAXED, __HIP_MEMORY_SCOPE_AGENT);
            }
        }
        asm volatile("s_waitcnt vmcnt(0)" ::: "memory");
        const int lane = (int)(threadIdx.x & 63); const int wid = wr * 4 + wc;
        unsigned* pc = cnt + 64 * u.pm;
        if (lane == 0) __hip_atomic_fetch_add(pc, 1u, __ATOMIC_RELAXED, __HIP_MEMORY_SCOPE_AGENT);
        if (wid == 0) {
            asm volatile("buffer_inv sc1" ::: "memory");
            unsigned sp = 0;
            while ((unsigned)__builtin_amdgcn_readfirstlane(__hip_atomic_load(pc, __ATOMIC_RELAXED, __HIP_MEMORY_SCOPE_AGENT)) < 32u) {
                __builtin_amdgcn_s_sleep(1);
                if ((++sp & 255u) == 0u) { if (__hip_atomic_load(tmo, __ATOMIC_RELAXED, __HIP_MEMORY_SCOPE_AGENT)) break; if (sp > (1u << 20)) { if (lane == 0) atomicAdd(tmo, 1u); break; } } }
            asm volatile("s_waitcnt vmcnt(0)" ::: "memory");
        }
        asm volatile("" ::: "memory"); __builtin_amdgcn_s_barrier(); asm volatile("" ::: "memory");
        const unsigned lr = lrow * 64u;
        const size_t ur = (size_t)u.pm * 256 * 16;
        f32x4 pr[2][4];
#pragma unroll
        for (int ai = 0; ai < 2; ++ai)
#pragma unroll
            for (int m = 0; m < 4; ++m) pr[ai][m] = *(const f32x4*)((const char*)(rss_out + ur + (ai * 128 + m * 16) * 16) + (lr + 16u * fq));
        f32x4 gv[2][2];
#pragma unroll
        for (int bj = 0; bj < 2; ++bj) { const float* gp = (const float*)((const char*)(fg + u.pn * 256 + bj * 128) + lc * 4u); gv[bj][0] = *(const f32x4*)gp; gv[bj][1] = *(const f32x4*)(gp + 4); }
#pragma unroll
        for (int ai = 0; ai < 2; ++ai)
#pragma unroll
            for (int m = 0; m < 4; ++m) { const float rs = rstd_of(pr[ai][m]);
#pragma unroll
                for (int bj = 0; bj < 2; ++bj) { float* xq = (float*)((char*)(out + ux + (size_t)(ai * 128 + m * 16) * D + bj * 128) + lx);
                    *(f32x4*)xq = acc[ai][bj][m][0] * rs * gv[bj][0]; *(f32x4*)(xq + 4) = acc[ai][bj][m][1] * rs * gv[bj][1]; } }
        ZERO_ACC(acc);
    }
};

#define LDG(T, uptr, lboff) (*(const T*)((const char*)(uptr) + (lboff)))
#define STG(T, uptr, lboff, val) (*(T*)((char*)(uptr) + (lboff)) = (val))
typedef short s16x4 __attribute__((ext_vector_type(4)));
__device__ __forceinline__ s16x4 lds_tr16(const LAS void* p) { return __builtin_amdgcn_ds_read_tr16_b64_v4i16((LAS s16x4*)p); }
template <int TH> __device__ __forceinline__ void mixer_a_body(bf16_t* P, const float* lns, const bf16_t* Wm, const float* ln_g, const float* ln_b, const float* b_s, LAS unsigned char* wl, int n, int g, int lane) {
    constexpr int SLEN = 64 * (TH + 1), NV = SLEN / 8, NKS = 2 * (TH + 1);
    const int T0 = n * 128;
    constexpr int VB = 136;
    constexpr int OB = 272;
    const int ck = lane & 7, rsub = lane >> 3;
    const int fr = lane & 15, fq = lane >> 4;
    const unsigned lv = (unsigned)(rsub * PITCH + ck * 8) * 2u;
    const unsigned lw = (unsigned)(fr * 128 + fq * 8) * 2u;
    const bf16_t* pv = P + (size_t)T0 * PITCH + C_V + g * 64;
    u32x4 raw[NV];
#pragma unroll
    for (int q = 0; q < NV; ++q) raw[q] = LDG(u32x4, pv + (size_t)(q * 8) * PITCH, lv);
    f32x4 st[TH + 1][4];
#pragma unroll
    for (int h = 0; h <= TH; ++h)
#pragma unroll
        for (int j = 0; j < 4; ++j) st[h][j] = LDG(f32x4, lns + (size_t)(T0 + 64 * h) * 16 + 4 * j, (unsigned)lane * 64u);
    float lg[8], lb[8];
    { const f32x4 g0 = LDG(f32x4, ln_g + g * 64, (unsigned)ck * 32u), g1 = LDG(f32x4, ln_g + g * 64 + 4, (unsigned)ck * 32u), b0 = LDG(f32x4, ln_b + g * 64, (unsigned)ck * 32u), b1 = LDG(f32x4, ln_b + g * 64 + 4, (unsigned)ck * 32u);
#pragma unroll
      for (int j = 0; j < 4; ++j) { lg[j] = g0[j]; lg[4 + j] = g1[j]; lb[j] = b0[j]; lb[4 + j] = b1[j]; } }
    float mean[TH + 1], rstd[TH + 1];
#pragma unroll
    for (int h = 0; h <= TH; ++h) { const f32x4 a = st[h][0], b = st[h][1], c = st[h][2], d = st[h][3];
        const float s1 = (a.x + a.z) + (b.x + b.z) + (c.x + c.z) + (d.x + d.z), s2 = (a.y + a.w) + (b.y + b.w) + (c.y + c.w) + (d.y + d.w);
        mean[h] = s1 * (1.f / 512.f); rstd[h] = __builtin_amdgcn_rsqf(fmaxf(s2 * (1.f / 512.f) - mean[h] * mean[h], 0.f) + LN_EPS); }
#pragma unroll
    for (int q = 0; q < NV; ++q) { const int s = q * 8 + rsub;
        const float mu = __shfl(mean[(q * 8) >> 6], s & 63), rs = __shfl(rstd[(q * 8) >> 6], s & 63);
        unsigned pk[4];
#pragma unroll
        for (int j = 0; j < 4; ++j) { const f32x2 y = (bf2(raw[q][j]) - mu) * rs * (f32x2){lg[2 * j], lg[2 * j + 1]} + (f32x2){lb[2 * j], lb[2 * j + 1]}; pk[j] = cvt_pk_bf16(y.x, y.y); }
        LAS unsigned char* wp = wl + s * VB + ck * 16;
        *(LAS u32x2*)wp = (u32x2){pk[0], pk[1]}; *(LAS u32x2*)(wp + 8) = (u32x2){pk[2], pk[3]}; }
    LDS_WAIT(); asm volatile("" ::: "memory");
    f32x4 acc[4][4];
#pragma unroll
    for (int ct = 0; ct < 4; ++ct)
#pragma unroll
        for (int tt = 0; tt < 4; ++tt) acc[ct][tt] = (f32x4){0.f, 0.f, 0.f, 0.f};
    const bf16_t* wmg = Wm + (size_t)g * 128 * 128 + (size_t)(64 * TH) * 128;
    const LAS unsigned char* trp = wl + (8 * fq + (fr >> 2)) * VB + (fr & 3) * 8;
#pragma unroll 1
    for (int ks = 0; ks < NKS; ++ks) {
        bf16x8 af[4], bfr[4];
#pragma unroll
        for (int tt = 0; tt < 4; ++tt) bfr[tt] = LDG(bf16x8, wmg + (16 * tt) * 128 + ks * 32, lw);
#pragma unroll
        for (int ct = 0; ct < 4; ++ct) { const s16x4 a0 = lds_tr16(trp + (ks * 32) * VB + ct * 32), a1 = lds_tr16(trp + (ks * 32 + 4) * VB + ct * 32);
            af[ct] = (bf16x8){a0[0], a0[1], a0[2], a0[3], a1[0], a1[1], a1[2], a1[3]}; }
#pragma unroll
        for (int ct = 0; ct < 4; ++ct)
#pragma unroll
            for (int tt = 0; tt < 4; ++tt) acc[ct][tt] = __builtin_amdgcn_mfma_f32_16x16x32_bf16(af[ct], bfr[tt], acc[ct][tt], 0, 0, 0);
    }
    LDS_WAIT(); asm volatile("" ::: "memory");
#pragma unroll
    for (int tt = 0; tt < 4; ++tt)
#pragma unroll
        for (int ct = 0; ct < 4; ++ct) *(LAS f32x4*)(wl + (16 * tt + fr) * OB + (16 * ct + 4 * fq) * 4) = acc[ct][tt];
    LDS_WAIT(); asm volatile("" ::: "memory");
    bf16_t* po = P + (size_t)(T0 + 64 * TH) * PITCH + g * 64;
    const float* bsp = b_s + g * 128 + 64 * TH;
#pragma unroll
    for (int hf = 0; hf < 2; ++hf) {
        u32x4 uu[4], zz[4]; float bs[4];
#pragma unroll
        for (int q = 0; q < 4; ++q) { uu[q] = LDG(u32x4, po + (size_t)((hf * 4 + q) * 8) * PITCH + C_U, lv); zz[q] = LDG(u32x4, po + (size_t)((hf * 4 + q) * 8) * PITCH + C_ZA, lv);
            bs[q] = LDG(float, bsp + (hf * 4 + q) * 8, (unsigned)rsub * 4u); }
#pragma unroll
        for (int q = 0; q < 4; ++q) { const int t = (hf * 4 + q) * 8 + rsub;
            const f32x4 s0 = *(const LAS f32x4*)(wl + t * OB + ck * 32), s1 = *(const LAS f32x4*)(wl + t * OB + ck * 32 + 16);
            u32x4 w;
#pragma unroll
            for (int j = 0; j < 4; ++j) { const f32x2 s2 = (j < 2 ? (f32x2){s0[2 * j], s0[2 * j + 1]} : (f32x2){s1[2 * j - 4], s1[2 * j - 3]}) + bs[q];
                const f32x2 o = gelu2(bf2(uu[q][j])) * s2 * silu2(bf2(zz[q][j]));
                w[j] = cvt_pk_bf16(o.x, o.y); }
            STG(u32x4, po + (size_t)((hf * 4 + q) * 8) * PITCH + C_U, lv, w); }
    }
    LDS_WAIT(); asm volatile("" ::: "memory");
}
__device__ __forceinline__ void mixer_a_item(bf16_t* P, const float* lns, const bf16_t* Wm, const float* ln_g, const float* ln_b, const float* b_s, LAS unsigned char* wl, int item, int lane) {
    const int th = item & 1, g = (item >> 1) & 7, n = item >> 4;
    if (th) mixer_a_body<1>(P, lns, Wm, ln_g, ln_b, b_s, wl, n, g, lane); else mixer_a_body<0>(P, lns, Wm, ln_g, ln_b, b_s, wl, n, g, lane);
}

__device__ __forceinline__ void mixer_b_item(bf16_t* P, const float* conv_w, const float* conv_b, int item, int lane) {
    const int hb = item & 1, t0 = (item >> 1) * 16;
    const bool seq_start = (t0 % SEQ) == 0;
    bf16_t* pbase = P + (size_t)t0 * PITCH + hb * 256;
    const unsigned l8 = (unsigned)lane * 8u, l16 = (unsigned)lane * 16u;
    const f32x4 w0 = LDG(f32x4, conv_w + hb * 256, l16), w1 = LDG(f32x4, conv_w + 512 + hb * 256, l16), w2 = LDG(f32x4, conv_w + 1024 + hb * 256, l16), cb = LDG(f32x4, conv_b + hb * 256, l16);
    f32x4 pm2 = (f32x4){0.f, 0.f, 0.f, 0.f}, pm1 = pm2;
#pragma unroll
    for (int hf = 0; hf < 2; ++hf) {
        u32x2 xx[10], cc[10], bb[8], zz[8];
#pragma unroll
        for (int r = (hf ? 2 : 0); r < 10; ++r) { const int dt = hf * 8 + r - 2; const bool ok = (dt >= 0) || !seq_start;
            xx[r] = ok ? LDG(u32x2, pbase + (ptrdiff_t)dt * PITCH + C_XB, l8) : (u32x2){0u, 0u}; cc[r] = ok ? LDG(u32x2, pbase + (ptrdiff_t)dt * PITCH + C_CG, l8) : (u32x2){0u, 0u}; }
#pragma unroll
        for (int r = 0; r < 8; ++r) { bb[r] = LDG(u32x2, pbase + (size_t)(hf * 8 + r) * PITCH + C_BG, l8); zz[r] = LDG(u32x2, pbase + (size_t)(hf * 8 + r) * PITCH + C_ZB, l8); }
        if (hf == 0) {
            pm2 = (f32x4){bf_lo(xx[0].x) * bf_lo(cc[0].x), bf_hi(xx[0].x) * bf_hi(cc[0].x), bf_lo(xx[0].y) * bf_lo(cc[0].y), bf_hi(xx[0].y) * bf_hi(cc[0].y)};
            pm1 = (f32x4){bf_lo(xx[1].x) * bf_lo(cc[1].x), bf_hi(xx[1].x) * bf_hi(cc[1].x), bf_lo(xx[1].y) * bf_lo(cc[1].y), bf_hi(xx[1].y) * bf_hi(cc[1].y)}; }
#pragma unroll
        for (int r = 0; r < 8; ++r) {
            const f32x4 p0 = (f32x4){bf_lo(xx[r + 2].x) * bf_lo(cc[r + 2].x), bf_hi(xx[r + 2].x) * bf_hi(cc[r + 2].x), bf_lo(xx[r + 2].y) * bf_lo(cc[r + 2].y), bf_hi(xx[r + 2].y) * bf_hi(cc[r + 2].y)};
            const f32x4 y = cb + w0 * pm2 + w1 * pm1 + w2 * p0;
            const f32x4 bg = (f32x4){bf_lo(bb[r].x), bf_hi(bb[r].x), bf_lo(bb[r].y), bf_hi(bb[r].y)};
            const f32x2 zb0 = silu2(bf2(zz[r].x)), zb1 = silu2(bf2(zz[r].y)); const f32x4 zb = (f32x4){zb0.x, zb0.y, zb1.x, zb1.y};
            const f32x4 o = bg * y * zb;
            u32x2 w; w.x = cvt_pk_bf16(o[0], o[1]); w.y = cvt_pk_bf16(o[2], o[3]); STG(u32x2, pbase + (size_t)(hf * 8 + r) * PITCH + C_ZB, l8, w);
            pm2 = pm1; pm1 = p0; }
    }
}

template <int W> __device__ __forceinline__ void mixer_c_pool(const bf16_t* pxc  , LAS bf16_t* pl, int PL_LD, int tseq, int lane) {
    constexpr int NR = 31 + W;
    unsigned xv[NR];
#pragma unroll
    for (int r = 0; r < NR; ++r) { const int dt = r - (W - 1); xv[r] = (dt >= 0 || tseq > 0) ? LDG(unsigned, pxc + (ptrdiff_t)dt * PITCH, (unsigned)lane * 4u) : 0u; }
    f32x2 s = (f32x2){0.f, 0.f};
#pragma unroll
    for (int r = 0; r < NR; ++r) {
        const int dt = r - (W - 1);
        const f32x2 xr = bf2(xv[r]);
        s += xr;
        if (r >= W) s -= bf2(xv[r - W]);
        if (dt >= 0) { const int pos = tseq + dt; const float inv = 1.0f / (float)((pos + 1 < W) ? (pos + 1) : W);
            const f32x2 o = s * inv - xr; *(LAS unsigned*)(pl + dt * PL_LD + 2 * lane) = cvt_pk_bf16(o.x, o.y); }
    }
}
__device__ __forceinline__ void mixer_c_item(bf16_t* P, const bf16_t* WpT, LAS unsigned char* wl, int item, int lane) {
    const int gi = item & 3, t0 = (item >> 2) * 32;
    constexpr int PL_LD = 136;
    constexpr int OB = 528;
    LAS bf16_t* pl = (LAS bf16_t*)wl;
    const bf16_t* pxc = P + (size_t)t0 * PITCH + C_XC + gi * 128; const int tseq = t0 % SEQ;
    if (gi == 0) mixer_c_pool<2>(pxc, pl, PL_LD, tseq, lane);
    else if (gi == 1) mixer_c_pool<4>(pxc, pl, PL_LD, tseq, lane);
    else if (gi == 2) mixer_c_pool<8>(pxc, pl, PL_LD, tseq, lane);
    else mixer_c_pool<16>(pxc, pl, PL_LD, tseq, lane);
    LDS_WAIT(); asm volatile("" ::: "memory");
    const int fr = lane & 15, fq = lane >> 4;
    const unsigned lw = (unsigned)(fr * 128 + fq * 8) * 2u;
    bf16x8 bfr[2][4];
#pragma unroll
    for (int tt = 0; tt < 2; ++tt)
#pragma unroll
        for (int ks = 0; ks < 4; ++ks) bfr[tt][ks] = *(const LAS bf16x8*)(pl + (tt * 16 + fr) * PL_LD + ks * 32 + fq * 8);
    LDS_WAIT(); asm volatile("" ::: "memory");
    const bf16_t* wg = WpT + (size_t)gi * 128 * 128;
#pragma unroll 2
    for (int dp = 0; dp < 4; ++dp) {
        bf16x8 af[2][4];
#pragma unroll
        for (int d2 = 0; d2 < 2; ++d2)
#pragma unroll
            for (int ks = 0; ks < 4; ++ks) af[d2][ks] = LDG(bf16x8, wg + (size_t)((dp * 2 + d2) * 16) * 128 + ks * 32, lw);
#pragma unroll
        for (int d2 = 0; d2 < 2; ++d2) {
            f32x4 a0 = (f32x4){0.f, 0.f, 0.f, 0.f}, a1 = a0;
#pragma unroll
            for (int ks = 0; ks < 4; ++ks) { a0 = __builtin_amdgcn_mfma_f32_16x16x32_bf16(af[d2][ks], bfr[0][ks], a0, 0, 0, 0); a1 = __builtin_amdgcn_mfma_f32_16x16x32_bf16(af[d2][ks], bfr[1][ks], a1, 0, 0, 0); }
            *(LAS f32x4*)(wl + fr * OB + ((dp * 2 + d2) * 16 + 4 * fq) * 4) = a0; *(LAS f32x4*)(wl + (16 + fr) * OB + ((dp * 2 + d2) * 16 + 4 * fq) * 4) = a1; }
    }
    LDS_WAIT(); asm volatile("" ::: "memory");
    bf16_t* pz = P + (size_t)t0 * PITCH + C_ZC + gi * 128;
    const int r4 = lane >> 4, c16 = lane & 15;
    const unsigned lz = (unsigned)(r4 * PITCH + c16 * 8) * 2u;
    u32x4 zv[8];
#pragma unroll
    for (int q = 0; q < 8; ++q) zv[q] = LDG(u32x4, pz + (size_t)(q * 4) * PITCH, lz);
#pragma unroll
    for (int q = 0; q < 8; ++q) { const int t = q * 4 + r4;
        const f32x4 s0 = *(const LAS f32x4*)(wl + t * OB + c16 * 32), s1 = *(const LAS f32x4*)(wl + t * OB + c16 * 32 + 16);
        u32x4 w;
#pragma unroll
        for (int j = 0; j < 4; ++j) { const float sa = (j < 2 ? s0[2 * j] : s1[2 * j - 4]), sb = (j < 2 ? s0[2 * j + 1] : s1[2 * j - 3]);
            { const f32x2 o = (f32x2){sa, sb} * silu2(bf2(zv[q][j])); w[j] = cvt_pk_bf16(o.x, o.y); } }
        STG(u32x4, pz + (size_t)(q * 4) * PITCH, lz, w); }
    LDS_WAIT(); asm volatile("" ::: "memory");
}

__global__ void __launch_bounds__(NWAVES * 64, 2) hybrid_fwd(Args args) {
    extern __shared__ __attribute__((aligned(16))) unsigned char lds_raw[];
    LAS unsigned char* lds = (LAS unsigned char*)lds_raw;
    volatile LAS unsigned* MISC = (volatile LAS unsigned*)(lds + MISC_OFF);
    const int tid = threadIdx.x, lane = tid & 63, wave = __builtin_amdgcn_readfirstlane(tid >> 6);
    const int G = gridDim.x; const int bx = blockIdx.x;
    const int vcu = (G % 8 == 0) ? (bx % 8) * (G / 8) + bx / 8 : bx;
    const int gw = vcu * NWAVES + wave, NGW = G * NWAVES;
    unsigned char* ws = args.ws;
    for (int u = tid; u < (LDS_BYTES - LDSCTL_OFF) / 4; u += NWAVES * 64) ((LAS unsigned*)(lds + LDSCTL_OFF))[u] = 0u;
    __syncthreads();
    const XcdBarrier bar = xcd_barrier_post((unsigned*)(ws + WS_CTL), MISC + 8, (unsigned)G);
    (void)xcd_barrier_post((unsigned*)(ws + WS_CTL) + (1 + (bx & 7)) * XCD_BAR_WORDS, MISC + 10, (unsigned)(G / 8));
    const int lo = args.ph_lo, hi = args.ph_hi;
#define IN(k) (lo <= (k) && (k) < hi)
#define SEAM(k) do { if (IN(k) && IN((k) + 1)) xcd_barrier(bar); } while (0)
#define CW_PROG 47104
#define GSEAM_W(k, nbr, tgt) GSEAM_X(k, nbr, tgt, false)
#define GSEAM_X(k, nbr, tgt, loc) do { if (IN(k) && IN((k) + 1)) { XcdBarrier gb; gb.bar = (unsigned*)(args.ws + WS_CTL) + (1 + ((int)blockIdx.x & 7)) * XCD_BAR_WORDS; gb.x = bar.x; gb.st = MISC + 10; gb.G = gridDim.x / 8; \
        unsigned* pw_ = (unsigned*)(args.ws + WS_CTL) + CW_PROG; const int nb_ = (nbr); \
        xcd_barrier(gb, nb_ >= 0 ? pw_ + 64 * nb_ : nullptr, (unsigned)(tgt), ((int)blockIdx.x >> 3) == 0 ? pw_ + 64 * ((int)blockIdx.x & 7) : nullptr, (loc)); } } while (0)
#define GSEAM(k) GSEAM_X(k, -1, 0, true)

    bf16_t* P = (bf16_t*)(ws + WS_P);
    float* rss = (float*)(ws + WS_RSS);
    float* lns = (float*)(ws + WS_LNS);

    if (IN(0)) { p0_prologue(args, lds, gw, NGW, wave, lane); }
    SEAM(0);

    for (int l = 0; l < DEPTH; ++l) {
        const int pb = 1 + 4 * l;
        const bf16_t* Wmix = (const bf16_t*)(ws + WS_WMIX) + (size_t)l * NMIX * D;
        const bf16_t* W3 = (const bf16_t*)(ws + WS_W3) + (size_t)l * D * K3;
        const bf16_t* WoT = (const bf16_t*)(ws + WS_WO) + (size_t)l * D * D;
        const float* rss_l = rss + (size_t)l * M * 16;
        if (IN(pb)) {
            const int jg = bx >> 3; const bool five = (G == 256) && (bx < 128);
            for (int pass = 0; pass < 2; ++pass) {
                if ((pass == 0) != five) {
                    SchedG S; S.x = bx & 7; S.r = jg & 15; S.n = five ? 1 : 2; S.c0 = five ? 4 : 0; S.sq = five ? 0 : 2;     S.A8 = (const char*)(ws + WS_XB8); S.W8 = (const char*)(ws + WS_WG8 + (size_t)l * 3 * D * D);
                    EpiP3G E{(unsigned char*)args.out, GATE_PLANE_BYTES, (unsigned)D, rss_l};
                    pg8::gemm_phase<EpiP3G, SchedG, true, true>(lds, D, D, S, E);
                } else {
                    SchedP1 S; S.T.init(M, NMIX, G, bx, P1_WGM); S.P = (const char*)P; S.W = (const char*)Wmix;
                    EpiP1 E{P, rss_l, lns};
                    pg8::gemm_phase<EpiP1, SchedP1, true>(lds, PITCH * 2, D * 2, S, E);
                }
            }
        }
        GSEAM_W(pb, (bx & 3) != 0 ? (bx & 7) - 1 : -1, 1 + 4 * l);
        if (IN(pb + 1)) {
            const bf16_t* Wm = (const bf16_t*)(ws + WS_WM) + (size_t)l * 8 * 128 * 128;
            const bf16_t* WpT = (const bf16_t*)(ws + WS_WPOOL) + (size_t)l * 4 * 128 * 128;
            LAS unsigned char* wl = lds + wave * WAVE_LDS;
            int ln = lane; asm volatile("" : "+v"(ln));
            { const int x = bx & 7, e = bx >> 3;
              SchedG S; S.x = x; S.r = e & 15; S.A8 = (const char*)(ws + WS_XB8); S.W8 = (const char*)(ws + WS_WG8 + (size_t)l * 3 * D * D);
              EpiP3G E{(unsigned char*)args.out, GATE_PLANE_BYTES, (unsigned)D, rss_l};
              if (G != 256) { for (int li = e * NWAVES + wave; li < 768; li += (G / 8) * NWAVES) { const int j = 256 * x + (li & 255);
                  if (li < 256) mixer_a_item(P, lns, Wm, args.in[3] + l * 512, args.in[4] + l * 512, args.in[6] + l * 1024, wl, j, ln);
                  else if (li < 512) mixer_b_item(P, args.in[7] + l * 1536, args.in[8] + l * 512, j, ln);
                  else mixer_c_item(P, WpT, wl, j, ln); } }
              else if (e < 16) {
                for (int li = e * 8 + wave; li < 512; li += 128) { const int j = 256 * x + (li & 255);
                  if (li < 256) mixer_a_item(P, lns, Wm, args.in[3] + l * 512, args.in[4] + l * 512, args.in[6] + l * 1024, wl, j, ln);
                  else mixer_b_item(P, args.in[7] + l * 1536, args.in[8] + l * 512, j, ln); }
                __syncthreads();
                S.n = 1; S.c0 = 10; S.sq = 0;
                pg8::gemm_phase<EpiP3G, SchedG, true, true>(lds, D, D, S, E); }
              else {
                S.n = 2; S.c0 = 6; S.sq = 2;
                pg8::gemm_phase<EpiP3G, SchedG, true, true>(lds, D, D, S, E);
                for (int li = 512 + (e - 16) * 8 + wave; li < 768; li += 128) mixer_c_item(P, WpT, wl, 256 * x + (li & 255), ln); } }
        }
        GSEAM(pb + 1);
        if (IN(pb + 2)) {
            pg8::TileOrder T; T.init(M, D, G, bx); int pm3, pn3;
            if (T.tile(0, pm3, pn3)) {
                SchedP3Y S; S.pm = pm3; S.pn = pn3; S.P = (const char*)P; S.W = (const char*)W3; EpiP3Y E{P, (const unsigned char*)args.out, GATE_PLANE_BYTES, (unsigned)D};
                pg8::gemm_phase<EpiP3Y, SchedP3Y, true>(lds, PITCH * 2, K3 * 2, S, E);
            }
        }
        GSEAM(pb + 2);
        if (IN(pb + 3)) {
            SchedP4 S; S.T.init(M, D, G, bx); S.P = (const char*)P; S.W = (const char*)WoT;
            if (l == 0) { EpiP4 E{P, rss + (size_t)(l + 1) * M * 16, ws + WS_XB8};
                pg8::gemm_phase<EpiP4, SchedP4, true>(lds, PITCH * 2, D * 2, S, E); }
            else { EpiP4F E{P, args.out, rss + (size_t)2 * M * 16, args.in[15], (unsigned*)(ws + WS_CTL) + CW_PANEL, (unsigned*)(ws + WS_CTL) + XB_TMO};
                pg8::gemm_phase<EpiP4F, SchedP4, true>(lds, PITCH * 2, D * 2, S, E); }
        }
        if (l + 1 < DEPTH) GSEAM_X(pb + 3, (bx & 3) != 3 ? (bx & 7) + 1 : -1, 2 + 4 * l, true);
    }
#undef IN
#undef SEAM
#undef GSEAM
}

extern "C" void kernel_launch(void* const* d_in, const int* in_sizes, int n_in, void* d_out, int out_size, void* d_ws, size_t ws_size, hipStream_t stream) {
    static int grid = 0;
    if (grid == 0) {
        if (n_in != 16 || in_sizes[0] != M * D || out_size != M * D || ws_size < WS_END) { fprintf(stderr, "kernel_launch: unexpected shapes (n_in %d, in0 %d, out %d, ws %zu); nothing launched\n", n_in, n_in > 0 ? in_sizes[0] : -1, out_size, ws_size); grid = -1; return; }
        int dev = 0, cus = 0, per_cu = 0;
        if (hipGetDevice(&dev) != hipSuccess || hipDeviceGetAttribute(&cus, hipDeviceAttributeMultiprocessorCount, dev) != hipSuccess) { grid = -1; return; }
        if (hipFuncSetAttribute((const void*)hybrid_fwd, hipFuncAttributeMaxDynamicSharedMemorySize, LDS_BYTES) != hipSuccess) { fprintf(stderr, "kernel_launch: hipFuncSetAttribute failed\n"); grid = -1; return; }
        if (hipOccupancyMaxActiveBlocksPerMultiprocessor(&per_cu, (const void*)hybrid_fwd, NWAVES * 64, LDS_BYTES) != hipSuccess || per_cu < 1) { fprintf(stderr, "kernel_launch: occupancy query reports %d blocks per CU\n", per_cu); (void)hipGetLastError(); grid = -1; return; }
        if (cus != 256) { fprintf(stderr, "kernel_launch: built for a 256-CU device (the unit assignment is written for 256 workgroups); this one has %d CUs; nothing launched\n", cus); grid = -1; return; }
        grid = cus;
    }
    if (grid < 0) return;
    if (hipMemsetAsync((char*)d_ws + WS_CTL, 0, CTL_ZERO_BYTES, stream) != hipSuccess) return;
    Args a{};
    for (int i = 0; i < 16; ++i) a.in[i] = (const float*)d_in[i];
    a.out = (float*)d_out; a.ws = (unsigned char*)d_ws;
    a.ph_lo = 0; a.ph_hi = 9;
    hipLaunchKernelGGL(hybrid_fwd, dim3(grid), dim3(NWAVES * 64), LDS_BYTES, stream, a);
}
```

```cpp
#include <hip/hip_runtime.h>
#include <cstdio>
#include <cstdint>


#define P1_WGM 2
#define GAS __attribute__((address_space(1)))
#define LAS __attribute__((address_space(3)))
typedef unsigned short bf16_t;
typedef short bf16x8 __attribute__((ext_vector_type(8)));
typedef float f32x4 __attribute__((ext_vector_type(4)));
typedef float f32x2 __attribute__((ext_vector_type(2)));
typedef unsigned u32x4 __attribute__((ext_vector_type(4)));
typedef unsigned u32x2 __attribute__((ext_vector_type(2)));

constexpr int SEQ = 8192, D = 1024, M = 2 * SEQ, DEPTH = 2;
constexpr int IN_TOTAL = 7680;
constexpr int NMIX = 4608;
constexpr int PITCH = NMIX + D;
constexpr int XB_COL = NMIX;
constexpr int C_U = 0, C_ZB = 512, C_ZC = 1024, C_V = 1536, C_ZA = 2048, C_XB = 2560, C_BG = 3072, C_CG = 3584, C_XC = 4096;
constexpr int C_S = 1536, C_MERGED = 1536;
constexpr int K3 = 1536;
constexpr float RMS_EPS = 1e-6f, LN_EPS = 1e-5f;

constexpr size_t MiB = 1u << 20;
constexpr size_t WS_CTL = 0, CTL_ZERO_BYTES = 192 * 1024;
constexpr int CW_PANEL = 40960;
constexpr size_t WS_RSS = 1 * MiB;
constexpr size_t WS_LNS = 4 * MiB;
constexpr size_t WS_WMIX = 5 * MiB;
constexpr size_t WS_W3 = 23 * MiB;
constexpr size_t WS_WO = 29 * MiB;
constexpr size_t WS_WM = 33 * MiB;
constexpr size_t WS_WPOOL = WS_WM + 512 * 1024;
constexpr size_t WS_P = 34 * MiB;
constexpr size_t WS_XB8 = WS_P + (size_t)M * PITCH * 2;
constexpr size_t WS_WG8 = WS_XB8 + (size_t)M * D;
constexpr float WG8_SCALE = 64.0f;
constexpr size_t GATE_GROUP_BYTES = 8 * MiB, GATE_PLANE_BYTES = 2 * MiB;
constexpr size_t WS_END = WS_WG8 + (size_t)DEPTH * 3 * D * D;
static_assert(WS_END <= 256 * MiB, "workspace map");

constexpr int NWAVES = 8;
constexpr int RING_BYTES = 131072;
constexpr int WAVE_LDS = 17920;
constexpr int LDSCTL_OFF = 143360, MISC_OFF = LDSCTL_OFF + 320;
constexpr int LDS_BYTES = 147456;

#define RLX_AGENT __ATOMIC_RELAXED, __HIP_MEMORY_SCOPE_AGENT
#define LDS_WAIT() asm volatile("s_waitcnt lgkmcnt(0)" ::: "memory")
#define VM_WAIT() asm volatile("s_waitcnt vmcnt(0)" ::: "memory")

__device__ __forceinline__ unsigned cvt_pk_bf16(float lo, float hi) { unsigned r; asm volatile("v_cvt_pk_bf16_f32 %0, %1, %2" : "=v"(r) : "v"(lo), "v"(hi)); return r; }
__device__ __forceinline__ unsigned pk4_fp8(float a, float b, float c, float d) { int w = 0; w = __builtin_amdgcn_cvt_pk_fp8_f32(a, b, w, false); w = __builtin_amdgcn_cvt_pk_fp8_f32(c, d, w, true); return (unsigned)w; }
__device__ __forceinline__ float bf_lo(unsigned w) { return __builtin_bit_cast(float, w << 16); }
__device__ __forceinline__ float bf_hi(unsigned w) { return __builtin_bit_cast(float, w & 0xffff0000u); }
__device__ __forceinline__ float sigmoid_f(float x) { return __builtin_amdgcn_rcpf(1.0f + __builtin_amdgcn_exp2f(-1.4426950409f * x)); }
__device__ __forceinline__ float silu_f(float x) { return x * sigmoid_f(x); }
__device__ __forceinline__ f32x2 bf2(unsigned w) { return (f32x2){bf_lo(w), bf_hi(w)}; }
__device__ __forceinline__ f32x2 rcp2(f32x2 d) { return (f32x2){__builtin_amdgcn_rcpf(d.x), __builtin_amdgcn_rcpf(d.y)}; }
__device__ __forceinline__ f32x2 exp2_2(f32x2 t) { return (f32x2){__builtin_amdgcn_exp2f(t.x), __builtin_amdgcn_exp2f(t.y)}; }
__device__ __forceinline__ f32x2 silu2(f32x2 x) { return x * rcp2(exp2_2(x * -1.4426950409f) + 1.0f); }
__device__ __forceinline__ f32x2 gelu2(f32x2 x) { const f32x2 t = x * x * (-2.3022081981f * 0.044715f) + (-2.3022081981f); return x * rcp2(exp2_2(x * t) + 1.0f); }
__device__ __forceinline__ float gelu_tanh_f(float x) { return x * __builtin_amdgcn_rcpf(1.0f + __builtin_amdgcn_exp2f(x * __builtin_fmaf(x * x, -2.3022081981f * 0.044715f, -2.3022081981f))); }

namespace pg8 {
constexpr int BM = 256, BK = 64, HALF = 128, HTB = HALF * BK * 2, STAGE_BYTES = 8 * HTB, NXCD = 8, WGM = 8;
__host__ __device__ __forceinline__ int lds_byte(int r, int c) { const int st = (r >> 4) * 2 + (c >> 5), rr = r & 15, cc = c & 31, ob = rr * 64 + cc * 2; return st * 1024 + (ob ^ (((ob >> 9) & 1) << 5)); }
__host__ __device__ __forceinline__ void stage_rc(int b, int& R, int& C) { const int st = b / 1024, sb = b % 1024, swz = sb ^ (((sb >> 9) & 1) << 5); R = (st >> 1) * 16 + swz / 64; C = (st & 1) * 32 + (swz % 64) / 2; }
__host__ __device__ __forceinline__ int perm32(int rho) { const int n = rho >> 4, i = rho & 15; return 8 * (i >> 2) + 4 * n + (i & 3); }

struct Unit { const char* A; const char* B; int nt; int kind; int pm, pn; };

struct TileOrder {
    int nM, nN, nwg, G, c, wgm;
    __device__ void init(int M_, int N_, int G_, int c_, int wgm_ = WGM) { nM = M_ / BM; nN = N_ / BM; nwg = nM * nN; G = G_; c = c_; wgm = wgm_; }
    __device__ bool tile(int i, int& pm, int& pn) const {
        const long L = (long)i * G + c; if (L >= nwg) return false;
        int wgid = (int)L; { const int q = nwg / NXCD, r = nwg % NXCD, xcd = wgid % NXCD, off = wgid / NXCD; wgid = (xcd < r ? xcd * (q + 1) : r * (q + 1) + (xcd - r) * q) + off; }
        const int nig = wgm * nN, gid = wgid / nig, fm = gid * wgm, gsz = (nM - fm) < wgm ? (nM - fm) : wgm;
        pm = fm + ((wgid % nig) % gsz); pn = (wgid % nig) / gsz; return true;
    }
};

typedef int i32x4 __attribute__((ext_vector_type(4)));
typedef int i32x8 __attribute__((ext_vector_type(8)));
__device__ __forceinline__ i32x8 cat16(bf16x8 lo, bf16x8 hi) { const i32x4 a = __builtin_bit_cast(i32x4, lo), b = __builtin_bit_cast(i32x4, hi); return __builtin_shufflevector(a, b, 0, 1, 2, 3, 4, 5, 6, 7); }
template <class Epi, class Sched, bool ALIGN_EPI, bool FP8 = false>
__device__ __forceinline__ void gemm_phase(LAS unsigned char* lds, const unsigned lda2, const unsigned ldb2, const Sched& S, const Epi& E) {
    int tid = threadIdx.x; asm volatile("" : "+v"(tid));
    const int wid = __builtin_amdgcn_readfirstlane(tid >> 6), lane = tid & 63, wr = wid >> 2, wc = wid & 3, fr = lane & 15, fq = lane >> 4;
    unsigned voffA[2], voffB[2];
#pragma unroll
    for (int i = 0; i < 2; ++i) { int R, C; stage_rc(tid * 16 + i * 8192, R, C); const int Rb = (R & ~31) + perm32(R & 31);
        voffA[i] = (unsigned)R * lda2 + (unsigned)C * 2u; voffB[i] = (unsigned)Rb * ldb2 + (unsigned)C * 2u; }
    const size_t kstep = (size_t)(BK * 2);
    const size_t hA = (size_t)HALF * lda2, hB = (size_t)HALF * ldb2;
    const unsigned ldsw = (unsigned)wid * 1024u;
    const int aoff = lds_byte(wr * 64 + fr, fq * 8), boff = lds_byte(wc * 32 + fr, fq * 8);
#define PG8_SA(b, h) (((b) * 2 + (h)) * HTB)
#define PG8_SB(b, h) ((4 + (b) * 2 + (h)) * HTB)
#define PG8_STAGE(bufoff, gbase, voff) do { _Pragma("unroll") for (int _i = 0; _i < 2; ++_i) \
        __builtin_amdgcn_global_load_lds((const unsigned*)((const char*)(gbase) + (voff)[_i]), (LAS unsigned*)(lds + (bufoff) + ldsw + _i * 8192), 16, 0, 0); } while (0)
#define PG8_LDA(dst, b, h) do { _Pragma("unroll") for (int m = 0; m < 4; ++m) { if constexpr (FP8) dst##8[m] = cat16(*(const LAS bf16x8*)(lds + PG8_SA(b, h) + aoff + m * 2048), *(const LAS bf16x8*)(lds + PG8_SA(b, h) + aoff + m * 2048 + 1024)); \
        else { _Pragma("unroll") for (int k = 0; k < 2; ++k) dst[m][k] = *(const LAS bf16x8*)(lds + PG8_SA(b, h) + aoff + m * 2048 + k * 1024); } } } while (0)
#define PG8_LDB(dst, b, h) do { _Pragma("unroll") for (int n = 0; n < 2; ++n) { if constexpr (FP8) dst##8[n] = cat16(*(const LAS bf16x8*)(lds + PG8_SB(b, h) + boff + n * 2048), *(const LAS bf16x8*)(lds + PG8_SB(b, h) + boff + n * 2048 + 1024)); \
        else { _Pragma("unroll") for (int k = 0; k < 2; ++k) dst[n][k] = *(const LAS bf16x8*)(lds + PG8_SB(b, h) + boff + n * 2048 + k * 1024); } } } while (0)
#define PG8_MMA(ai, bj, At, Bt) do { __builtin_amdgcn_s_setprio(1); \
        if constexpr (FP8) { _Pragma("unroll") for (int m = 0; m < 4; ++m) _Pragma("unroll") for (int n = 0; n < 2; ++n) \
            asm volatile("v_mfma_scale_f32_16x16x128_f8f6f4 %0, %1, %2, %0, %3, %3 op_sel_hi:[0,0,0]" : "+v"(acc[ai][bj][m][n]) : "v"(Bt##8[n]), "v"(At##8[m]), "v"(sc8)); \
            asm volatile("s_nop 15\n\ts_nop 7" ::: "memory"); }   \
        else { _Pragma("unroll") for (int m = 0; m < 4; ++m) _Pragma("unroll") for (int n = 0; n < 2; ++n) _Pragma("unroll") for (int k = 0; k < 2; ++k) \
            acc[ai][bj][m][n] = __builtin_amdgcn_mfma_f32_16x16x32_bf16(Bt[n][k], At[m][k], acc[ai][bj][m][n], 0, 0, 0); } \
        __builtin_amdgcn_s_setprio(0); } while (0)
#define PG8_WAIT_V(n) asm volatile("s_waitcnt vmcnt(" #n ")" ::: "memory")
#define PG8_WAIT_L(n) asm volatile("s_waitcnt lgkmcnt(" #n ")" ::: "memory")
#define PG8_BAR __builtin_amdgcn_s_barrier()
#define PG8_SCHED __builtin_amdgcn_sched_barrier(0)
    Unit cur, nxt; int ui = 0;
    if (!S.next(0, cur)) return;
    f32x4 acc[2][2][4][2];
#pragma unroll
    for (int a = 0; a < 2; ++a)
#pragma unroll
        for (int b = 0; b < 2; ++b)
#pragma unroll
            for (int m = 0; m < 4; ++m)
#pragma unroll
                for (int n = 0; n < 2; ++n) acc[a][b][m][n] = (f32x4){0.f, 0.f, 0.f, 0.f};
    bf16x8 At[4][2], B0[2][2], B1[2][2]; i32x8 At8[4], B08[2], B18[2];
    int sc8 = 0x7f7f7f7f; asm volatile("" : "+v"(sc8));
    const char* cA = cur.A; const char* cB = cur.B;
    PG8_STAGE(PG8_SB(0, 0), cB, voffB); PG8_STAGE(PG8_SB(0, 1), cB + hB, voffB); PG8_STAGE(PG8_SA(0, 0), cA, voffA); PG8_STAGE(PG8_SA(0, 1), cA + hA, voffA);
    if (wr == 1) PG8_BAR;
    PG8_WAIT_V(2); PG8_BAR;
    PG8_STAGE(PG8_SB(1, 0), cB + kstep, voffB); PG8_STAGE(PG8_SA(1, 0), cA + kstep, voffA); PG8_STAGE(PG8_SB(1, 1), cB + hB + kstep, voffB);
    PG8_WAIT_V(6); PG8_BAR;
    for (;;) {
        const bool has_next = S.next(ui + 1, nxt);
        const char* nA = has_next ? nxt.A : cA; const char* nB = has_next ? nxt.B : cB;
        const int nt = cur.nt;
#pragma unroll 1
        for (int t = 0; t < nt; t += 2) {
            const bool last = (t == nt - 2);
            const char* a1 = cA + (size_t)(t + 1) * kstep;
            const char* a2 = last ? nA : cA + (size_t)(t + 2) * kstep; const char* b2 = last ? nB : cB + (size_t)(t + 2) * kstep;
            const char* a3 = a2 + kstep; const char* b3 = b2 + kstep;
            PG8_LDB(B0, 0, 0); PG8_LDB(B1, 0, 1); PG8_SCHED; PG8_LDA(At, 0, 0); PG8_STAGE(PG8_SA(1, 1), a1 + hA, voffA);
            PG8_WAIT_V(8); PG8_WAIT_L(0); PG8_BAR; PG8_MMA(0, 0, At, B0); PG8_MMA(0, 1, At, B1); PG8_BAR; PG8_SCHED;
            PG8_LDA(At, 0, 1); PG8_STAGE(PG8_SB(0, 0), b2, voffB); PG8_STAGE(PG8_SB(0, 1), b2 + hB, voffB); PG8_STAGE(PG8_SA(0, 0), a2, voffA);
            PG8_WAIT_V(8); PG8_WAIT_L(0); PG8_BAR; PG8_MMA(1, 0, At, B0); PG8_MMA(1, 1, At, B1); PG8_BAR; PG8_SCHED;
            PG8_LDB(B0, 1, 0); PG8_LDB(B1, 1, 1); PG8_SCHED; PG8_LDA(At, 1, 0); PG8_STAGE(PG8_SA(0, 1), a2 + hA, voffA);
            PG8_WAIT_V(8); PG8_WAIT_L(0); PG8_BAR; PG8_MMA(0, 0, At, B0); PG8_MMA(0, 1, At, B1); PG8_BAR; PG8_SCHED;
            PG8_LDA(At, 1, 1); PG8_STAGE(PG8_SB(1, 0), b3, voffB); PG8_STAGE(PG8_SB(1, 1), b3 + hB, voffB); PG8_STAGE(PG8_SA(1, 0), a3, voffA);
            PG8_WAIT_V(8); PG8_WAIT_L(0); PG8_BAR; PG8_MMA(1, 0, At, B0); PG8_MMA(1, 1, At, B1); PG8_BAR; PG8_SCHED;
        }
        if constexpr (ALIGN_EPI) { if (wr == 0) PG8_BAR; }
        E(acc, cur, wr, wc, fr, fq);
        if (!has_next) break;
        cur = nxt; cA = nA; cB = nB; ++ui;
        if constexpr (ALIGN_EPI) { if (wr == 1) PG8_BAR; }
    }
    PG8_WAIT_V(0);
    if constexpr (!ALIGN_EPI) { if (wr == 0) PG8_BAR; }
    PG8_BAR;
#undef PG8_SA
#undef PG8_SB
#undef PG8_STAGE
#undef PG8_LDA
#undef PG8_LDB
#undef PG8_MMA
#undef PG8_WAIT_V
#undef PG8_WAIT_L
#undef PG8_BAR
#undef PG8_SCHED
}
}

#define XB_TMO      128
#define XB_XCNT(j)  (256  + 64 * (j))
#define XB_XSUB(j)  (1280 + 64 * (j))
#define XB_XGEN(j)  (2304 + 64 * (j))
#define XB_TOP      3328
#define XB_TOPGEN   3392
#define XCD_BAR_WORDS 3456
#define XB_SPIN_CAP (1u << 18)
__device__ __forceinline__ unsigned xb_ld(unsigned* p)              { return __hip_atomic_load(p, __ATOMIC_RELAXED, __HIP_MEMORY_SCOPE_AGENT); }
__device__ __forceinline__ unsigned xb_add(unsigned* p, unsigned v) { return __hip_atomic_fetch_add(p, v, __ATOMIC_RELAXED, __HIP_MEMORY_SCOPE_AGENT); }
__device__ __forceinline__ unsigned xb_xcc_id() { return (unsigned)__builtin_amdgcn_s_getreg((3 << 11) | 20) & 0xFu; }
#define XB_SPIN(cond, bar) do { unsigned _sp = 0; while (cond) { __builtin_amdgcn_s_sleep(1); \
    if ((++_sp & 255u) == 0u) { if (xb_ld(&(bar)[XB_TMO])) break; if (_sp > XB_SPIN_CAP) { atomicAdd(&(bar)[XB_TMO], 1u); break; } } } } while (0)
struct XcdBarrier { unsigned* bar; unsigned x; volatile LAS unsigned* st; unsigned G; };
__device__ __forceinline__ XcdBarrier xcd_barrier_post(unsigned* bar, volatile LAS unsigned* st, unsigned G) {
    XcdBarrier b; b.bar = bar; b.x = xb_xcc_id(); b.st = st; b.G = G;
    if (threadIdx.x == 0) (void)xb_add(&bar[XB_XCNT(b.x)], 1u);
    return b;
}
__device__ __forceinline__ void xcd_barrier_complete(unsigned* bar, unsigned x, unsigned G, unsigned& nloc, unsigned& nx) {
    unsigned sum, cnt, mine, sp = 0u;
    for (;;) {
        sum = 0u; cnt = 0u; mine = 0u;
#pragma unroll
        for (unsigned j = 0; j < 16; ++j) { const unsigned c = xb_ld(&bar[XB_XCNT(j)]); sum += c; cnt += (c > 0u) ? 1u : 0u; mine = (j == x) ? c : mine; }
        if (sum == G) break;
        __builtin_amdgcn_s_sleep(1);
        if ((++sp & 255u) == 0u) { if (xb_ld(&bar[XB_TMO])) break; if (sp > XB_SPIN_CAP) { atomicAdd(&bar[XB_TMO], 1u); break; } }
    }
    nloc = mine > 0u ? mine : 1u; nx = cnt > 0u ? cnt : 1u;
}
__device__ __forceinline__ void xcd_barrier(const XcdBarrier& b, unsigned* wait_word = nullptr, unsigned wait_target = 0u, unsigned* prog_word = nullptr, bool local_ok = false) {
    asm volatile("s_waitcnt vmcnt(0)" ::: "memory");
    __syncthreads();
    if (threadIdx.x == 0) {
        unsigned* bar = b.bar;
        __builtin_amdgcn_s_waitcnt(0);
        asm volatile("buffer_inv sc1" ::: "memory");
        unsigned nloc = b.st[0], nx = b.st[1];
        if (nloc == 0u) { xcd_barrier_complete(bar, b.x, b.G, nloc, nx); b.st[0] = nloc; b.st[1] = nx; }
        const unsigned old = xb_add(&bar[XB_XSUB(b.x)], 1u);
        const unsigned gen = old / nloc;
        if (old + 1u == (gen + 1u) * nloc) {
            if (!(local_ok && nx == 1u)) { __builtin_amdgcn_fence(__ATOMIC_RELEASE, "agent"); asm volatile("s_waitcnt vmcnt(0)" ::: "memory"); }
            (void)xb_add(&bar[XB_TOP], 1u);
        }
        const unsigned tgt = (gen + 1u) * nx;
        if (wait_word) XB_SPIN(xb_ld(wait_word) < wait_target, bar);
        XB_SPIN(xb_ld(&bar[XB_TOP]) < tgt, bar);
        if (prog_word) (void)xb_add(prog_word, 1u);
        asm volatile("s_waitcnt vmcnt(0)" ::: "memory");
    }
    __syncthreads();
}

struct Args { const float* in[16]; float* out; unsigned char* ws; int ph_lo, ph_hi; };

__device__ __forceinline__ float wave_sum(float v) {
#pragma unroll
    for (int o = 1; o < 64; o <<= 1) v += __shfl_xor(v, o);
    return v;
}

__device__ __forceinline__ void p0_transpose_item(const float* W, int ldw, int k0, int n0, const float* gs, bf16_t* dst, int ldd, LAS float* scr, int lane) {
    float v[32];
    const float* wp = W + (size_t)(k0 + (lane >> 5)) * ldw + n0 + (lane & 31);
#pragma unroll
    for (int i = 0; i < 32; ++i) v[i] = wp[(size_t)(2 * i) * ldw];
    if (gs) {
#pragma unroll
        for (int i = 0; i < 32; ++i) v[i] *= gs[k0 + 2 * i + (lane >> 5)]; }
#pragma unroll
    for (int i = 0; i < 32; ++i) scr[(2 * i + (lane >> 5)) * 33 + (lane & 31)] = v[i];
    LDS_WAIT(); asm volatile("" ::: "memory");
    const int c = lane & 7;
#pragma unroll
    for (int j = 0; j < 4; ++j) { const int n = (lane >> 3) + 8 * j; const LAS float* s = scr + (8 * c) * 33 + n;
        u32x4 o; o.x = cvt_pk_bf16(s[0 * 33], s[1 * 33]); o.y = cvt_pk_bf16(s[2 * 33], s[3 * 33]); o.z = cvt_pk_bf16(s[4 * 33], s[5 * 33]); o.w = cvt_pk_bf16(s[6 * 33], s[7 * 33]);
        *(u32x4*)(dst + (size_t)n * ldd + 8 * c) = o; }
    LDS_WAIT(); asm volatile("" ::: "memory");
}

__device__ __forceinline__ void p0_transpose_item_fp8(const float* W, int ldw, int k0, int n0, const float* gs, float sc, unsigned char* dst, int ldd, LAS float* scr, int lane) {
    float v[32];
    const float* wp = W + (size_t)(k0 + (lane >> 5)) * ldw + n0 + (lane & 31);
#pragma unroll
    for (int i = 0; i < 32; ++i) v[i] = wp[(size_t)(2 * i) * ldw];
#pragma unroll
    for (int i = 0; i < 32; ++i) v[i] *= gs[k0 + 2 * i + (lane >> 5)] * sc;
#pragma unroll
    for (int i = 0; i < 32; ++i) scr[(2 * i + (lane >> 5)) * 33 + (lane & 31)] = v[i];
    LDS_WAIT(); asm volatile("" ::: "memory");
    const int n = lane >> 1, h = lane & 1; const LAS float* s = scr + (32 * h) * 33 + n;
    u32x4 o0, o1;
#pragma unroll
    for (int q = 0; q < 4; ++q) { o0[q] = pk4_fp8(s[(4 * q) * 33], s[(4 * q + 1) * 33], s[(4 * q + 2) * 33], s[(4 * q + 3) * 33]);
                                  o1[q] = pk4_fp8(s[(16 + 4 * q) * 33], s[(17 + 4 * q) * 33], s[(18 + 4 * q) * 33], s[(19 + 4 * q) * 33]); }
    unsigned char* d = dst + (size_t)n * ldd + 32 * h;
    *(u32x4*)d = o0; *(u32x4*)(d + 16) = o1;
    LDS_WAIT(); asm volatile("" ::: "memory");
}

__device__ __forceinline__ void p0_prologue(const Args& a, LAS unsigned char* lds, int gw, int NGW, int wave, int lane) {
    unsigned char* ws = a.ws;
    LAS float* scr = (LAS float*)(lds + wave * WAVE_LDS);
    constexpr int I_IN = (D / 64) * (IN_TOTAL / 32);
    constexpr int I_P = (512 / 64) * (D / 32);
    constexpr int I_O = (D / 64) * (D / 32);
    constexpr int I_LAYER = I_IN + 3 * I_P + I_O;
    for (int it = gw; it < DEPTH * I_LAYER; it += NGW) {
        const int l = it / I_LAYER; int r = it % I_LAYER;
        bf16_t* Wmix = (bf16_t*)(ws + WS_WMIX) + (size_t)l * NMIX * D;
        bf16_t* W3 = (bf16_t*)(ws + WS_W3) + (size_t)l * D * K3;
        bf16_t* WoT = (bf16_t*)(ws + WS_WO) + (size_t)l * D * D;
        if (r < I_IN) {
            const int kb = r / (IN_TOTAL / 32), nb = r % (IN_TOTAL / 32), k0 = 64 * kb, n0 = 32 * nb, seg = n0 / 512;
            const float* W = a.in[2] + (size_t)l * D * IN_TOTAL; const float* gs = a.in[1] + l * D;
            if (seg < 9) { const int dseg = (seg == 0) ? 0 : (seg == 1) ? 3 : (seg == 2) ? 4 : (seg == 3) ? 5 : (seg == 4) ? 6 : (seg == 5) ? 7 : (seg == 6) ? 1 : (seg == 7) ? 8 : 2;
                p0_transpose_item(W, IN_TOTAL, k0, n0, gs, Wmix + (size_t)(dseg * 512 + (n0 & 511)) * D + k0, D, scr, lane); }
            else { const int nn = n0 - NMIX;
                p0_transpose_item_fp8(W, IN_TOTAL, k0, n0, gs, WG8_SCALE, ws + WS_WG8 + (size_t)l * 3 * D * D + (size_t)nn * D + k0, D, scr, lane); }
            continue; }
        r -= I_IN;
        if (r < 3 * I_P) { const int br = r / I_P, q = r % I_P, kb = q / (D / 32), nb = q % (D / 32), k0 = 64 * kb, n0 = 32 * nb;
            const float* W = a.in[11 + br] + (size_t)l * 512 * D;
            p0_transpose_item(W, D, k0, n0, nullptr, W3 + (size_t)n0 * K3 + br * 512 + k0, K3, scr, lane); continue; }
        r -= 3 * I_P;
        { const int kb = r / (D / 32), nb = r % (D / 32), k0 = 64 * kb, n0 = 32 * nb;
          const float* W = a.in[14] + (size_t)l * D * D;
          p0_transpose_item(W, D, k0, n0, nullptr, WoT + (size_t)n0 * D + k0, D, scr, lane); }
    }
    { bf16_t* Wm = (bf16_t*)(ws + WS_WM); const float* w_s = a.in[5];
      for (int i = gw * 64 + lane; i < DEPTH * 8 * 128 * 128 / 2; i += NGW * 64) { const int e = 2 * i, s = e & 127, t = (e >> 7) & 127;
          const f32x2 v = *(const f32x2*)(w_s + e); ((unsigned*)Wm)[i] = cvt_pk_bf16(s <= t ? v.x : 0.f, s + 1 <= t ? v.y : 0.f); } }
    { bf16_t* Wp = (bf16_t*)(ws + WS_WPOOL); const float* w_pool = a.in[9]; const float* ps = a.in[10];
      for (int i = gw * 64 + lane; i < DEPTH * 4 * 128 * 128 / 2; i += NGW * 64) { const int e = 2 * i, c = e & 127, d = (e >> 7) & 127, lg = e >> 14;
          const float sc = ps[lg * 128 + d];
          ((unsigned*)Wp)[i] = cvt_pk_bf16(w_pool[(size_t)lg * 16384 + c * 128 + d] * sc, w_pool[(size_t)lg * 16384 + (c + 1) * 128 + d] * sc); } }
    { bf16_t* P = (bf16_t*)(ws + WS_P); float* rss = (float*)(ws + WS_RSS);
      for (int m4 = gw * 4; m4 < M; m4 += NGW * 4) {
          f32x4 v[4][4];
#pragma unroll
          for (int r = 0; r < 4; ++r) { const f32x4* xr = (const f32x4*)(a.in[0] + (size_t)(m4 + r) * D) + lane;
#pragma unroll
              for (int j = 0; j < 4; ++j) v[r][j] = xr[64 * j]; }
#pragma unroll
          for (int r = 0; r < 4; ++r) { float s = 0.f;
#pragma unroll
              for (int j = 0; j < 4; ++j) s += (v[r][j].x * v[r][j].x + v[r][j].y * v[r][j].y) + (v[r][j].z * v[r][j].z + v[r][j].w * v[r][j].w);
              s = wave_sum(s);
              u32x2* o = (u32x2*)(P + (size_t)(m4 + r) * PITCH + XB_COL) + lane;
#pragma unroll
              for (int j = 0; j < 4; ++j) { u32x2 w; w.x = cvt_pk_bf16(v[r][j].x, v[r][j].y); w.y = cvt_pk_bf16(v[r][j].z, v[r][j].w); o[64 * j] = w; }
              unsigned* o8 = (unsigned*)(ws + WS_XB8 + (size_t)(m4 + r) * D) + lane;
#pragma unroll
              for (int j = 0; j < 4; ++j) o8[64 * j] = pk4_fp8(v[r][j].x, v[r][j].y, v[r][j].z, v[r][j].w);
              if (lane < 16) rss[(size_t)(m4 + r) * 16 + lane] = (lane == 0) ? s : 0.f; }
      } }
}

__device__ __forceinline__ float row_rstd(const float* rss, int row, int fq) {
    const f32x4 p = *(const f32x4*)(rss + (size_t)row * 16 + fq * 4);
    float s = (p.x + p.y) + (p.z + p.w); s += __shfl_xor(s, 16); s += __shfl_xor(s, 32);
    return __builtin_amdgcn_rsqf(s * (1.0f / D) + RMS_EPS);
}
__device__ __forceinline__ float rstd_of(f32x4 p) { float s = (p.x + p.y) + (p.z + p.w); s += __shfl_xor(s, 16); s += __shfl_xor(s, 32); return __builtin_amdgcn_rsqf(s * (1.0f / D) + RMS_EPS); }
#define ZERO_ACC(acc) do { _Pragma("unroll") for (int _a = 0; _a < 2; ++_a) _Pragma("unroll") for (int _b = 0; _b < 2; ++_b) _Pragma("unroll") for (int _m = 0; _m < 4; ++_m) _Pragma("unroll") for (int _n = 0; _n < 2; ++_n) acc[_a][_b][_m][_n] = (f32x4){0.f, 0.f, 0.f, 0.f}; } while (0)

struct SchedP1 {
    pg8::TileOrder T; const char* P; const char* W;
    __device__ __forceinline__ bool next(int i, pg8::Unit& u) const { int pm, pn; if (!T.tile(i, pm, pn)) return false;
        u.pm = pm; u.pn = pn; u.kind = pn >> 1; u.nt = D / 64; u.A = P + ((size_t)pm * 256 * PITCH + XB_COL) * 2; u.B = W + (size_t)pn * 256 * D * 2; return true; }
};
struct EpiP1 {
    bf16_t* P; const float* rss; float* lns;
    __device__ __forceinline__ void operator()(f32x4 (&acc)[2][2][4][2], const pg8::Unit& u, int wr, int wc, int fr, int fq) const {
        const int seg = u.kind;
        const int act = (seg == 3) ? 1 : 0;
        unsigned lrow = (unsigned)(wr * 64 + fr); asm volatile("" : "+v"(lrow));
        const unsigned lp = (lrow * PITCH + (unsigned)(wc * 32) + 8u * (unsigned)fq) * 2u;
        const unsigned lr = lrow * 64u;
        const size_t up = (size_t)u.pm * 256 * PITCH + (size_t)u.pn * 256;
        const size_t ur = (size_t)u.pm * 256 * 16;
        f32x4 pr[2][4];
#pragma unroll
        for (int ai = 0; ai < 2; ++ai)
#pragma unroll
            for (int m = 0; m < 4; ++m) pr[ai][m] = *(const f32x4*)((const char*)(rss + ur + (ai * 128 + m * 16) * 16) + (lr + 16u * fq));
#pragma unroll
        for (int ai = 0; ai < 2; ++ai)
#pragma unroll
            for (int m = 0; m < 4; ++m) {
                const float rs = rstd_of(pr[ai][m]);
                float s1 = 0.f, s2 = 0.f;
#pragma unroll
                for (int bj = 0; bj < 2; ++bj) {
                    f32x4 v0 = acc[ai][bj][m][0] * rs, v1 = acc[ai][bj][m][1] * rs;
                    if (act == 1) {
#pragma unroll
                        for (int j = 0; j < 2; ++j) { const f32x2 g0 = gelu2((f32x2){v0[2 * j], v0[2 * j + 1]}), g1 = gelu2((f32x2){v1[2 * j], v1[2 * j + 1]});
                            v0[2 * j] = g0.x; v0[2 * j + 1] = g0.y; v1[2 * j] = g1.x; v1[2 * j + 1] = g1.y; } }
                    u32x4 w; w.x = cvt_pk_bf16(v0[0], v0[1]); w.y = cvt_pk_bf16(v0[2], v0[3]); w.z = cvt_pk_bf16(v1[0], v1[1]); w.w = cvt_pk_bf16(v1[2], v1[3]);
                    *(u32x4*)((char*)(P + up + (size_t)(ai * 128 + m * 16) * PITCH + bj * 128) + lp) = w;
                    if (seg == 3) {
#pragma unroll
                        for (int q = 0; q < 4; ++q) { const float lo = bf_lo(w[q]), hi = bf_hi(w[q]); s1 += lo + hi; s2 += lo * lo + hi * hi; } }
                }
                if (seg == 3) { s1 += __shfl_xor(s1, 16); s1 += __shfl_xor(s1, 32); s2 += __shfl_xor(s2, 16); s2 += __shfl_xor(s2, 32);
                    if (fq == 0) *(f32x2*)((char*)(lns + ur + (ai * 128 + m * 16) * 16 + ((u.pn - 6) * 4 + wc) * 2) + lr) = (f32x2){s1, s2}; }
            }
        ZERO_ACC(acc);
    }
};

struct SchedG {
    int x, r, n, c0, sq; const char* A8; const char* W8;
    __device__ __forceinline__ bool next(int i, pg8::Unit& u) const { if (i >= n) return false;
        int combo, pl;
        if (i < sq) { pl = 4 * i + (r & 3); combo = c0 + (r >> 2); } else { pl = r & 7; combo = c0 + (sq ? 4 : 0) + 2 * (i - sq) + (r >> 3); }
        const int gate = combo >> 2;
        u.pm = 8 * x + pl; u.pn = combo & 3; u.kind = gate; u.nt = D / 128;
        u.A = A8 + (size_t)u.pm * 256 * D; u.B = W8 + ((size_t)gate * D + (size_t)u.pn * 256) * D; return true; }
};
struct EpiP3G {
    unsigned char* S8; size_t gstride; unsigned rowb; const float* rss;
    __device__ __forceinline__ void operator()(f32x4 (&acc)[2][2][4][2], const pg8::Unit& u, int wr, int wc, int fr, int fq) const {
        unsigned lrow = (unsigned)(wr * 64 + fr); asm volatile("" : "+v"(lrow));
        const unsigned ls = lrow * rowb + (unsigned)(wc * 32) + 8u * (unsigned)fq;
        const unsigned lr = lrow * 64u;
        unsigned char* sb = S8 + (size_t)(u.pm >> 3) * GATE_GROUP_BYTES + (size_t)u.kind * gstride + (size_t)(u.pm & 7) * 256 * rowb + (size_t)u.pn * 256;
        const size_t ur = (size_t)u.pm * 256 * 16;
        f32x4 pr[2][4];
#pragma unroll
        for (int ai = 0; ai < 2; ++ai)
#pragma unroll
            for (int m = 0; m < 4; ++m) pr[ai][m] = *(const f32x4*)((const char*)(rss + ur + (ai * 128 + m * 16) * 16) + (lr + 16u * fq));
#pragma unroll
        for (int ai = 0; ai < 2; ++ai)
#pragma unroll
            for (int m = 0; m < 4; ++m) {
                const float rs = rstd_of(pr[ai][m]) * (-1.4426950409f / WG8_SCALE);
#pragma unroll
                for (int bj = 0; bj < 2; ++bj) { const f32x4 v0 = acc[ai][bj][m][0] * rs, v1 = acc[ai][bj][m][1] * rs;
                    unsigned w0 = 0u, w1 = 0u;
#pragma unroll
                    for (int j = 0; j < 4; ++j) { w0 = __builtin_amdgcn_cvt_pk_u8_f32(__builtin_amdgcn_rcpf(__builtin_fmaf(__builtin_amdgcn_exp2f(v0[j]), 1.0f / 255.0f, 1.0f / 255.0f)), j, w0);
                                                  w1 = __builtin_amdgcn_cvt_pk_u8_f32(__builtin_amdgcn_rcpf(__builtin_fmaf(__builtin_amdgcn_exp2f(v1[j]), 1.0f / 255.0f, 1.0f / 255.0f)), j, w1); }
                    w0 |= (((w0 - 0x01010101u) & ~w0) >> 7) & 0x01010101u; w1 |= (((w1 - 0x01010101u) & ~w1) >> 7) & 0x01010101u;
                    *(u32x2*)(sb + (size_t)(ai * 128 + m * 16) * rowb + bj * 128 + ls) = (u32x2){w0, w1}; }
            }
        ZERO_ACC(acc);
    }
};
struct SchedP3Y {
    int pm, pn; const char* P; const char* W;
    __device__ __forceinline__ bool next(int i, pg8::Unit& u) const { if (i >= 3) return false;
        u.pm = pm; u.pn = pn; u.kind = i; u.nt = 512 / 64;
        u.A = P + ((size_t)pm * 256 * PITCH + (size_t)i * 512) * 2; u.B = W + ((size_t)pn * 256 * K3 + (size_t)i * 512) * 2; return true; }
};
struct EpiP3Y {
    bf16_t* P; const unsigned char* S8; size_t gstride; unsigned rowb;
    __device__ __forceinline__ void operator()(f32x4 (&acc)[2][2][4][2], const pg8::Unit& u, int wr, int wc, int fr, int fq) const {
        const int j = u.kind; const bool fin = (j == 2);
        unsigned lrow = (unsigned)(wr * 64 + fr); asm volatile("" : "+v"(lrow));
        const unsigned ls = lrow * rowb + (unsigned)(wc * 32) + 8u * (unsigned)fq;
        const unsigned lp = (lrow * PITCH + (unsigned)(wc * 32) + 8u * (unsigned)fq) * 2u;
        const unsigned char* sb = S8 + (size_t)(u.pm >> 3) * GATE_GROUP_BYTES + (size_t)(u.pm & 7) * 256 * rowb + (size_t)u.pn * 256;
        const unsigned char* pn_ = sb + (size_t)j * gstride; const unsigned char* pd_ = sb + (size_t)(fin ? 2 : j + 1) * gstride;
        bf16_t* pmg = P + (size_t)u.pm * 256 * PITCH + C_MERGED + (size_t)u.pn * 256;
#pragma unroll
        for (int ai = 0; ai < 2; ++ai)
#pragma unroll
        for (int mh = 0; mh < 2; ++mh) {
            u32x2 sn[2][2], sd[2][2];
#pragma unroll
            for (int mm = 0; mm < 2; ++mm)
#pragma unroll
                for (int bj = 0; bj < 2; ++bj) { const size_t ro = (size_t)(ai * 128 + (mh * 2 + mm) * 16) * rowb + bj * 128;
                    sn[mm][bj] = *(const u32x2*)(pn_ + ro + ls); sd[mm][bj] = *(const u32x2*)(pd_ + ro + ls); }
#pragma unroll
            for (int mm = 0; mm < 2; ++mm)
#pragma unroll
                for (int bj = 0; bj < 2; ++bj) { const int m = mh * 2 + mm;
#pragma unroll
                    for (int n = 0; n < 2; ++n) { const unsigned sdw = fin ? 0xffffffffu : sd[mm][bj][n];
#pragma unroll
                        for (int e = 0; e < 4; ++e) { const float qn = (float)((sn[mm][bj][n] >> (8 * e)) & 0xffu), qd = (float)((sdw >> (8 * e)) & 0xffu);
                            acc[ai][bj][m][n][e] *= qn * __builtin_amdgcn_rcpf(qd); } }
                    if (fin) { const f32x4 v0 = acc[ai][bj][m][0], v1 = acc[ai][bj][m][1];
                        u32x4 w; w.x = cvt_pk_bf16(v0[0], v0[1]); w.y = cvt_pk_bf16(v0[2], v0[3]); w.z = cvt_pk_bf16(v1[0], v1[1]); w.w = cvt_pk_bf16(v1[2], v1[3]);
                        *(u32x4*)((char*)(pmg + (size_t)(ai * 128 + m * 16) * PITCH + bj * 128) + lp) = w; } }
        }
    }
};

struct SchedP4 {
    pg8::TileOrder T; const char* P; const char* W;
    __device__ __forceinline__ bool next(int i, pg8::Unit& u) const { int pm, pn; if (!T.tile(i, pm, pn)) return false;
        u.pm = pm; u.pn = pn; u.kind = 0; u.nt = D / 64; u.A = P + ((size_t)pm * 256 * PITCH + C_MERGED) * 2; u.B = W + (size_t)pn * 256 * D * 2; return true; }
};
struct EpiP4 {
    bf16_t* P; float* rss_out; unsigned char* xb8;
    __device__ __forceinline__ void operator()(f32x4 (&acc)[2][2][4][2], const pg8::Unit& u, int wr, int wc, int fr, int fq) const {
        unsigned lrow = (unsigned)(wr * 64 + fr); asm volatile("" : "+v"(lrow));
        const unsigned lc = (unsigned)(wc * 32) + 8u * (unsigned)fq;
        const unsigned lp = (lrow * PITCH + lc) * 2u, lx = (lrow * D + lc) * 4u, l8 = lrow * D + lc;
        const size_t ux = (size_t)u.pm * 256 * D + (size_t)u.pn * 256;
        bf16_t* pb = P + (size_t)u.pm * 256 * PITCH + (size_t)u.pn * 256 + XB_COL;
        float* rb = rss_out + (size_t)u.pm * 256 * 16 + u.pn * 4 + wc;
#pragma unroll
        for (int ai = 0; ai < 2; ++ai)
#pragma unroll
        for (int mh = 0; mh < 2; ++mh) {
            u32x4 hv[2][2];
#pragma unroll
            for (int mm = 0; mm < 2; ++mm)
#pragma unroll
                for (int bj = 0; bj < 2; ++bj) hv[mm][bj] = *(const u32x4*)((const char*)(pb + (size_t)(ai * 128 + (mh * 2 + mm) * 16) * PITCH + bj * 128) + lp);
#pragma unroll
            for (int mm = 0; mm < 2; ++mm) {
                const int m = mh * 2 + mm; float ss = 0.f;
#pragma unroll
                for (int bj = 0; bj < 2; ++bj) { const size_t ro = (size_t)(ai * 128 + m * 16) * D + bj * 128;
                    const f32x4 v0 = (f32x4){bf_lo(hv[mm][bj].x), bf_hi(hv[mm][bj].x), bf_lo(hv[mm][bj].y), bf_hi(hv[mm][bj].y)} + acc[ai][bj][m][0], v1 = (f32x4){bf_lo(hv[mm][bj].z), bf_hi(hv[mm][bj].z), bf_lo(hv[mm][bj].w), bf_hi(hv[mm][bj].w)} + acc[ai][bj][m][1];
                    ss += (v0[0] * v0[0] + v0[1] * v0[1]) + (v0[2] * v0[2] + v0[3] * v0[3]) + (v1[0] * v1[0] + v1[1] * v1[1]) + (v1[2] * v1[2] + v1[3] * v1[3]);
                    u32x4 w; w.x = cvt_pk_bf16(v0[0], v0[1]); w.y = cvt_pk_bf16(v0[2], v0[3]); w.z = cvt_pk_bf16(v1[0], v1[1]); w.w = cvt_pk_bf16(v1[2], v1[3]);
                    *(u32x4*)((char*)(pb + (size_t)(ai * 128 + m * 16) * PITCH + bj * 128) + lp) = w;
                    *(u32x2*)((xb8 + ux + ro) + l8) = (u32x2){pk4_fp8(v0[0], v0[1], v0[2], v0[3]), pk4_fp8(v1[0], v1[1], v1[2], v1[3])};
 }
                ss += __shfl_xor(ss, 16); ss += __shfl_xor(ss, 32);
                if (fq == 0) *(float*)((char*)(rb + (ai * 128 + m * 16) * 16) + lrow * 64u) = ss;
            }
        }
        ZERO_ACC(acc);
    }
};

struct EpiP4F {

    const bf16_t* P; float* out; float* rss_out; const float* fg; unsigned* cnt; unsigned* tmo;
    __device__ __forceinline__ void operator()(f32x4 (&acc)[2][2][4][2], const pg8::Unit& u, int wr, int wc, int fr, int fq) const {
        unsigned lrow = (unsigned)(wr * 64 + fr); asm volatile("" : "+v"(lrow));
        const unsigned lc = (unsigned)(wc * 32) + 8u * (unsigned)fq;
        const unsigned lx = (lrow * D + lc) * 4u;
        const unsigned lp = (lrow * PITCH + lc) * 2u, l8 = lrow * D + lc;
        const bf16_t* pxb = P + (size_t)u.pm * 256 * PITCH + (size_t)u.pn * 256 + XB_COL;
        const size_t ux = (size_t)u.pm * 256 * D + (size_t)u.pn * 256;
        float* rb = rss_out + (size_t)u.pm * 256 * 16 + u.pn * 4 + wc;
#pragma unroll
        for (int ai = 0; ai < 2; ++ai)
#pragma unroll
        for (int mh = 0; mh < 2; ++mh) {
            f32x4 xo[2][2][2]; u32x4 hv[2][2];
#pragma unroll
            for (int mm = 0; mm < 2; ++mm)
#pragma unroll
                for (int bj = 0; bj < 2; ++bj) hv[mm][bj] = *(const u32x4*)((const char*)(pxb + (size_t)(ai * 128 + (mh * 2 + mm) * 16) * PITCH + bj * 128) + lp);
#pragma unroll
            for (int mm = 0; mm < 2; ++mm)
#pragma unroll
                for (int bj = 0; bj < 2; ++bj)
#pragma unroll
                    for (int n = 0; n < 2; ++n) xo[mm][bj][n] = (f32x4){bf_lo(hv[mm][bj][2 * n]), bf_hi(hv[mm][bj][2 * n]), bf_lo(hv[mm][bj][2 * n + 1]), bf_hi(hv[mm][bj][2 * n + 1])};
#pragma unroll
            for (int mm = 0; mm < 2; ++mm) {
                const int m = mh * 2 + mm; float ss = 0.f;
#pragma unroll
                for (int bj = 0; bj < 2; ++bj) { const f32x4 v0 = xo[mm][bj][0] + acc[ai][bj][m][0], v1 = xo[mm][bj][1] + acc[ai][bj][m][1];
                    acc[ai][bj][m][0] = v0; acc[ai][bj][m][1] = v1;
                    ss += (v0[0] * v0[0] + v0[1] * v0[1]) + (v0[2] * v0[2] + v0[3] * v0[3]) + (v1[0] * v1[0] + v1[1] * v1[1]) + (v1[2] * v1[2] + v1[3] * v1[3]); }
                ss += __shfl_xor(ss, 16); ss += __shfl_xor(ss, 32);
                if (fq == 0) __hip_atomic_store((float*)((char*)(rb + (ai * 128 + m * 16) * 16) + lrow * 64u), ss, __ATOMIC_RELAXED, __HIP_MEMORY_SCOPE_AGENT);
            }
        }
        asm volatile("s_waitcnt vmcnt(0)" ::: "memory");
        const int lane = (int)(threadIdx.x & 63); const int wid = wr * 4 + wc;
        unsigned* pc = cnt + 64 * u.pm;
        if (lane == 0) __hip_atomic_fetch_add(pc, 1u, __ATOMIC_RELAXED, __HIP_MEMORY_SCOPE_AGENT);
        if (wid == 0) {
            asm volatile("buffer_inv sc1" ::: "memory");
            unsigned sp = 0;
            while ((unsigned)__builtin_amdgcn_readfirstlane(__hip_atomic_load(pc, __ATOMIC_RELAXED, __HIP_MEMORY_SCOPE_AGENT)) < 32u) {
                __builtin_amdgcn_s_sleep(1);
                if ((++sp & 255u) == 0u) { if (__hip_atomic_load(tmo, __ATOMIC_RELAXED, __HIP_MEMORY_SCOPE_AGENT)) break; if (sp > (1u << 20)) { if (lane == 0) atomicAdd(tmo, 1u); break; } } }
            asm volatile("s_waitcnt vmcnt(0)" ::: "memory");
        }
        asm volatile("" ::: "memory"); __builtin_amdgcn_s_barrier(); asm volatile("" ::: "memory");
        const unsigned lr = lrow * 64u;
        const size_t ur = (size_t)u.pm * 256 * 16;
        f32x4 pr[2][4];
#pragma unroll
        for (int ai = 0; ai < 2; ++ai)
#pragma unroll
            for (int m = 0; m < 4; ++m) pr[ai][m] = *(const f32x4*)((const char*)(rss_out + ur + (ai * 128 + m * 16) * 16) + (lr + 16u * fq));
        f32x4 gv[2][2];
#pragma unroll
        for (int bj = 0; bj < 2; ++bj) { const float* gp = (const float*)((const char*)(fg + u.pn * 256 + bj * 128) + lc * 4u); gv[bj][0] = *(const f32x4*)gp; gv[bj][1] = *(const f32x4*)(gp + 4); }
#pragma unroll
        for (int ai = 0; ai < 2; ++ai)
#pragma unroll
            for (int m = 0; m < 4; ++m) { const float rs = rstd_of(pr[ai][m]);
#pragma unroll
                for (int bj = 0; bj < 2; ++bj) { float* xq = (float*)((char*)(out + ux + (size_t)(ai * 128 + m * 16) * D + bj * 128) + lx);
                    *(f32x4*)xq = acc[ai][bj][m][0] * rs * gv[bj][0]; *(f32x4*)(xq + 4) = acc[ai][bj][m][1] * rs * gv[bj][1]; } }
        ZERO_ACC(acc);
    }
};

#define LDG(T, uptr, lboff) (*(const T*)((const char*)(uptr) + (lboff)))
#define STG(T, uptr, lboff, val) (*(T*)((char*)(uptr) + (lboff)) = (val))
typedef short s16x4 __attribute__((ext_vector_type(4)));
__device__ __forceinline__ s16x4 lds_tr16(const LAS void* p) { return __builtin_amdgcn_ds_read_tr16_b64_v4i16((LAS s16x4*)p); }
template <int TH> __device__ __forceinline__ void mixer_a_body(bf16_t* P, const float* lns, const bf16_t* Wm, const float* ln_g, const float* ln_b, const float* b_s, LAS unsigned char* wl, int n, int g, int lane) {
    constexpr int SLEN = 64 * (TH + 1), NV = SLEN / 8, NKS = 2 * (TH + 1);
    const int T0 = n * 128;
    constexpr int VB = 136;
    constexpr int OB = 272;
    const int ck = lane & 7, rsub = lane >> 3;
    const int fr = lane & 15, fq = lane >> 4;
    const unsigned lv = (unsigned)(rsub * PITCH + ck * 8) * 2u;
    const unsigned lw = (unsigned)(fr * 128 + fq * 8) * 2u;
    const bf16_t* pv = P + (size_t)T0 * PITCH + C_V + g * 64;
    u32x4 raw[NV];
#pragma unroll
    for (int q = 0; q < NV; ++q) raw[q] = LDG(u32x4, pv + (size_t)(q * 8) * PITCH, lv);
    f32x4 st[TH + 1][4];
#pragma unroll
    for (int h = 0; h <= TH; ++h)
#pragma unroll
        for (int j = 0; j < 4; ++j) st[h][j] = LDG(f32x4, lns + (size_t)(T0 + 64 * h) * 16 + 4 * j, (unsigned)lane * 64u);
    float lg[8], lb[8];
    { const f32x4 g0 = LDG(f32x4, ln_g + g * 64, (unsigned)ck * 32u), g1 = LDG(f32x4, ln_g + g * 64 + 4, (unsigned)ck * 32u), b0 = LDG(f32x4, ln_b + g * 64, (unsigned)ck * 32u), b1 = LDG(f32x4, ln_b + g * 64 + 4, (unsigned)ck * 32u);
#pragma unroll
      for (int j = 0; j < 4; ++j) { lg[j] = g0[j]; lg[4 + j] = g1[j]; lb[j] = b0[j]; lb[4 + j] = b1[j]; } }
    float mean[TH + 1], rstd[TH + 1];
#pragma unroll
    for (int h = 0; h <= TH; ++h) { const f32x4 a = st[h][0], b = st[h][1], c = st[h][2], d = st[h][3];
        const float s1 = (a.x + a.z) + (b.x + b.z) + (c.x + c.z) + (d.x + d.z), s2 = (a.y + a.w) + (b.y + b.w) + (c.y + c.w) + (d.y + d.w);
        mean[h] = s1 * (1.f / 512.f); rstd[h] = __builtin_amdgcn_rsqf(fmaxf(s2 * (1.f / 512.f) - mean[h] * mean[h], 0.f) + LN_EPS); }
#pragma unroll
    for (int q = 0; q < NV; ++q) { const int s = q * 8 + rsub;
        const float mu = __shfl(mean[(q * 8) >> 6], s & 63), rs = __shfl(rstd[(q * 8) >> 6], s & 63);
        unsigned pk[4];
#pragma unroll
        for (int j = 0; j < 4; ++j) pk[j] = cvt_pk_bf16((bf_lo(raw[q][j]) - mu) * rs * lg[2 * j] + lb[2 * j], (bf_hi(raw[q][j]) - mu) * rs * lg[2 * j + 1] + lb[2 * j + 1]);
        LAS unsigned char* wp = wl + s * VB + ck * 16;
        *(LAS u32x2*)wp = (u32x2){pk[0], pk[1]}; *(LAS u32x2*)(wp + 8) = (u32x2){pk[2], pk[3]}; }
    LDS_WAIT(); asm volatile("" ::: "memory");
    f32x4 acc[4][4];
#pragma unroll
    for (int ct = 0; ct < 4; ++ct)
#pragma unroll
        for (int tt = 0; tt < 4; ++tt) acc[ct][tt] = (f32x4){0.f, 0.f, 0.f, 0.f};
    const bf16_t* wmg = Wm + (size_t)g * 128 * 128 + (size_t)(64 * TH) * 128;
    const LAS unsigned char* trp = wl + (8 * fq + (fr >> 2)) * VB + (fr & 3) * 8;
#pragma unroll 1
    for (int ks = 0; ks < NKS; ++ks) {
        bf16x8 af[4], bfr[4];
#pragma unroll
        for (int tt = 0; tt < 4; ++tt) bfr[tt] = LDG(bf16x8, wmg + (16 * tt) * 128 + ks * 32, lw);
#pragma unroll
        for (int ct = 0; ct < 4; ++ct) { const s16x4 a0 = lds_tr16(trp + (ks * 32) * VB + ct * 32), a1 = lds_tr16(trp + (ks * 32 + 4) * VB + ct * 32);
            af[ct] = (bf16x8){a0[0], a0[1], a0[2], a0[3], a1[0], a1[1], a1[2], a1[3]}; }
#pragma unroll
        for (int ct = 0; ct < 4; ++ct)
#pragma unroll
            for (int tt = 0; tt < 4; ++tt) acc[ct][tt] = __builtin_amdgcn_mfma_f32_16x16x32_bf16(af[ct], bfr[tt], acc[ct][tt], 0, 0, 0);
    }
    LDS_WAIT(); asm volatile("" ::: "memory");
#pragma unroll
    for (int tt = 0; tt < 4; ++tt)
#pragma unroll
        for (int ct = 0; ct < 4; ++ct) *(LAS f32x4*)(wl + (16 * tt + fr) * OB + (16 * ct + 4 * fq) * 4) = acc[ct][tt];
    LDS_WAIT(); asm volatile("" ::: "memory");
    bf16_t* po = P + (size_t)(T0 + 64 * TH) * PITCH + g * 64;
    const float* bsp = b_s + g * 128 + 64 * TH;
#pragma unroll
    for (int hf = 0; hf < 2; ++hf) {
        u32x4 uu[4], zz[4]; float bs[4];
#pragma unroll
        for (int q = 0; q < 4; ++q) { uu[q] = LDG(u32x4, po + (size_t)((hf * 4 + q) * 8) * PITCH + C_U, lv); zz[q] = LDG(u32x4, po + (size_t)((hf * 4 + q) * 8) * PITCH + C_ZA, lv);
            bs[q] = LDG(float, bsp + (hf * 4 + q) * 8, (unsigned)rsub * 4u); }
#pragma unroll
        for (int q = 0; q < 4; ++q) { const int t = (hf * 4 + q) * 8 + rsub;
            const f32x4 s0 = *(const LAS f32x4*)(wl + t * OB + ck * 32), s1 = *(const LAS f32x4*)(wl + t * OB + ck * 32 + 16);
            u32x4 w;
#pragma unroll
            for (int j = 0; j < 4; ++j) { const f32x2 s2 = (j < 2 ? (f32x2){s0[2 * j], s0[2 * j + 1]} : (f32x2){s1[2 * j - 4], s1[2 * j - 3]}) + bs[q];
                const f32x2 o = gelu2(bf2(uu[q][j])) * s2 * silu2(bf2(zz[q][j]));
                w[j] = cvt_pk_bf16(o.x, o.y); }
            STG(u32x4, po + (size_t)((hf * 4 + q) * 8) * PITCH + C_U, lv, w); }
    }
    LDS_WAIT(); asm volatile("" ::: "memory");
}
__device__ __forceinline__ void mixer_a_item(bf16_t* P, const float* lns, const bf16_t* Wm, const float* ln_g, const float* ln_b, const float* b_s, LAS unsigned char* wl, int item, int lane) {
    const int th = item & 1, g = (item >> 1) & 7, n = item >> 4;
    if (th) mixer_a_body<1>(P, lns, Wm, ln_g, ln_b, b_s, wl, n, g, lane); else mixer_a_body<0>(P, lns, Wm, ln_g, ln_b, b_s, wl, n, g, lane);
}

__device__ __forceinline__ void mixer_b_item(bf16_t* P, const float* conv_w, const float* conv_b, int item, int lane) {
    const int hb = item & 1, t0 = (item >> 1) * 16;
    const bool seq_start = (t0 % SEQ) == 0;
    bf16_t* pbase = P + (size_t)t0 * PITCH + hb * 256;
    const unsigned l8 = (unsigned)lane * 8u, l16 = (unsigned)lane * 16u;
    const f32x4 w0 = LDG(f32x4, conv_w + hb * 256, l16), w1 = LDG(f32x4, conv_w + 512 + hb * 256, l16), w2 = LDG(f32x4, conv_w + 1024 + hb * 256, l16), cb = LDG(f32x4, conv_b + hb * 256, l16);
    f32x4 pm2 = (f32x4){0.f, 0.f, 0.f, 0.f}, pm1 = pm2;
#pragma unroll
    for (int hf = 0; hf < 2; ++hf) {
        u32x2 xx[10], cc[10], bb[8], zz[8];
#pragma unroll
        for (int r = (hf ? 2 : 0); r < 10; ++r) { const int dt = hf * 8 + r - 2; const bool ok = (dt >= 0) || !seq_start;
            xx[r] = ok ? LDG(u32x2, pbase + (ptrdiff_t)dt * PITCH + C_XB, l8) : (u32x2){0u, 0u}; cc[r] = ok ? LDG(u32x2, pbase + (ptrdiff_t)dt * PITCH + C_CG, l8) : (u32x2){0u, 0u}; }
#pragma unroll
        for (int r = 0; r < 8; ++r) { bb[r] = LDG(u32x2, pbase + (size_t)(hf * 8 + r) * PITCH + C_BG, l8); zz[r] = LDG(u32x2, pbase + (size_t)(hf * 8 + r) * PITCH + C_ZB, l8); }
        if (hf == 0) {
            pm2 = (f32x4){bf_lo(xx[0].x) * bf_lo(cc[0].x), bf_hi(xx[0].x) * bf_hi(cc[0].x), bf_lo(xx[0].y) * bf_lo(cc[0].y), bf_hi(xx[0].y) * bf_hi(cc[0].y)};
            pm1 = (f32x4){bf_lo(xx[1].x) * bf_lo(cc[1].x), bf_hi(xx[1].x) * bf_hi(cc[1].x), bf_lo(xx[1].y) * bf_lo(cc[1].y), bf_hi(xx[1].y) * bf_hi(cc[1].y)}; }
#pragma unroll
        for (int r = 0; r < 8; ++r) {
            const f32x4 p0 = (f32x4){bf_lo(xx[r + 2].x) * bf_lo(cc[r + 2].x), bf_hi(xx[r + 2].x) * bf_hi(cc[r + 2].x), bf_lo(xx[r + 2].y) * bf_lo(cc[r + 2].y), bf_hi(xx[r + 2].y) * bf_hi(cc[r + 2].y)};
            const f32x4 y = cb + w0 * pm2 + w1 * pm1 + w2 * p0;
            const f32x4 bg = (f32x4){bf_lo(bb[r].x), bf_hi(bb[r].x), bf_lo(bb[r].y), bf_hi(bb[r].y)};
            const f32x2 zb0 = silu2(bf2(zz[r].x)), zb1 = silu2(bf2(zz[r].y)); const f32x4 zb = (f32x4){zb0.x, zb0.y, zb1.x, zb1.y};
            const f32x4 o = bg * y * zb;
            u32x2 w; w.x = cvt_pk_bf16(o[0], o[1]); w.y = cvt_pk_bf16(o[2], o[3]); STG(u32x2, pbase + (size_t)(hf * 8 + r) * PITCH + C_ZB, l8, w);
            pm2 = pm1; pm1 = p0; }
    }
}

template <int W> __device__ __forceinline__ void mixer_c_pool(const bf16_t* pxc  , LAS bf16_t* pl, int PL_LD, int tseq, int lane) {
    constexpr int NR = 31 + W;
    unsigned xv[NR];
#pragma unroll
    for (int r = 0; r < NR; ++r) { const int dt = r - (W - 1); xv[r] = (dt >= 0 || tseq > 0) ? LDG(unsigned, pxc + (ptrdiff_t)dt * PITCH, (unsigned)lane * 4u) : 0u; }
    float s0 = 0.f, s1 = 0.f;
#pragma unroll
    for (int r = 0; r < NR; ++r) {
        const int dt = r - (W - 1);
        s0 += bf_lo(xv[r]); s1 += bf_hi(xv[r]);
        if (r >= W) { s0 -= bf_lo(xv[r - W]); s1 -= bf_hi(xv[r - W]); }
        if (dt >= 0) { const int pos = tseq + dt; const float inv = 1.0f / (float)((pos + 1 < W) ? (pos + 1) : W);
            *(LAS unsigned*)(pl + dt * PL_LD + 2 * lane) = cvt_pk_bf16(s0 * inv - bf_lo(xv[r]), s1 * inv - bf_hi(xv[r])); }
    }
}
__device__ __forceinline__ void mixer_c_item(bf16_t* P, const bf16_t* WpT, LAS unsigned char* wl, int item, int lane) {
    const int gi = item & 3, t0 = (item >> 2) * 32;
    constexpr int PL_LD = 136;
    constexpr int OB = 528;
    LAS bf16_t* pl = (LAS bf16_t*)wl;
    const bf16_t* pxc = P + (size_t)t0 * PITCH + C_XC + gi * 128; const int tseq = t0 % SEQ;
    if (gi == 0) mixer_c_pool<2>(pxc, pl, PL_LD, tseq, lane);
    else if (gi == 1) mixer_c_pool<4>(pxc, pl, PL_LD, tseq, lane);
    else if (gi == 2) mixer_c_pool<8>(pxc, pl, PL_LD, tseq, lane);
    else mixer_c_pool<16>(pxc, pl, PL_LD, tseq, lane);
    LDS_WAIT(); asm volatile("" ::: "memory");
    const int fr = lane & 15, fq = lane >> 4;
    const unsigned lw = (unsigned)(fr * 128 + fq * 8) * 2u;
    bf16x8 bfr[2][4];
#pragma unroll
    for (int tt = 0; tt < 2; ++tt)
#pragma unroll
        for (int ks = 0; ks < 4; ++ks) bfr[tt][ks] = *(const LAS bf16x8*)(pl + (tt * 16 + fr) * PL_LD + ks * 32 + fq * 8);
    LDS_WAIT(); asm volatile("" ::: "memory");
    const bf16_t* wg = WpT + (size_t)gi * 128 * 128;
#pragma unroll 2
    for (int dp = 0; dp < 4; ++dp) {
        bf16x8 af[2][4];
#pragma unroll
        for (int d2 = 0; d2 < 2; ++d2)
#pragma unroll
            for (int ks = 0; ks < 4; ++ks) af[d2][ks] = LDG(bf16x8, wg + (size_t)((dp * 2 + d2) * 16) * 128 + ks * 32, lw);
#pragma unroll
        for (int d2 = 0; d2 < 2; ++d2) {
            f32x4 a0 = (f32x4){0.f, 0.f, 0.f, 0.f}, a1 = a0;
#pragma unroll
            for (int ks = 0; ks < 4; ++ks) { a0 = __builtin_amdgcn_mfma_f32_16x16x32_bf16(af[d2][ks], bfr[0][ks], a0, 0, 0, 0); a1 = __builtin_amdgcn_mfma_f32_16x16x32_bf16(af[d2][ks], bfr[1][ks], a1, 0, 0, 0); }
            *(LAS f32x4*)(wl + fr * OB + ((dp * 2 + d2) * 16 + 4 * fq) * 4) = a0; *(LAS f32x4*)(wl + (16 + fr) * OB + ((dp * 2 + d2) * 16 + 4 * fq) * 4) = a1; }
    }
    LDS_WAIT(); asm volatile("" ::: "memory");
    bf16_t* pz = P + (size_t)t0 * PITCH + C_ZC + gi * 128;
    const int r4 = lane >> 4, c16 = lane & 15;
    const unsigned lz = (unsigned)(r4 * PITCH + c16 * 8) * 2u;
    u32x4 zv[8];
#pragma unroll
    for (int q = 0; q < 8; ++q) zv[q] = LDG(u32x4, pz + (size_t)(q * 4) * PITCH, lz);
#pragma unroll
    for (int q = 0; q < 8; ++q) { const int t = q * 4 + r4;
        const f32x4 s0 = *(const LAS f32x4*)(wl + t * OB + c16 * 32), s1 = *(const LAS f32x4*)(wl + t * OB + c16 * 32 + 16);
        u32x4 w;
#pragma unroll
        for (int j = 0; j < 4; ++j) { const float sa = (j < 2 ? s0[2 * j] : s1[2 * j - 4]), sb = (j < 2 ? s0[2 * j + 1] : s1[2 * j - 3]);
            { const f32x2 o = (f32x2){sa, sb} * silu2(bf2(zv[q][j])); w[j] = cvt_pk_bf16(o.x, o.y); } }
        STG(u32x4, pz + (size_t)(q * 4) * PITCH, lz, w); }
    LDS_WAIT(); asm volatile("" ::: "memory");
}

__global__ void __launch_bounds__(NWAVES * 64, 2) hybrid_fwd(Args args) {
    extern __shared__ __attribute__((aligned(16))) unsigned char lds_raw[];
    LAS unsigned char* lds = (LAS unsigned char*)lds_raw;
    volatile LAS unsigned* MISC = (volatile LAS unsigned*)(lds + MISC_OFF);
    const int tid = threadIdx.x, lane = tid & 63, wave = __builtin_amdgcn_readfirstlane(tid >> 6);
    const int G = gridDim.x; const int bx = blockIdx.x;
    const int vcu = (G % 8 == 0) ? (bx % 8) * (G / 8) + bx / 8 : bx;
    const int gw = vcu * NWAVES + wave, NGW = G * NWAVES;
    unsigned char* ws = args.ws;
    for (int u = tid; u < (LDS_BYTES - LDSCTL_OFF) / 4; u += NWAVES * 64) ((LAS unsigned*)(lds + LDSCTL_OFF))[u] = 0u;
    __syncthreads();
    const XcdBarrier bar = xcd_barrier_post((unsigned*)(ws + WS_CTL), MISC + 8, (unsigned)G);
    (void)xcd_barrier_post((unsigned*)(ws + WS_CTL) + (1 + (bx & 7)) * XCD_BAR_WORDS, MISC + 10, (unsigned)(G / 8));
    const int lo = args.ph_lo, hi = args.ph_hi;
#define IN(k) (lo <= (k) && (k) < hi)
#define SEAM(k) do { if (IN(k) && IN((k) + 1)) xcd_barrier(bar); } while (0)
#define CW_PROG 47104
#define GSEAM_W(k, nbr, tgt) GSEAM_X(k, nbr, tgt, false)
#define GSEAM_X(k, nbr, tgt, loc) do { if (IN(k) && IN((k) + 1)) { XcdBarrier gb; gb.bar = (unsigned*)(args.ws + WS_CTL) + (1 + ((int)blockIdx.x & 7)) * XCD_BAR_WORDS; gb.x = bar.x; gb.st = MISC + 10; gb.G = gridDim.x / 8; \
        unsigned* pw_ = (unsigned*)(args.ws + WS_CTL) + CW_PROG; const int nb_ = (nbr); \
        xcd_barrier(gb, nb_ >= 0 ? pw_ + 64 * nb_ : nullptr, (unsigned)(tgt), ((int)blockIdx.x >> 3) == 0 ? pw_ + 64 * ((int)blockIdx.x & 7) : nullptr, (loc)); } } while (0)
#define GSEAM(k) GSEAM_X(k, -1, 0, true)

    bf16_t* P = (bf16_t*)(ws + WS_P);
    float* rss = (float*)(ws + WS_RSS);
    float* lns = (float*)(ws + WS_LNS);

    if (IN(0)) { p0_prologue(args, lds, gw, NGW, wave, lane); }
    SEAM(0);

    for (int l = 0; l < DEPTH; ++l) {
        const int pb = 1 + 4 * l;
        const bf16_t* Wmix = (const bf16_t*)(ws + WS_WMIX) + (size_t)l * NMIX * D;
        const bf16_t* W3 = (const bf16_t*)(ws + WS_W3) + (size_t)l * D * K3;
        const bf16_t* WoT = (const bf16_t*)(ws + WS_WO) + (size_t)l * D * D;
        const float* rss_l = rss + (size_t)l * M * 16;
        if (IN(pb)) {
            const int jg = bx >> 3; const bool five = (G == 256) && (bx < 128);
            for (int pass = 0; pass < 2; ++pass) {
                if ((pass == 0) != five) {
                    SchedG S; S.x = bx & 7; S.r = jg & 15; S.n = five ? 1 : 2; S.c0 = five ? 4 : 0; S.sq = five ? 0 : 2;     S.A8 = (const char*)(ws + WS_XB8); S.W8 = (const char*)(ws + WS_WG8 + (size_t)l * 3 * D * D);
                    EpiP3G E{(unsigned char*)args.out, GATE_PLANE_BYTES, (unsigned)D, rss_l};
                    pg8::gemm_phase<EpiP3G, SchedG, true, true>(lds, D, D, S, E);
                } else {
                    SchedP1 S; S.T.init(M, NMIX, G, bx, P1_WGM); S.P = (const char*)P; S.W = (const char*)Wmix;
                    EpiP1 E{P, rss_l, lns};
                    pg8::gemm_phase<EpiP1, SchedP1, true>(lds, PITCH * 2, D * 2, S, E);
                }
            }
        }
        GSEAM_W(pb, (bx & 3) != 0 ? (bx & 7) - 1 : -1, 1 + 4 * l);
        if (IN(pb + 1)) {
            const bf16_t* Wm = (const bf16_t*)(ws + WS_WM) + (size_t)l * 8 * 128 * 128;
            const bf16_t* WpT = (const bf16_t*)(ws + WS_WPOOL) + (size_t)l * 4 * 128 * 128;
            LAS unsigned char* wl = lds + wave * WAVE_LDS;
            int ln = lane; asm volatile("" : "+v"(ln));
            { const int x = bx & 7, e = bx >> 3;
              SchedG S; S.x = x; S.r = e & 15; S.A8 = (const char*)(ws + WS_XB8); S.W8 = (const char*)(ws + WS_WG8 + (size_t)l * 3 * D * D);
              EpiP3G E{(unsigned char*)args.out, GATE_PLANE_BYTES, (unsigned)D, rss_l};
              if (G != 256) { for (int li = e * NWAVES + wave; li < 768; li += (G / 8) * NWAVES) { const int j = 256 * x + (li & 255);
                  if (li < 256) mixer_a_item(P, lns, Wm, args.in[3] + l * 512, args.in[4] + l * 512, args.in[6] + l * 1024, wl, j, ln);
                  else if (li < 512) mixer_b_item(P, args.in[7] + l * 1536, args.in[8] + l * 512, j, ln);
                  else mixer_c_item(P, WpT, wl, j, ln); } }
              else if (e < 16) {
                for (int li = e * 8 + wave; li < 512; li += 128) { const int j = 256 * x + (li & 255);
                  if (li < 256) mixer_a_item(P, lns, Wm, args.in[3] + l * 512, args.in[4] + l * 512, args.in[6] + l * 1024, wl, j, ln);
                  else mixer_b_item(P, args.in[7] + l * 1536, args.in[8] + l * 512, j, ln); }
                __syncthreads();
                S.n = 1; S.c0 = 10; S.sq = 0;
                pg8::gemm_phase<EpiP3G, SchedG, true, true>(lds, D, D, S, E); }
              else {
                S.n = 2; S.c0 = 6; S.sq = 2;
                pg8::gemm_phase<EpiP3G, SchedG, true, true>(lds, D, D, S, E);
                for (int li = 512 + (e - 16) * 8 + wave; li < 768; li += 128) mixer_c_item(P, WpT, wl, 256 * x + (li & 255), ln); } }
        }
        GSEAM(pb + 1);
        if (IN(pb + 2)) {
            pg8::TileOrder T; T.init(M, D, G, bx); int pm3, pn3;
            if (T.tile(0, pm3, pn3)) {
                SchedP3Y S; S.pm = pm3; S.pn = pn3; S.P = (const char*)P; S.W = (const char*)W3; EpiP3Y E{P, (const unsigned char*)args.out, GATE_PLANE_BYTES, (unsigned)D};
                pg8::gemm_phase<EpiP3Y, SchedP3Y, true>(lds, PITCH * 2, K3 * 2, S, E);
            }
        }
        GSEAM(pb + 2);
        if (IN(pb + 3)) {
            SchedP4 S; S.T.init(M, D, G, bx); S.P = (const char*)P; S.W = (const char*)WoT;
            if (l == 0) { EpiP4 E{P, rss + (size_t)(l + 1) * M * 16, ws + WS_XB8};
                pg8::gemm_phase<EpiP4, SchedP4, true>(lds, PITCH * 2, D * 2, S, E); }
            else { EpiP4F E{P, args.out, rss + (size_t)2 * M * 16, args.in[15], (unsigned*)(ws + WS_CTL) + CW_PANEL, (unsigned*)(ws + WS_CTL) + XB_TMO};
                pg8::gemm_phase<EpiP4F, SchedP4, true>(lds, PITCH * 2, D * 2, S, E); }
        }
        if (l + 1 < DEPTH) GSEAM_X(pb + 3, (bx & 3) != 3 ? (bx & 7) + 1 : -1, 2 + 4 * l, true);
    }
#undef IN
#undef SEAM
#undef GSEAM
}

extern "C" void kernel_launch(void* const* d_in, const int* in_sizes, int n_in, void* d_out, int out_size, void* d_ws, size_t ws_size, hipStream_t stream) {
    static int grid = 0;
    if (grid == 0) {
        if (n_in != 16 || in_sizes[0] != M * D || out_size != M * D || ws_size < WS_END) { fprintf(stderr, "kernel_launch: unexpected shapes (n_in %d, in0 %d, out %d, ws %zu); nothing launched\n", n_in, n_in > 0 ? in_sizes[0] : -1, out_size, ws_size); grid = -1; return; }
        int dev = 0, cus = 0, per_cu = 0;
        if (hipGetDevice(&dev) != hipSuccess || hipDeviceGetAttribute(&cus, hipDeviceAttributeMultiprocessorCount, dev) != hipSuccess) { grid = -1; return; }
        if (hipFuncSetAttribute((const void*)hybrid_fwd, hipFuncAttributeMaxDynamicSharedMemorySize, LDS_BYTES) != hipSuccess) { fprintf(stderr, "kernel_launch: hipFuncSetAttribute failed\n"); grid = -1; return; }
        if (hipOccupancyMaxActiveBlocksPerMultiprocessor(&per_cu, (const void*)hybrid_fwd, NWAVES * 64, LDS_BYTES) != hipSuccess || per_cu < 1) { fprintf(stderr, "kernel_launch: occupancy query reports %d blocks per CU\n", per_cu); (void)hipGetLastError(); grid = -1; return; }
        if (cus != 256) { fprintf(stderr, "kernel_launch: built for a 256-CU device (the unit assignment is written for 256 workgroups); this one has %d CUs; nothing launched\n", cus); grid = -1; return; }
        grid = cus;
    }
    if (grid < 0) return;
    if (hipMemsetAsync((char*)d_ws + WS_CTL, 0, CTL_ZERO_BYTES, stream) != hipSuccess) return;
    Args a{};
    for (int i = 0; i < 16; ++i) a.in[i] = (const float*)d_in[i];
    a.out = (float*)d_out; a.ws = (unsigned char*)d_ws;
    a.ph_lo = 0; a.ph_hi = 9;
    hipLaunchKernelGGL(hybrid_fwd, dim3(grid), dim3(NWAVES * 64), LDS_BYTES, stream, a);
}
```

```cpp
#include <hip/hip_runtime.h>
#include <cstdio>
#include <cstdint>


#define P1_WGM 2
#define GAS __attribute__((address_space(1)))
#define LAS __attribute__((address_space(3)))
typedef unsigned short bf16_t;
typedef short bf16x8 __attribute__((ext_vector_type(8)));
typedef float f32x4 __attribute__((ext_vector_type(4)));
typedef float f32x2 __attribute__((ext_vector_type(2)));
typedef unsigned u32x4 __attribute__((ext_vector_type(4)));
typedef unsigned u32x2 __attribute__((ext_vector_type(2)));

constexpr int SEQ = 8192, D = 1024, M = 2 * SEQ, DEPTH = 2;
constexpr int IN_TOTAL = 7680;
constexpr int NMIX = 4608;
constexpr int PITCH = NMIX + D;
constexpr int XB_COL = NMIX;
constexpr int C_U = 0, C_ZB = 512, C_ZC = 1024, C_V = 1536, C_ZA = 2048, C_XB = 2560, C_BG = 3072, C_CG = 3584, C_XC = 4096;
constexpr int C_S = 1536, C_MERGED = 1536;
constexpr int K3 = 1536;
constexpr float RMS_EPS = 1e-6f, LN_EPS = 1e-5f;

constexpr size_t MiB = 1u << 20;
constexpr size_t WS_CTL = 0, CTL_ZERO_BYTES = 192 * 1024;
constexpr int CW_PANEL = 40960;
constexpr size_t WS_RSS = 1 * MiB;
constexpr size_t WS_LNS = 4 * MiB;
constexpr size_t WS_WMIX = 5 * MiB;
constexpr size_t WS_W3 = 23 * MiB;
constexpr size_t WS_WO = 29 * MiB;
constexpr size_t WS_WM = 33 * MiB;
constexpr size_t WS_WPOOL = WS_WM + 512 * 1024;
constexpr size_t WS_P = 34 * MiB;
constexpr size_t WS_XB8 = WS_P + (size_t)M * PITCH * 2;
constexpr size_t WS_WG8 = WS_XB8 + (size_t)M * D;
constexpr float WG8_SCALE = 64.0f;
constexpr size_t GATE_GROUP_BYTES = 8 * MiB, GATE_PLANE_BYTES = 2 * MiB;
constexpr size_t WS_END = WS_WG8 + (size_t)DEPTH * 3 * D * D;
static_assert(WS_END <= 256 * MiB, "workspace map");

constexpr int NWAVES = 8;
constexpr int RING_BYTES = 131072;
constexpr int WAVE_LDS = 17920;
constexpr int LDSCTL_OFF = 143360, MISC_OFF = LDSCTL_OFF + 320;
constexpr int LDS_BYTES = 147456;

#define RLX_AGENT __ATOMIC_RELAXED, __HIP_MEMORY_SCOPE_AGENT
#define LDS_WAIT() asm volatile("s_waitcnt lgkmcnt(0)" ::: "memory")
#define VM_WAIT() asm volatile("s_waitcnt vmcnt(0)" ::: "memory")

__device__ __forceinline__ unsigned cvt_pk_bf16(float lo, float hi) { unsigned r; asm volatile("v_cvt_pk_bf16_f32 %0, %1, %2" : "=v"(r) : "v"(lo), "v"(hi)); return r; }
__device__ __forceinline__ unsigned pk4_fp8(float a, float b, float c, float d) { int w = 0; w = __builtin_amdgcn_cvt_pk_fp8_f32(a, b, w, false); w = __builtin_amdgcn_cvt_pk_fp8_f32(c, d, w, true); return (unsigned)w; }
__device__ __forceinline__ float bf_lo(unsigned w) { return __builtin_bit_cast(float, w << 16); }
__device__ __forceinline__ float bf_hi(unsigned w) { return __builtin_bit_cast(float, w & 0xffff0000u); }
__device__ __forceinline__ float sigmoid_f(float x) { return __builtin_amdgcn_rcpf(1.0f + __builtin_amdgcn_exp2f(-1.4426950409f * x)); }
__device__ __forceinline__ float silu_f(float x) { return x * sigmoid_f(x); }
__device__ __forceinline__ f32x2 bf2(unsigned w) { return (f32x2){bf_lo(w), bf_hi(w)}; }
__device__ __forceinline__ f32x2 rcp2(f32x2 d) { return (f32x2){__builtin_amdgcn_rcpf(d.x), __builtin_amdgcn_rcpf(d.y)}; }
__device__ __forceinline__ f32x2 exp2_2(f32x2 t) { return (f32x2){__builtin_amdgcn_exp2f(t.x), __builtin_amdgcn_exp2f(t.y)}; }
__device__ __forceinline__ f32x2 silu2(f32x2 x) { return x * rcp2(exp2_2(x * -1.4426950409f) + 1.0f); }
__device__ __forceinline__ f32x2 gelu2(f32x2 x) { const f32x2 t = x * x * (-2.3022081981f * 0.044715f) + (-2.3022081981f); return x * rcp2(exp2_2(x * t) + 1.0f); }
__device__ __forceinline__ float gelu_tanh_f(float x) { return x * __builtin_amdgcn_rcpf(1.0f + __builtin_amdgcn_exp2f(x * __builtin_fmaf(x * x, -2.3022081981f * 0.044715f, -2.3022081981f))); }

namespace pg8 {
constexpr int BM = 256, BK = 64, HALF = 128, HTB = HALF * BK * 2, STAGE_BYTES = 8 * HTB, NXCD = 8, WGM = 8;
__host__ __device__ __forceinline__ int lds_byte(int r, int c) { const int st = (r >> 4) * 2 + (c >> 5), rr = r & 15, cc = c & 31, ob = rr * 64 + cc * 2; return st * 1024 + (ob ^ (((ob >> 9) & 1) << 5)); }
__host__ __device__ __forceinline__ void stage_rc(int b, int& R, int& C) { const int st = b / 1024, sb = b % 1024, swz = sb ^ (((sb >> 9) & 1) << 5); R = (st >> 1) * 16 + swz / 64; C = (st & 1) * 32 + (swz % 64) / 2; }
__host__ __device__ __forceinline__ int perm32(int rho) { const int n = rho >> 4, i = rho & 15; return 8 * (i >> 2) + 4 * n + (i & 3); }

struct Unit { const char* A; const char* B; int nt; int kind; int pm, pn; };

struct TileOrder {
    int nM, nN, nwg, G, c, wgm;
    __device__ void init(int M_, int N_, int G_, int c_, int wgm_ = WGM) { nM = M_ / BM; nN = N_ / BM; nwg = nM * nN; G = G_; c = c_; wgm = wgm_; }
    __device__ bool tile(int i, int& pm, int& pn) const {
        const long L = (long)i * G + c; if (L >= nwg) return false;
        int wgid = (int)L; { const int q = nwg / NXCD, r = nwg % NXCD, xcd = wgid % NXCD, off = wgid / NXCD; wgid = (xcd < r ? xcd * (q + 1) : r * (q + 1) + (xcd - r) * q) + off; }
        const int nig = wgm * nN, gid = wgid / nig, fm = gid * wgm, gsz = (nM - fm) < wgm ? (nM - fm) : wgm;
        pm = fm + ((wgid % nig) % gsz); pn = (wgid % nig) / gsz; return true;
    }
};

typedef int i32x4 __attribute__((ext_vector_type(4)));
typedef int i32x8 __attribute__((ext_vector_type(8)));
__device__ __forceinline__ i32x8 cat16(bf16x8 lo, bf16x8 hi) { const i32x4 a = __builtin_bit_cast(i32x4, lo), b = __builtin_bit_cast(i32x4, hi); return __builtin_shufflevector(a, b, 0, 1, 2, 3, 4, 5, 6, 7); }
template <class Epi, class Sched, bool ALIGN_EPI, bool FP8 = false>
__device__ __forceinline__ void gemm_phase(LAS unsigned char* lds, const unsigned lda2, const unsigned ldb2, const Sched& S, const Epi& E) {
    int tid = threadIdx.x; asm volatile("" : "+v"(tid));
    const int wid = __builtin_amdgcn_readfirstlane(tid >> 6), lane = tid & 63, wr = wid >> 2, wc = wid & 3, fr = lane & 15, fq = lane >> 4;
    unsigned voffA[2], voffB[2];
#pragma unroll
    for (int i = 0; i < 2; ++i) { int R, C; stage_rc(tid * 16 + i * 8192, R, C); const int Rb = (R & ~31) + perm32(R & 31);
        voffA[i] = (unsigned)R * lda2 + (unsigned)C * 2u; voffB[i] = (unsigned)Rb * ldb2 + (unsigned)C * 2u; }
    const size_t kstep = (size_t)(BK * 2);
    const size_t hA = (size_t)HALF * lda2, hB = (size_t)HALF * ldb2;
    const unsigned ldsw = (unsigned)wid * 1024u;
    const int aoff = lds_byte(wr * 64 + fr, fq * 8), boff = lds_byte(wc * 32 + fr, fq * 8);
#define PG8_SA(b, h) (((b) * 2 + (h)) * HTB)
#define PG8_SB(b, h) ((4 + (b) * 2 + (h)) * HTB)
#define PG8_STAGE(bufoff, gbase, voff) do { _Pragma("unroll") for (int _i = 0; _i < 2; ++_i) \
        __builtin_amdgcn_global_load_lds((const unsigned*)((const char*)(gbase) + (voff)[_i]), (LAS unsigned*)(lds + (bufoff) + ldsw + _i * 8192), 16, 0, 0); } while (0)
#define PG8_LDA(dst, b, h) do { _Pragma("unroll") for (int m = 0; m < 4; ++m) { if constexpr (FP8) dst##8[m] = cat16(*(const LAS bf16x8*)(lds + PG8_SA(b, h) + aoff + m * 2048), *(const LAS bf16x8*)(lds + PG8_SA(b, h) + aoff + m * 2048 + 1024)); \
        else { _Pragma("unroll") for (int k = 0; k < 2; ++k) dst[m][k] = *(const LAS bf16x8*)(lds + PG8_SA(b, h) + aoff + m * 2048 + k * 1024); } } } while (0)
#define PG8_LDB(dst, b, h) do { _Pragma("unroll") for (int n = 0; n < 2; ++n) { if constexpr (FP8) dst##8[n] = cat16(*(const LAS bf16x8*)(lds + PG8_SB(b, h) + boff + n * 2048), *(const LAS bf16x8*)(lds + PG8_SB(b, h) + boff + n * 2048 + 1024)); \
        else { _Pragma("unroll") for (int k = 0; k < 2; ++k) dst[n][k] = *(const LAS bf16x8*)(lds + PG8_SB(b, h) + boff + n * 2048 + k * 1024); } } } while (0)
#define PG8_MMA(ai, bj, At, Bt) do { __builtin_amdgcn_s_setprio(1); \
        if constexpr (FP8) { _Pragma("unroll") for (int m = 0; m < 4; ++m) _Pragma("unroll") for (int n = 0; n < 2; ++n) \
            asm volatile("v_mfma_scale_f32_16x16x128_f8f6f4 %0, %1, %2, %0, %3, %3 op_sel_hi:[0,0,0]" : "+v"(acc[ai][bj][m][n]) : "v"(Bt##8[n]), "v"(At##8[m]), "v"(sc8)); \
            asm volatile("s_nop 15\n\ts_nop 7" ::: "memory"); }   \
        else { _Pragma("unroll") for (int m = 0; m < 4; ++m) _Pragma("unroll") for (int n = 0; n < 2; ++n) _Pragma("unroll") for (int k = 0; k < 2; ++k) \
            acc[ai][bj][m][n] = __builtin_amdgcn_mfma_f32_16x16x32_bf16(Bt[n][k], At[m][k], acc[ai][bj][m][n], 0, 0, 0); } \
        __builtin_amdgcn_s_setprio(0); } while (0)
#define PG8_WAIT_V(n) asm volatile("s_waitcnt vmcnt(" #n ")" ::: "memory")
#define PG8_WAIT_L(n) asm volatile("s_waitcnt lgkmcnt(" #n ")" ::: "memory")
#define PG8_BAR __builtin_amdgcn_s_barrier()
#define PG8_SCHED __builtin_amdgcn_sched_barrier(0)
    Unit cur, nxt; int ui = 0;
    if (!S.next(0, cur)) return;
    f32x4 acc[2][2][4][2];
#pragma unroll
    for (int a = 0; a < 2; ++a)
#pragma unroll
        for (int b = 0; b < 2; ++b)
#pragma unroll
            for (int m = 0; m < 4; ++m)
#pragma unroll
                for (int n = 0; n < 2; ++n) acc[a][b][m][n] = (f32x4){0.f, 0.f, 0.f, 0.f};
    bf16x8 At[4][2], B0[2][2], B1[2][2]; i32x8 At8[4], B08[2], B18[2];
    int sc8 = 0x7f7f7f7f; asm volatile("" : "+v"(sc8));
    const char* cA = cur.A; const char* cB = cur.B;
    PG8_STAGE(PG8_SB(0, 0), cB, voffB); PG8_STAGE(PG8_SB(0, 1), cB + hB, voffB); PG8_STAGE(PG8_SA(0, 0), cA, voffA); PG8_STAGE(PG8_SA(0, 1), cA + hA, voffA);
    if (wr == 1) PG8_BAR;
    PG8_WAIT_V(2); PG8_BAR;
    PG8_STAGE(PG8_SB(1, 0), cB + kstep, voffB); PG8_STAGE(PG8_SA(1, 0), cA + kstep, voffA); PG8_STAGE(PG8_SB(1, 1), cB + hB + kstep, voffB);
    PG8_WAIT_V(6); PG8_BAR;
    for (;;) {
        const bool has_next = S.next(ui + 1, nxt);
        const char* nA = has_next ? nxt.A : cA; const char* nB = has_next ? nxt.B : cB;
        const int nt = cur.nt;
#pragma unroll 1
        for (int t = 0; t < nt; t += 2) {
            const bool last = (t == nt - 2);
            const char* a1 = cA + (size_t)(t + 1) * kstep;
            const char* a2 = last ? nA : cA + (size_t)(t + 2) * kstep; const char* b2 = last ? nB : cB + (size_t)(t + 2) * kstep;
            const char* a3 = a2 + kstep; const char* b3 = b2 + kstep;
            PG8_LDB(B0, 0, 0); PG8_LDB(B1, 0, 1); PG8_SCHED; PG8_LDA(At, 0, 0); PG8_STAGE(PG8_SA(1, 1), a1 + hA, voffA);
            PG8_WAIT_V(8); PG8_WAIT_L(0); PG8_BAR; PG8_MMA(0, 0, At, B0); PG8_MMA(0, 1, At, B1); PG8_BAR; PG8_SCHED;
            PG8_LDA(At, 0, 1); PG8_STAGE(PG8_SB(0, 0), b2, voffB); PG8_STAGE(PG8_SB(0, 1), b2 + hB, voffB); PG8_STAGE(PG8_SA(0, 0), a2, voffA);
            PG8_WAIT_V(8); PG8_WAIT_L(0); PG8_BAR; PG8_MMA(1, 0, At, B0); PG8_MMA(1, 1, At, B1); PG8_BAR; PG8_SCHED;
            PG8_LDB(B0, 1, 0); PG8_LDB(B1, 1, 1); PG8_SCHED; PG8_LDA(At, 1, 0); PG8_STAGE(PG8_SA(0, 1), a2 + hA, voffA);
            PG8_WAIT_V(8); PG8_WAIT_L(0); PG8_BAR; PG8_MMA(0, 0, At, B0); PG8_MMA(0, 1, At, B1); PG8_BAR; PG8_SCHED;
            PG8_LDA(At, 1, 1); PG8_STAGE(PG8_SB(1, 0), b3, voffB); PG8_STAGE(PG8_SB(1, 1), b3 + hB, voffB); PG8_STAGE(PG8_SA(1, 0), a3, voffA);
            PG8_WAIT_V(8); PG8_WAIT_L(0); PG8_BAR; PG8_MMA(1, 0, At, B0); PG8_MMA(1, 1, At, B1); PG8_BAR; PG8_SCHED;
        }
        if constexpr (ALIGN_EPI) { if (wr == 0) PG8_BAR; }
        E(acc, cur, wr, wc, fr, fq);
        if (!has_next) break;
        cur = nxt; cA = nA; cB = nB; ++ui;
        if constexpr (ALIGN_EPI) { if (wr == 1) PG8_BAR; }
    }
    PG8_WAIT_V(0);
    if constexpr (!ALIGN_EPI) { if (wr == 0) PG8_BAR; }
    PG8_BAR;
#undef PG8_SA
#undef PG8_SB
#undef PG8_STAGE
#undef PG8_LDA
#undef PG8_LDB
#undef PG8_MMA
#undef PG8_WAIT_V
#undef PG8_WAIT_L
#undef PG8_BAR
#undef PG8_SCHED
}
}

#define XB_TMO      128
#define XB_XCNT(j)  (256  + 64 * (j))
#define XB_XSUB(j)  (1280 + 64 * (j))
#define XB_XGEN(j)  (2304 + 64 * (j))
#define XB_TOP      3328
#define XB_TOPGEN   3392
#define XCD_BAR_WORDS 3456
#define XB_SPIN_CAP (1u << 18)
__device__ __forceinline__ unsigned xb_ld(unsigned* p)              { return __hip_atomic_load(p, __ATOMIC_RELAXED, __HIP_MEMORY_SCOPE_AGENT); }
__device__ __forceinline__ unsigned xb_add(unsigned* p, unsigned v) { return __hip_atomic_fetch_add(p, v, __ATOMIC_RELAXED, __HIP_MEMORY_SCOPE_AGENT); }
__device__ __forceinline__ unsigned xb_xcc_id() { return (unsigned)__builtin_amdgcn_s_getreg((3 << 11) | 20) & 0xFu; }
#define XB_SPIN(cond, bar) do { unsigned _sp = 0; while (cond) { __builtin_amdgcn_s_sleep(1); \
    if ((++_sp & 255u) == 0u) { if (xb_ld(&(bar)[XB_TMO])) break; if (_sp > XB_SPIN_CAP) { atomicAdd(&(bar)[XB_TMO], 1u); break; } } } } while (0)
struct XcdBarrier { unsigned* bar; unsigned x; volatile LAS unsigned* st; unsigned G; };
__device__ __forceinline__ XcdBarrier xcd_barrier_post(unsigned* bar, volatile LAS unsigned* st, unsigned G) {
    XcdBarrier b; b.bar = bar; b.x = xb_xcc_id(); b.st = st; b.G = G;
    if (threadIdx.x == 0) (void)xb_add(&bar[XB_XCNT(b.x)], 1u);
    return b;
}
__device__ __forceinline__ void xcd_barrier_complete(unsigned* bar, unsigned x, unsigned G, unsigned& nloc, unsigned& nx) {
    unsigned sum, cnt, mine, sp = 0u;
    for (;;) {
        sum = 0u; cnt = 0u; mine = 0u;
#pragma unroll
        for (unsigned j = 0; j < 16; ++j) { const unsigned c = xb_ld(&bar[XB_XCNT(j)]); sum += c; cnt += (c > 0u) ? 1u : 0u; mine = (j == x) ? c : mine; }
        if (sum == G) break;
        __builtin_amdgcn_s_sleep(1);
        if ((++sp & 255u) == 0u) { if (xb_ld(&bar[XB_TMO])) break; if (sp > XB_SPIN_CAP) { atomicAdd(&bar[XB_TMO], 1u); break; } }
    }
    nloc = mine > 0u ? mine : 1u; nx = cnt > 0u ? cnt : 1u;
}
__device__ __forceinline__ void xcd_barrier(const XcdBarrier& b, unsigned* wait_word = nullptr, unsigned wait_target = 0u, unsigned* prog_word = nullptr, bool local_ok = false) {
    asm volatile("s_waitcnt vmcnt(0)" ::: "memory");
    __syncthreads();
    if (threadIdx.x == 0) {
        unsigned* bar = b.bar;
        __builtin_amdgcn_s_waitcnt(0);
        asm volatile("buffer_inv sc1" ::: "memory");
        unsigned nloc = b.st[0], nx = b.st[1];
        if (nloc == 0u) { xcd_barrier_complete(bar, b.x, b.G, nloc, nx); b.st[0] = nloc; b.st[1] = nx; }
        const unsigned old = xb_add(&bar[XB_XSUB(b.x)], 1u);
        const unsigned gen = old / nloc;
        if (old + 1u == (gen + 1u) * nloc) {
            if (!(local_ok && nx == 1u)) { __builtin_amdgcn_fence(__ATOMIC_RELEASE, "agent"); asm volatile("s_waitcnt vmcnt(0)" ::: "memory"); }
            (void)xb_add(&bar[XB_TOP], 1u);
        }
        const unsigned tgt = (gen + 1u) * nx;
        if (wait_word) XB_SPIN(xb_ld(wait_word) < wait_target, bar);
        XB_SPIN(xb_ld(&bar[XB_TOP]) < tgt, bar);
        if (prog_word) (void)xb_add(prog_word, 1u);
        asm volatile("s_waitcnt vmcnt(0)" ::: "memory");
    }
    __syncthreads();
}

struct Args { const float* in[16]; float* out; unsigned char* ws; int ph_lo, ph_hi; };

__device__ __forceinline__ float wave_sum(float v) {
#pragma unroll
    for (int o = 1; o < 64; o <<= 1) v += __shfl_xor(v, o);
    return v;
}

__device__ __forceinline__ void p0_transpose_item(const float* W, int ldw, int k0, int n0, const float* gs, bf16_t* dst, int ldd, LAS float* scr, int lane) {
    float v[32];
    const float* wp = W + (size_t)(k0 + (lane >> 5)) * ldw + n0 + (lane & 31);
#pragma unroll
    for (int i = 0; i < 32; ++i) v[i] = wp[(size_t)(2 * i) * ldw];
    if (gs) {
#pragma unroll
        for (int i = 0; i < 32; ++i) v[i] *= gs[k0 + 2 * i + (lane >> 5)]; }
#pragma unroll
    for (int i = 0; i < 32; ++i) scr[(2 * i + (lane >> 5)) * 33 + (lane & 31)] = v[i];
    LDS_WAIT(); asm volatile("" ::: "memory");
    const int c = lane & 7;
#pragma unroll
    for (int j = 0; j < 4; ++j) { const int n = (lane >> 3) + 8 * j; const LAS float* s = scr + (8 * c) * 33 + n;
        u32x4 o; o.x = cvt_pk_bf16(s[0 * 33], s[1 * 33]); o.y = cvt_pk_bf16(s[2 * 33], s[3 * 33]); o.z = cvt_pk_bf16(s[4 * 33], s[5 * 33]); o.w = cvt_pk_bf16(s[6 * 33], s[7 * 33]);
        *(u32x4*)(dst + (size_t)n * ldd + 8 * c) = o; }
    LDS_WAIT(); asm volatile("" ::: "memory");
}

__device__ __forceinline__ void p0_transpose_item_fp8(const float* W, int ldw, int k0, int n0, const float* gs, float sc, unsigned char* dst, int ldd, LAS float* scr, int lane) {
    float v[32];
    const float* wp = W + (size_t)(k0 + (lane >> 5)) * ldw + n0 + (lane & 31);
#pragma unroll
    for (int i = 0; i < 32; ++i) v[i] = wp[(size_t)(2 * i) * ldw];
#pragma unroll
    for (int i = 0; i < 32; ++i) v[i] *= gs[k0 + 2 * i + (lane >> 5)] * sc;
#pragma unroll
    for (int i = 0; i < 32; ++i) scr[(2 * i + (lane >> 5)) * 33 + (lane & 31)] = v[i];
    LDS_WAIT(); asm volatile("" ::: "memory");
    const int n = lane >> 1, h = lane & 1; const LAS float* s = scr + (32 * h) * 33 + n;
    u32x4 o0, o1;
#pragma unroll
    for (int q = 0; q < 4; ++q) { o0[q] = pk4_fp8(s[(4 * q) * 33], s[(4 * q + 1) * 33], s[(4 * q + 2) * 33], s[(4 * q + 3) * 33]);
                                  o1[q] = pk4_fp8(s[(16 + 4 * q) * 33], s[(17 + 4 * q) * 33], s[(18 + 4 * q) * 33], s[(19 + 4 * q) * 33]); }
    unsigned char* d = dst + (size_t)n * ldd + 32 * h;
    *(u32x4*)d = o0; *(u32x4*)(d + 16) = o1;
    LDS_WAIT(); asm volatile("" ::: "memory");
}

__device__ __forceinline__ void p0_prologue(const Args& a, LAS unsigned char* lds, int gw, int NGW, int wave, int lane) {
    unsigned char* ws = a.ws;
    LAS float* scr = (LAS float*)(lds + wave * WAVE_LDS);
    constexpr int I_IN = (D / 64) * (IN_TOTAL / 32);
    constexpr int I_P = (512 / 64) * (D / 32);
    constexpr int I_O = (D / 64) * (D / 32);
    constexpr int I_LAYER = I_IN + 3 * I_P + I_O;
    { bf16_t* P = (bf16_t*)(ws + WS_P); float* rss = (float*)(ws + WS_RSS);
      for (int m4 = gw * 4; m4 < M; m4 += NGW * 4) {
          f32x4 v[4][4];
#pragma unroll
          for (int r = 0; r < 4; ++r) { const f32x4* xr = (const f32x4*)(a.in[0] + (size_t)(m4 + r) * D) + lane;
#pragma unroll
              for (int j = 0; j < 4; ++j) v[r][j] = xr[64 * j]; }
#pragma unroll
          for (int r = 0; r < 4; ++r) { float s = 0.f;
#pragma unroll
              for (int j = 0; j < 4; ++j) s += (v[r][j].x * v[r][j].x + v[r][j].y * v[r][j].y) + (v[r][j].z * v[r][j].z + v[r][j].w * v[r][j].w);
              s = wave_sum(s);
              u32x2* o = (u32x2*)(P + (size_t)(m4 + r) * PITCH + XB_COL) + lane;
#pragma unroll
              for (int j = 0; j < 4; ++j) { u32x2 w; w.x = cvt_pk_bf16(v[r][j].x, v[r][j].y); w.y = cvt_pk_bf16(v[r][j].z, v[r][j].w); o[64 * j] = w; }
              unsigned* o8 = (unsigned*)(ws + WS_XB8 + (size_t)(m4 + r) * D) + lane;
#pragma unroll
              for (int j = 0; j < 4; ++j) o8[64 * j] = pk4_fp8(v[r][j].x, v[r][j].y, v[r][j].z, v[r][j].w);
              if (lane < 16) rss[(size_t)(m4 + r) * 16 + lane] = (lane == 0) ? s : 0.f; }
      } }
    for (int it = gw; it < DEPTH * I_LAYER; it += NGW) {
        const int l = it / I_LAYER; int r = it % I_LAYER;
        bf16_t* Wmix = (bf16_t*)(ws + WS_WMIX) + (size_t)l * NMIX * D;
        bf16_t* W3 = (bf16_t*)(ws + WS_W3) + (size_t)l * D * K3;
        bf16_t* WoT = (bf16_t*)(ws + WS_WO) + (size_t)l * D * D;
        if (r < I_IN) {
            const int kb = r / (IN_TOTAL / 32), nb = r % (IN_TOTAL / 32), k0 = 64 * kb, n0 = 32 * nb, seg = n0 / 512;
            const float* W = a.in[2] + (size_t)l * D * IN_TOTAL; const float* gs = a.in[1] + l * D;
            if (seg < 9) { const int dseg = (seg == 0) ? 0 : (seg == 1) ? 3 : (seg == 2) ? 4 : (seg == 3) ? 5 : (seg == 4) ? 6 : (seg == 5) ? 7 : (seg == 6) ? 1 : (seg == 7) ? 8 : 2;
                p0_transpose_item(W, IN_TOTAL, k0, n0, gs, Wmix + (size_t)(dseg * 512 + (n0 & 511)) * D + k0, D, scr, lane); }
            else { const int nn = n0 - NMIX;
                p0_transpose_item_fp8(W, IN_TOTAL, k0, n0, gs, WG8_SCALE, ws + WS_WG8 + (size_t)l * 3 * D * D + (size_t)nn * D + k0, D, scr, lane); }
            continue; }
        r -= I_IN;
        if (r < 3 * I_P) { const int br = r / I_P, q = r % I_P, kb = q / (D / 32), nb = q % (D / 32), k0 = 64 * kb, n0 = 32 * nb;
            const float* W = a.in[11 + br] + (size_t)l * 512 * D;
            p0_transpose_item(W, D, k0, n0, nullptr, W3 + (size_t)n0 * K3 + br * 512 + k0, K3, scr, lane); continue; }
        r -= 3 * I_P;
        { const int kb = r / (D / 32), nb = r % (D / 32), k0 = 64 * kb, n0 = 32 * nb;
          const float* W = a.in[14] + (size_t)l * D * D;
          p0_transpose_item(W, D, k0, n0, nullptr, WoT + (size_t)n0 * D + k0, D, scr, lane); }
    }
    { bf16_t* Wm = (bf16_t*)(ws + WS_WM); const float* w_s = a.in[5];
      for (int i = gw * 64 + lane; i < DEPTH * 8 * 128 * 128 / 2; i += NGW * 64) { const int e = 2 * i, s = e & 127, t = (e >> 7) & 127;
          const f32x2 v = *(const f32x2*)(w_s + e); ((unsigned*)Wm)[i] = cvt_pk_bf16(s <= t ? v.x : 0.f, s + 1 <= t ? v.y : 0.f); } }
    { bf16_t* Wp = (bf16_t*)(ws + WS_WPOOL); const float* w_pool = a.in[9]; const float* ps = a.in[10];
      for (int i = gw * 64 + lane; i < DEPTH * 4 * 128 * 128 / 2; i += NGW * 64) { const int e = 2 * i, c = e & 127, d = (e >> 7) & 127, lg = e >> 14;
          const float sc = ps[lg * 128 + d];
          ((unsigned*)Wp)[i] = cvt_pk_bf16(w_pool[(size_t)lg * 16384 + c * 128 + d] * sc, w_pool[(size_t)lg * 16384 + (c + 1) * 128 + d] * sc); } }
}

__device__ __forceinline__ float row_rstd(const float* rss, int row, int fq) {
    const f32x4 p = *(const f32x4*)(rss + (size_t)row * 16 + fq * 4);
    float s = (p.x + p.y) + (p.z + p.w); s += __shfl_xor(s, 16); s += __shfl_xor(s, 32);
    return __builtin_amdgcn_rsqf(s * (1.0f / D) + RMS_EPS);
}
__device__ __forceinline__ float rstd_of(f32x4 p) { float s = (p.x + p.y) + (p.z + p.w); s += __shfl_xor(s, 16); s += __shfl_xor(s, 32); return __builtin_amdgcn_rsqf(s * (1.0f / D) + RMS_EPS); }
#define ZERO_ACC(acc) do { _Pragma("unroll") for (int _a = 0; _a < 2; ++_a) _Pragma("unroll") for (int _b = 0; _b < 2; ++_b) _Pragma("unroll") for (int _m = 0; _m < 4; ++_m) _Pragma("unroll") for (int _n = 0; _n < 2; ++_n) acc[_a][_b][_m][_n] = (f32x4){0.f, 0.f, 0.f, 0.f}; } while (0)

struct SchedP1 {
    pg8::TileOrder T; const char* P; const char* W;
    __device__ __forceinline__ bool next(int i, pg8::Unit& u) const { int pm, pn; if (!T.tile(i, pm, pn)) return false;
        u.pm = pm; u.pn = pn; u.kind = pn >> 1; u.nt = D / 64; u.A = P + ((size_t)pm * 256 * PITCH + XB_COL) * 2; u.B = W + (size_t)pn * 256 * D * 2; return true; }
};
struct EpiP1 {
    bf16_t* P; const float* rss; float* lns;
    __device__ __forceinline__ void operator()(f32x4 (&acc)[2][2][4][2], const pg8::Unit& u, int wr, int wc, int fr, int fq) const {
        const int seg = u.kind;
        const int act = (seg == 3) ? 1 : 0;
        unsigned lrow = (unsigned)(wr * 64 + fr); asm volatile("" : "+v"(lrow));
        const unsigned lp = (lrow * PITCH + (unsigned)(wc * 32) + 8u * (unsigned)fq) * 2u;
        const unsigned lr = lrow * 64u;
        const size_t up = (size_t)u.pm * 256 * PITCH + (size_t)u.pn * 256;
        const size_t ur = (size_t)u.pm * 256 * 16;
        f32x4 pr[2][4];
#pragma unroll
        for (int ai = 0; ai < 2; ++ai)
#pragma unroll
            for (int m = 0; m < 4; ++m) pr[ai][m] = *(const f32x4*)((const char*)(rss + ur + (ai * 128 + m * 16) * 16) + (lr + 16u * fq));
#pragma unroll
        for (int ai = 0; ai < 2; ++ai)
#pragma unroll
            for (int m = 0; m < 4; ++m) {
                const float rs = rstd_of(pr[ai][m]);
                float s1 = 0.f, s2 = 0.f;
#pragma unroll
                for (int bj = 0; bj < 2; ++bj) {
                    f32x4 v0 = acc[ai][bj][m][0] * rs, v1 = acc[ai][bj][m][1] * rs;
                    if (act == 1) {
#pragma unroll
                        for (int j = 0; j < 2; ++j) { const f32x2 g0 = gelu2((f32x2){v0[2 * j], v0[2 * j + 1]}), g1 = gelu2((f32x2){v1[2 * j], v1[2 * j + 1]});
                            v0[2 * j] = g0.x; v0[2 * j + 1] = g0.y; v1[2 * j] = g1.x; v1[2 * j + 1] = g1.y; } }
                    u32x4 w; w.x = cvt_pk_bf16(v0[0], v0[1]); w.y = cvt_pk_bf16(v0[2], v0[3]); w.z = cvt_pk_bf16(v1[0], v1[1]); w.w = cvt_pk_bf16(v1[2], v1[3]);
                    *(u32x4*)((char*)(P + up + (size_t)(ai * 128 + m * 16) * PITCH + bj * 128) + lp) = w;
                    if (seg == 3) {
#pragma unroll
                        for (int q = 0; q < 4; ++q) { const float lo = bf_lo(w[q]), hi = bf_hi(w[q]); s1 += lo + hi; s2 += lo * lo + hi * hi; } }
                }
                if (seg == 3) { s1 += __shfl_xor(s1, 16); s1 += __shfl_xor(s1, 32); s2 += __shfl_xor(s2, 16); s2 += __shfl_xor(s2, 32);
                    if (fq == 0) *(f32x2*)((char*)(lns + ur + (ai * 128 + m * 16) * 16 + ((u.pn - 6) * 4 + wc) * 2) + lr) = (f32x2){s1, s2}; }
            }
        ZERO_ACC(acc);
    }
};

struct SchedG {
    int x, r, n, c0, sq; const char* A8; const char* W8;
    __device__ __forceinline__ bool next(int i, pg8::Unit& u) const { if (i >= n) return false;
        int combo, pl;
        if (i < sq) { pl = 4 * i + (r & 3); combo = c0 + (r >> 2); } else { pl = r & 7; combo = c0 + (sq ? 4 : 0) + 2 * (i - sq) + (r >> 3); }
        const int gate = combo >> 2;
        u.pm = 8 * x + pl; u.pn = combo & 3; u.kind = gate; u.nt = D / 128;
        u.A = A8 + (size_t)u.pm * 256 * D; u.B = W8 + ((size_t)gate * D + (size_t)u.pn * 256) * D; return true; }
};
struct EpiP3G {
    unsigned char* S8; size_t gstride; unsigned rowb; const float* rss;
    __device__ __forceinline__ void operator()(f32x4 (&acc)[2][2][4][2], const pg8::Unit& u, int wr, int wc, int fr, int fq) const {
        unsigned lrow = (unsigned)(wr * 64 + fr); asm volatile("" : "+v"(lrow));
        const unsigned ls = lrow * rowb + (unsigned)(wc * 32) + 8u * (unsigned)fq;
        const unsigned lr = lrow * 64u;
        unsigned char* sb = S8 + (size_t)(u.pm >> 3) * GATE_GROUP_BYTES + (size_t)u.kind * gstride + (size_t)(u.pm & 7) * 256 * rowb + (size_t)u.pn * 256;
        const size_t ur = (size_t)u.pm * 256 * 16;
        f32x4 pr[2][4];
#pragma unroll
        for (int ai = 0; ai < 2; ++ai)
#pragma unroll
            for (int m = 0; m < 4; ++m) pr[ai][m] = *(const f32x4*)((const char*)(rss + ur + (ai * 128 + m * 16) * 16) + (lr + 16u * fq));
#pragma unroll
        for (int ai = 0; ai < 2; ++ai)
#pragma unroll
            for (int m = 0; m < 4; ++m) {
                const float rs = rstd_of(pr[ai][m]) * (-1.4426950409f / WG8_SCALE);
#pragma unroll
                for (int bj = 0; bj < 2; ++bj) { const f32x4 v0 = acc[ai][bj][m][0] * rs, v1 = acc[ai][bj][m][1] * rs;
                    unsigned w0 = 0u, w1 = 0u;
#pragma unroll
                    for (int j = 0; j < 4; ++j) { w0 = __builtin_amdgcn_cvt_pk_u8_f32(__builtin_amdgcn_rcpf(__builtin_fmaf(__builtin_amdgcn_exp2f(v0[j]), 1.0f / 255.0f, 1.0f / 255.0f)), j, w0);
                                                  w1 = __builtin_amdgcn_cvt_pk_u8_f32(__builtin_amdgcn_rcpf(__builtin_fmaf(__builtin_amdgcn_exp2f(v1[j]), 1.0f / 255.0f, 1.0f / 255.0f)), j, w1); }
                    w0 |= (((w0 - 0x01010101u) & ~w0) >> 7) & 0x01010101u; w1 |= (((w1 - 0x01010101u) & ~w1) >> 7) & 0x01010101u;
                    *(u32x2*)(sb + (size_t)(ai * 128 + m * 16) * rowb + bj * 128 + ls) = (u32x2){w0, w1}; }
            }
        ZERO_ACC(acc);
    }
};
struct SchedP3Y {
    int pm, pn; const char* P; const char* W;
    __device__ __forceinline__ bool next(int i, pg8::Unit& u) const { if (i >= 3) return false;
        u.pm = pm; u.pn = pn; u.kind = i; u.nt = 512 / 64;
        u.A = P + ((size_t)pm * 256 * PITCH + (size_t)i * 512) * 2; u.B = W + ((size_t)pn * 256 * K3 + (size_t)i * 512) * 2; return true; }
};
struct EpiP3Y {
    bf16_t* P; const unsigned char* S8; size_t gstride; unsigned rowb;
    __device__ __forceinline__ void operator()(f32x4 (&acc)[2][2][4][2], const pg8::Unit& u, int wr, int wc, int fr, int fq) const {
        const int j = u.kind; const bool fin = (j == 2);
        unsigned lrow = (unsigned)(wr * 64 + fr); asm volatile("" : "+v"(lrow));
        const unsigned ls = lrow * rowb + (unsigned)(wc * 32) + 8u * (unsigned)fq;
        const unsigned lp = (lrow * PITCH + (unsigned)(wc * 32) + 8u * (unsigned)fq) * 2u;
        const unsigned char* sb = S8 + (size_t)(u.pm >> 3) * GATE_GROUP_BYTES + (size_t)(u.pm & 7) * 256 * rowb + (size_t)u.pn * 256;
        const unsigned char* pn_ = sb + (size_t)j * gstride; const unsigned char* pd_ = sb + (size_t)(fin ? 2 : j + 1) * gstride;
        bf16_t* pmg = P + (size_t)u.pm * 256 * PITCH + C_MERGED + (size_t)u.pn * 256;
#pragma unroll
        for (int ai = 0; ai < 2; ++ai)
#pragma unroll
        for (int mh = 0; mh < 2; ++mh) {
            u32x2 sn[2][2], sd[2][2];
#pragma unroll
            for (int mm = 0; mm < 2; ++mm)
#pragma unroll
                for (int bj = 0; bj < 2; ++bj) { const size_t ro = (size_t)(ai * 128 + (mh * 2 + mm) * 16) * rowb + bj * 128;
                    sn[mm][bj] = *(const u32x2*)(pn_ + ro + ls); sd[mm][bj] = *(const u32x2*)(pd_ + ro + ls); }
#pragma unroll
            for (int mm = 0; mm < 2; ++mm)
#pragma unroll
                for (int bj = 0; bj < 2; ++bj) { const int m = mh * 2 + mm;
#pragma unroll
                    for (int n = 0; n < 2; ++n) { const unsigned sdw = fin ? 0xffffffffu : sd[mm][bj][n];
#pragma unroll
                        for (int e = 0; e < 4; ++e) { const float qn = (float)((sn[mm][bj][n] >> (8 * e)) & 0xffu), qd = (float)((sdw >> (8 * e)) & 0xffu);
                            acc[ai][bj][m][n][e] *= qn * __builtin_amdgcn_rcpf(qd); } }
                    if (fin) { const f32x4 v0 = acc[ai][bj][m][0], v1 = acc[ai][bj][m][1];
                        u32x4 w; w.x = cvt_pk_bf16(v0[0], v0[1]); w.y = cvt_pk_bf16(v0[2], v0[3]); w.z = cvt_pk_bf16(v1[0], v1[1]); w.w = cvt_pk_bf16(v1[2], v1[3]);
                        *(u32x4*)((char*)(pmg + (size_t)(ai * 128 + m * 16) * PITCH + bj * 128) + lp) = w; } }
        }
    }
};

struct SchedP4 {
    pg8::TileOrder T; const char* P; const char* W;
    __device__ __forceinline__ bool next(int i, pg8::Unit& u) const { int pm, pn; if (!T.tile(i, pm, pn)) return false;
        u.pm = pm; u.pn = pn; u.kind = 0; u.nt = D / 64; u.A = P + ((size_t)pm * 256 * PITCH + C_MERGED) * 2; u.B = W + (size_t)pn * 256 * D * 2; return true; }
};
struct EpiP4 {
    bf16_t* P; float* rss_out; unsigned char* xb8;
    __device__ __forceinline__ void operator()(f32x4 (&acc)[2][2][4][2], const pg8::Unit& u, int wr, int wc, int fr, int fq) const {
        unsigned lrow = (unsigned)(wr * 64 + fr); asm volatile("" : "+v"(lrow));
        const unsigned lc = (unsigned)(wc * 32) + 8u * (unsigned)fq;
        const unsigned lp = (lrow * PITCH + lc) * 2u, lx = (lrow * D + lc) * 4u, l8 = lrow * D + lc;
        const size_t ux = (size_t)u.pm * 256 * D + (size_t)u.pn * 256;
        bf16_t* pb = P + (size_t)u.pm * 256 * PITCH + (size_t)u.pn * 256 + XB_COL;
        float* rb = rss_out + (size_t)u.pm * 256 * 16 + u.pn * 4 + wc;
#pragma unroll
        for (int ai = 0; ai < 2; ++ai)
#pragma unroll
        for (int mh = 0; mh < 2; ++mh) {
            u32x4 hv[2][2];
#pragma unroll
            for (int mm = 0; mm < 2; ++mm)
#pragma unroll
                for (int bj = 0; bj < 2; ++bj) hv[mm][bj] = *(const u32x4*)((const char*)(pb + (size_t)(ai * 128 + (mh * 2 + mm) * 16) * PITCH + bj * 128) + lp);
#pragma unroll
            for (int mm = 0; mm < 2; ++mm) {
                const int m = mh * 2 + mm; float ss = 0.f;
#pragma unroll
                for (int bj = 0; bj < 2; ++bj) { const size_t ro = (size_t)(ai * 128 + m * 16) * D + bj * 128;
                    const f32x4 v0 = (f32x4){bf_lo(hv[mm][bj].x), bf_hi(hv[mm][bj].x), bf_lo(hv[mm][bj].y), bf_hi(hv[mm][bj].y)} + acc[ai][bj][m][0], v1 = (f32x4){bf_lo(hv[mm][bj].z), bf_hi(hv[mm][bj].z), bf_lo(hv[mm][bj].w), bf_hi(hv[mm][bj].w)} + acc[ai][bj][m][1];
                    ss += (v0[0] * v0[0] + v0[1] * v0[1]) + (v0[2] * v0[2] + v0[3] * v0[3]) + (v1[0] * v1[0] + v1[1] * v1[1]) + (v1[2] * v1[2] + v1[3] * v1[3]);
                    u32x4 w; w.x = cvt_pk_bf16(v0[0], v0[1]); w.y = cvt_pk_bf16(v0[2], v0[3]); w.z = cvt_pk_bf16(v1[0], v1[1]); w.w = cvt_pk_bf16(v1[2], v1[3]);
                    *(u32x4*)((char*)(pb + (size_t)(ai * 128 + m * 16) * PITCH + bj * 128) + lp) = w;
                    *(u32x2*)((xb8 + ux + ro) + l8) = (u32x2){pk4_fp8(v0[0], v0[1], v0[2], v0[3]), pk4_fp8(v1[0], v1[1], v1[2], v1[3])};
 }
                ss += __shfl_xor(ss, 16); ss += __shfl_xor(ss, 32);
                if (fq == 0) *(float*)((char*)(rb + (ai * 128 + m * 16) * 16) + lrow * 64u) = ss;
            }
        }
        ZERO_ACC(acc);
    }
};

struct EpiP4F {

    const bf16_t* P; float* out; float* rss_out; const float* fg; unsigned* cnt; unsigned* tmo;
    __device__ __forceinline__ void operator()(f32x4 (&acc)[2][2][4][2], const pg8::Unit& u, int wr, int wc, int fr, int fq) const {
        unsigned lrow = (unsigned)(wr * 64 + fr); asm volatile("" : "+v"(lrow));
        const unsigned lc = (unsigned)(wc * 32) + 8u * (unsigned)fq;
        const unsigned lx = (lrow * D + lc) * 4u;
        const unsigned lp = (lrow * PITCH + lc) * 2u, l8 = lrow * D + lc;
        const bf16_t* pxb = P + (size_t)u.pm * 256 * PITCH + (size_t)u.pn * 256 + XB_COL;
        const size_t ux = (size_t)u.pm * 256 * D + (size_t)u.pn * 256;
        float* rb = rss_out + (size_t)u.pm * 256 * 16 + u.pn * 4 + wc;
#pragma unroll
        for (int ai = 0; ai < 2; ++ai)
#pragma unroll
        for (int mh = 0; mh < 2; ++mh) {
            f32x4 xo[2][2][2]; u32x4 hv[2][2];
#pragma unroll
            for (int mm = 0; mm < 2; ++mm)
#pragma unroll
                for (int bj = 0; bj < 2; ++bj) hv[mm][bj] = *(const u32x4*)((const char*)(pxb + (size_t)(ai * 128 + (mh * 2 + mm) * 16) * PITCH + bj * 128) + lp);
#pragma unroll
            for (int mm = 0; mm < 2; ++mm)
#pragma unroll
                for (int bj = 0; bj < 2; ++bj)
#pragma unroll
                    for (int n = 0; n < 2; ++n) xo[mm][bj][n] = (f32x4){bf_lo(hv[mm][bj][2 * n]), bf_hi(hv[mm][bj][2 * n]), bf_lo(hv[mm][bj][2 * n + 1]), bf_hi(hv[mm][bj][2 * n + 1])};
#pragma unroll
            for (int mm = 0; mm < 2; ++mm) {
                const int m = mh * 2 + mm; float ss = 0.f;
#pragma unroll
                for (int bj = 0; bj < 2; ++bj) { const f32x4 v0 = xo[mm][bj][0] + acc[ai][bj][m][0], v1 = xo[mm][bj][1] + acc[ai][bj][m][1];
                    acc[ai][bj][m][0] = v0; acc[ai][bj][m][1] = v1;
                    ss += (v0[0] * v0[0] + v0[1] * v0[1]) + (v0[2] * v0[2] + v0[3] * v0[3]) + (v1[0] * v1[0] + v1[1] * v1[1]) + (v1[2] * v1[2] + v1[3] * v1[3]); }
                ss += __shfl_xor(ss, 16); ss += __shfl_xor(ss, 32);
                if (fq == 0) __hip_atomic_store((float*)((char*)(rb + (ai * 128 + m * 16) * 16) + lrow * 64u), ss, __ATOMIC_RELAXED, __HIP_MEMORY_SCOPE_AGENT);
            }
        }
        asm volatile("s_waitcnt vmcnt(0)" ::: "memory");
        const int lane = (int)(threadIdx.x & 63); const int wid = wr * 4 + wc;
        unsigned* pc = cnt + 64 * u.pm;
        if (lane == 0) __hip_atomic_fetch_add(pc, 1u, __ATOMIC_RELAXED, __HIP_MEMORY_SCOPE_AGENT);
        if (wid == 0) {
            asm volatile("buffer_inv sc1" ::: "memory");
            unsigned sp = 0;
            while ((unsigned)__builtin_amdgcn_readfirstlane(__hip_atomic_load(pc, __ATOMIC_RELAXED, __HIP_MEMORY_SCOPE_AGENT)) < 32u) {
                __builtin_amdgcn_s_sleep(1);
                if ((++sp & 255u) == 0u) { if (__hip_atomic_load(tmo, __ATOMIC_RELAXED, __HIP_MEMORY_SCOPE_AGENT)) break; if (sp > (1u << 20)) { if (lane == 0) atomicAdd(tmo, 1u); break; } } }
            asm volatile("s_waitcnt vmcnt(0)" ::: "memory");
        }
        asm volatile("" ::: "memory"); __builtin_amdgcn_s_barrier(); asm volatile("" ::: "memory");
        const unsigned lr = lrow * 64u;
        const size_t ur = (size_t)u.pm * 256 * 16;
        f32x4 pr[2][4];
#pragma unroll
        for (int ai = 0; ai < 2; ++ai)
#pragma unroll
            for (int m = 0; m < 4; ++m) pr[ai][m] = *(const f32x4*)((const char*)(rss_out + ur + (ai * 128 + m * 16) * 16) + (lr + 16u * fq));
        f32x4 gv[2][2];
#pragma unroll
        for (int bj = 0; bj < 2; ++bj) { const float* gp = (const float*)((const char*)(fg + u.pn * 256 + bj * 128) + lc * 4u); gv[bj][0] = *(const f32x4*)gp; gv[bj][1] = *(const f32x4*)(gp + 4); }
#pragma unroll
        for (int ai = 0; ai < 2; ++ai)
#pragma unroll
            for (int m = 0; m < 4; ++m) { const float rs = rstd_of(pr[ai][m]);
#pragma unroll
                for (int bj = 0; bj < 2; ++bj) { float* xq = (float*)((char*)(out + ux + (size_t)(ai * 128 + m * 16) * D + bj * 128) + lx);
                    *(f32x4*)xq = acc[ai][bj][m][0] * rs * gv[bj][0]; *(f32x4*)(xq + 4) = acc[ai][bj][m][1] * rs * gv[bj][1]; } }
        ZERO_ACC(acc);
    }
};

#define LDG(T, uptr, lboff) (*(const T*)((const char*)(uptr) + (lboff)))
#define STG(T, uptr, lboff, val) (*(T*)((char*)(uptr) + (lboff)) = (val))
typedef short s16x4 __attribute__((ext_vector_type(4)));
__device__ __forceinline__ s16x4 lds_tr16(const LAS void* p) { return __builtin_amdgcn_ds_read_tr16_b64_v4i16((LAS s16x4*)p); }
template <int TH> __device__ __forceinline__ void mixer_a_body(bf16_t* P, const float* lns, const bf16_t* Wm, const float* ln_g, const float* ln_b, const float* b_s, LAS unsigned char* wl, int n, int g, int lane) {
    constexpr int SLEN = 64 * (TH + 1), NV = SLEN / 8, NKS = 2 * (TH + 1);
    const int T0 = n * 128;
    constexpr int VB = 136;
    constexpr int OB = 272;
    const int ck = lane & 7, rsub = lane >> 3;
    const int fr = lane & 15, fq = lane >> 4;
    const unsigned lv = (unsigned)(rsub * PITCH + ck * 8) * 2u;
    const unsigned lw = (unsigned)(fr * 128 + fq * 8) * 2u;
    const bf16_t* pv = P + (size_t)T0 * PITCH + C_V + g * 64;
    u32x4 raw[NV];
#pragma unroll
    for (int q = 0; q < NV; ++q) raw[q] = LDG(u32x4, pv + (size_t)(q * 8) * PITCH, lv);
    f32x4 st[TH + 1][4];
#pragma unroll
    for (int h = 0; h <= TH; ++h)
#pragma unroll
        for (int j = 0; j < 4; ++j) st[h][j] = LDG(f32x4, lns + (size_t)(T0 + 64 * h) * 16 + 4 * j, (unsigned)lane * 64u);
    float lg[8], lb[8];
    { const f32x4 g0 = LDG(f32x4, ln_g + g * 64, (unsigned)ck * 32u), g1 = LDG(f32x4, ln_g + g * 64 + 4, (unsigned)ck * 32u), b0 = LDG(f32x4, ln_b + g * 64, (unsigned)ck * 32u), b1 = LDG(f32x4, ln_b + g * 64 + 4, (unsigned)ck * 32u);
#pragma unroll
      for (int j = 0; j < 4; ++j) { lg[j] = g0[j]; lg[4 + j] = g1[j]; lb[j] = b0[j]; lb[4 + j] = b1[j]; } }
    float mean[TH + 1], rstd[TH + 1];
#pragma unroll
    for (int h = 0; h <= TH; ++h) { const f32x4 a = st[h][0], b = st[h][1], c = st[h][2], d = st[h][3];
        const float s1 = (a.x + a.z) + (b.x + b.z) + (c.x + c.z) + (d.x + d.z), s2 = (a.y + a.w) + (b.y + b.w) + (c.y + c.w) + (d.y + d.w);
        mean[h] = s1 * (1.f / 512.f); rstd[h] = __builtin_amdgcn_rsqf(fmaxf(s2 * (1.f / 512.f) - mean[h] * mean[h], 0.f) + LN_EPS); }
#pragma unroll
    for (int q = 0; q < NV; ++q) { const int s = q * 8 + rsub;
        const float mu = __shfl(mean[(q * 8) >> 6], s & 63), rs = __shfl(rstd[(q * 8) >> 6], s & 63);
        unsigned pk[4];
#pragma unroll
        for (int j = 0; j < 4; ++j) pk[j] = cvt_pk_bf16((bf_lo(raw[q][j]) - mu) * rs * lg[2 * j] + lb[2 * j], (bf_hi(raw[q][j]) - mu) * rs * lg[2 * j + 1] + lb[2 * j + 1]);
        LAS unsigned char* wp = wl + s * VB + ck * 16;
        *(LAS u32x2*)wp = (u32x2){pk[0], pk[1]}; *(LAS u32x2*)(wp + 8) = (u32x2){pk[2], pk[3]}; }
    LDS_WAIT(); asm volatile("" ::: "memory");
    f32x4 acc[4][4];
#pragma unroll
    for (int ct = 0; ct < 4; ++ct)
#pragma unroll
        for (int tt = 0; tt < 4; ++tt) acc[ct][tt] = (f32x4){0.f, 0.f, 0.f, 0.f};
    const bf16_t* wmg = Wm + (size_t)g * 128 * 128 + (size_t)(64 * TH) * 128;
    const LAS unsigned char* trp = wl + (8 * fq + (fr >> 2)) * VB + (fr & 3) * 8;
#pragma unroll 1
    for (int ks = 0; ks < NKS; ++ks) {
        bf16x8 af[4], bfr[4];
#pragma unroll
        for (int tt = 0; tt < 4; ++tt) bfr[tt] = LDG(bf16x8, wmg + (16 * tt) * 128 + ks * 32, lw);
#pragma unroll
        for (int ct = 0; ct < 4; ++ct) { const s16x4 a0 = lds_tr16(trp + (ks * 32) * VB + ct * 32), a1 = lds_tr16(trp + (ks * 32 + 4) * VB + ct * 32);
            af[ct] = (bf16x8){a0[0], a0[1], a0[2], a0[3], a1[0], a1[1], a1[2], a1[3]}; }
#pragma unroll
        for (int ct = 0; ct < 4; ++ct)
#pragma unroll
            for (int tt = 0; tt < 4; ++tt) acc[ct][tt] = __builtin_amdgcn_mfma_f32_16x16x32_bf16(af[ct], bfr[tt], acc[ct][tt], 0, 0, 0);
    }
    LDS_WAIT(); asm volatile("" ::: "memory");
#pragma unroll
    for (int tt = 0; tt < 4; ++tt)
#pragma unroll
        for (int ct = 0; ct < 4; ++ct) *(LAS f32x4*)(wl + (16 * tt + fr) * OB + (16 * ct + 4 * fq) * 4) = acc[ct][tt];
    LDS_WAIT(); asm volatile("" ::: "memory");
    bf16_t* po = P + (size_t)(T0 + 64 * TH) * PITCH + g * 64;
    const float* bsp = b_s + g * 128 + 64 * TH;
#pragma unroll
    for (int hf = 0; hf < 2; ++hf) {
        u32x4 uu[4], zz[4]; float bs[4];
#pragma unroll
        for (int q = 0; q < 4; ++q) { uu[q] = LDG(u32x4, po + (size_t)((hf * 4 + q) * 8) * PITCH + C_U, lv); zz[q] = LDG(u32x4, po + (size_t)((hf * 4 + q) * 8) * PITCH + C_ZA, lv);
            bs[q] = LDG(float, bsp + (hf * 4 + q) * 8, (unsigned)rsub * 4u); }
#pragma unroll
        for (int q = 0; q < 4; ++q) { const int t = (hf * 4 + q) * 8 + rsub;
            const f32x4 s0 = *(const LAS f32x4*)(wl + t * OB + ck * 32), s1 = *(const LAS f32x4*)(wl + t * OB + ck * 32 + 16);
            u32x4 w;
#pragma unroll
            for (int j = 0; j < 4; ++j) { const f32x2 s2 = (j < 2 ? (f32x2){s0[2 * j], s0[2 * j + 1]} : (f32x2){s1[2 * j - 4], s1[2 * j - 3]}) + bs[q];
                const f32x2 o = gelu2(bf2(uu[q][j])) * s2 * silu2(bf2(zz[q][j]));
                w[j] = cvt_pk_bf16(o.x, o.y); }
            STG(u32x4, po + (size_t)((hf * 4 + q) * 8) * PITCH + C_U, lv, w); }
    }
    LDS_WAIT(); asm volatile("" ::: "memory");
}
__device__ __forceinline__ void mixer_a_item(bf16_t* P, const float* lns, const bf16_t* Wm, const float* ln_g, const float* ln_b, const float* b_s, LAS unsigned char* wl, int item, int lane) {
    const int th = item & 1, g = (item >> 1) & 7, n = item >> 4;
    if (th) mixer_a_body<1>(P, lns, Wm, ln_g, ln_b, b_s, wl, n, g, lane); else mixer_a_body<0>(P, lns, Wm, ln_g, ln_b, b_s, wl, n, g, lane);
}

__device__ __forceinline__ void mixer_b_item(bf16_t* P, const float* conv_w, const float* conv_b, int item, int lane) {
    const int hb = item & 1, t0 = (item >> 1) * 16;
    const bool seq_start = (t0 % SEQ) == 0;
    bf16_t* pbase = P + (size_t)t0 * PITCH + hb * 256;
    const unsigned l8 = (unsigned)lane * 8u, l16 = (unsigned)lane * 16u;
    const f32x4 w0 = LDG(f32x4, conv_w + hb * 256, l16), w1 = LDG(f32x4, conv_w + 512 + hb * 256, l16), w2 = LDG(f32x4, conv_w + 1024 + hb * 256, l16), cb = LDG(f32x4, conv_b + hb * 256, l16);
    f32x4 pm2 = (f32x4){0.f, 0.f, 0.f, 0.f}, pm1 = pm2;
#pragma unroll
    for (int hf = 0; hf < 2; ++hf) {
        u32x2 xx[10], cc[10], bb[8], zz[8];
#pragma unroll
        for (int r = (hf ? 2 : 0); r < 10; ++r) { const int dt = hf * 8 + r - 2; const bool ok = (dt >= 0) || !seq_start;
            xx[r] = ok ? LDG(u32x2, pbase + (ptrdiff_t)dt * PITCH + C_XB, l8) : (u32x2){0u, 0u}; cc[r] = ok ? LDG(u32x2, pbase + (ptrdiff_t)dt * PITCH + C_CG, l8) : (u32x2){0u, 0u}; }
#pragma unroll
        for (int r = 0; r < 8; ++r) { bb[r] = LDG(u32x2, pbase + (size_t)(hf * 8 + r) * PITCH + C_BG, l8); zz[r] = LDG(u32x2, pbase + (size_t)(hf * 8 + r) * PITCH + C_ZB, l8); }
        if (hf == 0) {
            pm2 = (f32x4){bf_lo(xx[0].x) * bf_lo(cc[0].x), bf_hi(xx[0].x) * bf_hi(cc[0].x), bf_lo(xx[0].y) * bf_lo(cc[0].y), bf_hi(xx[0].y) * bf_hi(cc[0].y)};
            pm1 = (f32x4){bf_lo(xx[1].x) * bf_lo(cc[1].x), bf_hi(xx[1].x) * bf_hi(cc[1].x), bf_lo(xx[1].y) * bf_lo(cc[1].y), bf_hi(xx[1].y) * bf_hi(cc[1].y)}; }
#pragma unroll
        for (int r = 0; r < 8; ++r) {
            const f32x4 p0 = (f32x4){bf_lo(xx[r + 2].x) * bf_lo(cc[r + 2].x), bf_hi(xx[r + 2].x) * bf_hi(cc[r + 2].x), bf_lo(xx[r + 2].y) * bf_lo(cc[r + 2].y), bf_hi(xx[r + 2].y) * bf_hi(cc[r + 2].y)};
            const f32x4 y = cb + w0 * pm2 + w1 * pm1 + w2 * p0;
            const f32x4 bg = (f32x4){bf_lo(bb[r].x), bf_hi(bb[r].x), bf_lo(bb[r].y), bf_hi(bb[r].y)};
            const f32x2 zb0 = silu2(bf2(zz[r].x)), zb1 = silu2(bf2(zz[r].y)); const f32x4 zb = (f32x4){zb0.x, zb0.y, zb1.x, zb1.y};
            const f32x4 o = bg * y * zb;
            u32x2 w; w.x = cvt_pk_bf16(o[0], o[1]); w.y = cvt_pk_bf16(o[2], o[3]); STG(u32x2, pbase + (size_t)(hf * 8 + r) * PITCH + C_ZB, l8, w);
            pm2 = pm1; pm1 = p0; }
    }
}

template <int W> __device__ __forceinline__ void mixer_c_pool(const bf16_t* pxc  , LAS bf16_t* pl, int PL_LD, int tseq, int lane) {
    constexpr int NR = 31 + W;
    unsigned xv[NR];
#pragma unroll
    for (int r = 0; r < NR; ++r) { const int dt = r - (W - 1); xv[r] = (dt >= 0 || tseq > 0) ? LDG(unsigned, pxc + (ptrdiff_t)dt * PITCH, (unsigned)lane * 4u) : 0u; }
    float s0 = 0.f, s1 = 0.f;
#pragma unroll
    for (int r = 0; r < NR; ++r) {
        const int dt = r - (W - 1);
        s0 += bf_lo(xv[r]); s1 += bf_hi(xv[r]);
        if (r >= W) { s0 -= bf_lo(xv[r - W]); s1 -= bf_hi(xv[r - W]); }
        if (dt >= 0) { const int pos = tseq + dt; const float inv = 1.0f / (float)((pos + 1 < W) ? (pos + 1) : W);
            *(LAS unsigned*)(pl + dt * PL_LD + 2 * lane) = cvt_pk_bf16(s0 * inv - bf_lo(xv[r]), s1 * inv - bf_hi(xv[r])); }
    }
}
__device__ __forceinline__ void mixer_c_item(bf16_t* P, const bf16_t* WpT, LAS unsigned char* wl, int item, int lane) {
    const int gi = item & 3, t0 = (item >> 2) * 32;
    constexpr int PL_LD = 136;
    constexpr int OB = 528;
    LAS bf16_t* pl = (LAS bf16_t*)wl;
    const bf16_t* pxc = P + (size_t)t0 * PITCH + C_XC + gi * 128; const int tseq = t0 % SEQ;
    if (gi == 0) mixer_c_pool<2>(pxc, pl, PL_LD, tseq, lane);
    else if (gi == 1) mixer_c_pool<4>(pxc, pl, PL_LD, tseq, lane);
    else if (gi == 2) mixer_c_pool<8>(pxc, pl, PL_LD, tseq, lane);
    else mixer_c_pool<16>(pxc, pl, PL_LD, tseq, lane);
    LDS_WAIT(); asm volatile("" ::: "memory");
    const int fr = lane & 15, fq = lane >> 4;
    const unsigned lw = (unsigned)(fr * 128 + fq * 8) * 2u;
    bf16x8 bfr[2][4];
#pragma unroll
    for (int tt = 0; tt < 2; ++tt)
#pragma unroll
        for (int ks = 0; ks < 4; ++ks) bfr[tt][ks] = *(const LAS bf16x8*)(pl + (tt * 16 + fr) * PL_LD + ks * 32 + fq * 8);
    LDS_WAIT(); asm volatile("" ::: "memory");
    const bf16_t* wg = WpT + (size_t)gi * 128 * 128;
#pragma unroll 2
    for (int dp = 0; dp < 4; ++dp) {
        bf16x8 af[2][4];
#pragma unroll
        for (int d2 = 0; d2 < 2; ++d2)
#pragma unroll
            for (int ks = 0; ks < 4; ++ks) af[d2][ks] = LDG(bf16x8, wg + (size_t)((dp * 2 + d2) * 16) * 128 + ks * 32, lw);
#pragma unroll
        for (int d2 = 0; d2 < 2; ++d2) {
            f32x4 a0 = (f32x4){0.f, 0.f, 0.f, 0.f}, a1 = a0;
#pragma unroll
            for (int ks = 0; ks < 4; ++ks) { a0 = __builtin_amdgcn_mfma_f32_16x16x32_bf16(af[d2][ks], bfr[0][ks], a0, 0, 0, 0); a1 = __builtin_amdgcn_mfma_f32_16x16x32_bf16(af[d2][ks], bfr[1][ks], a1, 0, 0, 0); }
            *(LAS f32x4*)(wl + fr * OB + ((dp * 2 + d2) * 16 + 4 * fq) * 4) = a0; *(LAS f32x4*)(wl + (16 + fr) * OB + ((dp * 2 + d2) * 16 + 4 * fq) * 4) = a1; }
    }
    LDS_WAIT(); asm volatile("" ::: "memory");
    bf16_t* pz = P + (size_t)t0 * PITCH + C_ZC + gi * 128;
    const int r4 = lane >> 4, c16 = lane & 15;
    const unsigned lz = (unsigned)(r4 * PITCH + c16 * 8) * 2u;
    u32x4 zv[8];
#pragma unroll
    for (int q = 0; q < 8; ++q) zv[q] = LDG(u32x4, pz + (size_t)(q * 4) * PITCH, lz);
#pragma unroll
    for (int q = 0; q < 8; ++q) { const int t = q * 4 + r4;
        const f32x4 s0 = *(const LAS f32x4*)(wl + t * OB + c16 * 32), s1 = *(const LAS f32x4*)(wl + t * OB + c16 * 32 + 16);
        u32x4 w;
#pragma unroll
        for (int j = 0; j < 4; ++j) { const float sa = (j < 2 ? s0[2 * j] : s1[2 * j - 4]), sb = (j < 2 ? s0[2 * j + 1] : s1[2 * j - 3]);
            { const f32x2 o = (f32x2){sa, sb} * silu2(bf2(zv[q][j])); w[j] = cvt_pk_bf16(o.x, o.y); } }
        STG(u32x4, pz + (size_t)(q * 4) * PITCH, lz, w); }
    LDS_WAIT(); asm volatile("" ::: "memory");
}

__global__ void __launch_bounds__(NWAVES * 64, 2) hybrid_fwd(Args args) {
    extern __shared__ __attribute__((aligned(16))) unsigned char lds_raw[];
    LAS unsigned char* lds = (LAS unsigned char*)lds_raw;
    volatile LAS unsigned* MISC = (volatile LAS unsigned*)(lds + MISC_OFF);
    const int tid = threadIdx.x, lane = tid & 63, wave = __builtin_amdgcn_readfirstlane(tid >> 6);
    const int G = gridDim.x; const int bx = blockIdx.x;
    const int vcu = (G % 8 == 0) ? (bx % 8) * (G / 8) + bx / 8 : bx;
    const int gw = vcu * NWAVES + wave, NGW = G * NWAVES;
    unsigned char* ws = args.ws;
    for (int u = tid; u < (LDS_BYTES - LDSCTL_OFF) / 4; u += NWAVES * 64) ((LAS unsigned*)(lds + LDSCTL_OFF))[u] = 0u;
    __syncthreads();
    const XcdBarrier bar = xcd_barrier_post((unsigned*)(ws + WS_CTL), MISC + 8, (unsigned)G);
    (void)xcd_barrier_post((unsigned*)(ws + WS_CTL) + (1 + (bx & 7)) * XCD_BAR_WORDS, MISC + 10, (unsigned)(G / 8));
    const int lo = args.ph_lo, hi = args.ph_hi;
#define IN(k) (lo <= (k) && (k) < hi)
#define SEAM(k) do { if (IN(k) && IN((k) + 1)) xcd_barrier(bar); } while (0)
#define CW_PROG 47104
#define GSEAM_W(k, nbr, tgt) GSEAM_X(k, nbr, tgt, false)
#define GSEAM_X(k, nbr, tgt, loc) do { if (IN(k) && IN((k) + 1)) { XcdBarrier gb; gb.bar = (unsigned*)(args.ws + WS_CTL) + (1 + ((int)blockIdx.x & 7)) * XCD_BAR_WORDS; gb.x = bar.x; gb.st = MISC + 10; gb.G = gridDim.x / 8; \
        unsigned* pw_ = (unsigned*)(args.ws + WS_CTL) + CW_PROG; const int nb_ = (nbr); \
        xcd_barrier(gb, nb_ >= 0 ? pw_ + 64 * nb_ : nullptr, (unsigned)(tgt), ((int)blockIdx.x >> 3) == 0 ? pw_ + 64 * ((int)blockIdx.x & 7) : nullptr, (loc)); } } while (0)
#define GSEAM(k) GSEAM_X(k, -1, 0, true)

    bf16_t* P = (bf16_t*)(ws + WS_P);
    float* rss = (float*)(ws + WS_RSS);
    float* lns = (float*)(ws + WS_LNS);

    if (IN(0)) { p0_prologue(args, lds, gw, NGW, wave, lane); }
    SEAM(0);

    for (int l = 0; l < DEPTH; ++l) {
        const int pb = 1 + 4 * l;
        const bf16_t* Wmix = (const bf16_t*)(ws + WS_WMIX) + (size_t)l * NMIX * D;
        const bf16_t* W3 = (const bf16_t*)(ws + WS_W3) + (size_t)l * D * K3;
        const bf16_t* WoT = (const bf16_t*)(ws + WS_WO) + (size_t)l * D * D;
        const float* rss_l = rss + (size_t)l * M * 16;
        if (IN(pb)) {
            const int jg = bx >> 3; const bool five = (G == 256) && (bx < 128);
            for (int pass = 0; pass < 2; ++pass) {
                if ((pass == 0) != five) {
                    SchedG S; S.x = bx & 7; S.r = jg & 15; S.n = five ? 1 : 2; S.c0 = five ? 4 : 0; S.sq = five ? 0 : 2;     S.A8 = (const char*)(ws + WS_XB8); S.W8 = (const char*)(ws + WS_WG8 + (size_t)l * 3 * D * D);
                    EpiP3G E{(unsigned char*)args.out, GATE_PLANE_BYTES, (unsigned)D, rss_l};
                    pg8::gemm_phase<EpiP3G, SchedG, true, true>(lds, D, D, S, E);
                } else {
                    SchedP1 S; S.T.init(M, NMIX, G, bx, P1_WGM); S.P = (const char*)P; S.W = (const char*)Wmix;
                    EpiP1 E{P, rss_l, lns};
                    pg8::gemm_phase<EpiP1, SchedP1, true>(lds, PITCH * 2, D * 2, S, E);
                }
            }
        }
        GSEAM_W(pb, (bx & 3) != 0 ? (bx & 7) - 1 : -1, 1 + 4 * l);
        if (IN(pb + 1)) {
            const bf16_t* Wm = (const bf16_t*)(ws + WS_WM) + (size_t)l * 8 * 128 * 128;
            const bf16_t* WpT = (const bf16_t*)(ws + WS_WPOOL) + (size_t)l * 4 * 128 * 128;
            LAS unsigned char* wl = lds + wave * WAVE_LDS;
            int ln = lane; asm volatile("" : "+v"(ln));
            { const int x = bx & 7, e = bx >> 3;
              SchedG S; S.x = x; S.r = e & 15; S.A8 = (const char*)(ws + WS_XB8); S.W8 = (const char*)(ws + WS_WG8 + (size_t)l * 3 * D * D);
              EpiP3G E{(unsigned char*)args.out, GATE_PLANE_BYTES, (unsigned)D, rss_l};
              if (G != 256) { for (int li = e * NWAVES + wave; li < 768; li += (G / 8) * NWAVES) { const int j = 256 * x + (li & 255);
                  if (li < 256) mixer_a_item(P, lns, Wm, args.in[3] + l * 512, args.in[4] + l * 512, args.in[6] + l * 1024, wl, j, ln);
                  else if (li < 512) mixer_b_item(P, args.in[7] + l * 1536, args.in[8] + l * 512, j, ln);
                  else mixer_c_item(P, WpT, wl, j, ln); } }
              else if (e < 16) {
                for (int li = e * 8 + wave; li < 512; li += 128) { const int j = 256 * x + (li & 255);
                  if (li < 256) mixer_a_item(P, lns, Wm, args.in[3] + l * 512, args.in[4] + l * 512, args.in[6] + l * 1024, wl, j, ln);
                  else mixer_b_item(P, args.in[7] + l * 1536, args.in[8] + l * 512, j, ln); }
                __syncthreads();
                S.n = 1; S.c0 = 10; S.sq = 0;
                pg8::gemm_phase<EpiP3G, SchedG, true, true>(lds, D, D, S, E); }
              else {
                S.n = 2; S.c0 = 6; S.sq = 2;
                pg8::gemm_phase<EpiP3G, SchedG, true, true>(lds, D, D, S, E);
                for (int li = 512 + (e - 16) * 8 + wave; li < 768; li += 128) mixer_c_item(P, WpT, wl, 256 * x + (li & 255), ln); } }
        }
        GSEAM(pb + 1);
        if (IN(pb + 2)) {
            pg8::TileOrder T; T.init(M, D, G, bx); int pm3, pn3;
            if (T.tile(0, pm3, pn3)) {
                SchedP3Y S; S.pm = pm3; S.pn = pn3; S.P = (const char*)P; S.W = (const char*)W3; EpiP3Y E{P, (const unsigned char*)args.out, GATE_PLANE_BYTES, (unsigned)D};
                pg8::gemm_phase<EpiP3Y, SchedP3Y, true>(lds, PITCH * 2, K3 * 2, S, E);
            }
        }
        GSEAM(pb + 2);
        if (IN(pb + 3)) {
            SchedP4 S; S.T.init(M, D, G, bx); S.P = (const char*)P; S.W = (const char*)WoT;
            if (l == 0) { EpiP4 E{P, rss + (size_t)(l + 1) * M * 16, ws + WS_XB8};
                pg8::gemm_phase<EpiP4, SchedP4, true>(lds, PITCH * 2, D * 2, S, E); }
            else { EpiP4F E{P, args.out, rss + (size_t)2 * M * 16, args.in[15], (unsigned*)(ws + WS_CTL) + CW_PANEL, (unsigned*)(ws + WS_CTL) + XB_TMO};
                pg8::gemm_phase<EpiP4F, SchedP4, true>(lds, PITCH * 2, D * 2, S, E); }
        }
        if (l + 1 < DEPTH) GSEAM_X(pb + 3, (bx & 3) != 3 ? (bx & 7) + 1 : -1, 2 + 4 * l, true);
    }
#undef IN
#undef SEAM
#undef GSEAM
}

extern "C" void kernel_launch(void* const* d_in, const int* in_sizes, int n_in, void* d_out, int out_size, void* d_ws, size_t ws_size, hipStream_t stream) {
    static int grid = 0;
    if (grid == 0) {
        if (n_in != 16 || in_sizes[0] != M * D || out_size != M * D || ws_size < WS_END) { fprintf(stderr, "kernel_launch: unexpected shapes (n_in %d, in0 %d, out %d, ws %zu); nothing launched\n", n_in, n_in > 0 ? in_sizes[0] : -1, out_size, ws_size); grid = -1; return; }
        int dev = 0, cus = 0, per_cu = 0;
        if (hipGetDevice(&dev) != hipSuccess || hipDeviceGetAttribute(&cus, hipDeviceAttributeMultiprocessorCount, dev) != hipSuccess) { grid = -1; return; }
        if (hipFuncSetAttribute((const void*)hybrid_fwd, hipFuncAttributeMaxDynamicSharedMemorySize, LDS_BYTES) != hipSuccess) { fprintf(stderr, "kernel_launch: hipFuncSetAttribute failed\n"); grid = -1; return; }
        if (hipOccupancyMaxActiveBlocksPerMultiprocessor(&per_cu, (const void*)hybrid_fwd, NWAVES * 64, LDS_BYTES) != hipSuccess || per_cu < 1) { fprintf(stderr, "kernel_launch: occupancy query reports %d blocks per CU\n", per_cu); (void)hipGetLastError(); grid = -1; return; }
        if (cus != 256) { fprintf(stderr, "kernel_launch: built for a 256-CU device (the unit assignment is written for 256 workgroups); this one has %d CUs; nothing launched\n", cus); grid = -1; return; }
        grid = cus;
    }
    if (grid < 0) return;
    if (hipMemsetAsync((char*)d_ws + WS_CTL, 0, CTL_ZERO_BYTES, stream) != hipSuccess) return;
    Args a{};
    for (int i = 0; i < 16; ++i) a.in[i] = (const float*)d_in[i];
    a.out = (float*)d_out; a.ws = (unsigned char*)d_ws;
    a.ph_lo = 0; a.ph_hi = 9;
    hipLaunchKernelGGL(hybrid_fwd, dim3(grid), dim3(NWAVES * 64), LDS_BYTES, stream, a);
}
```

```cpp
#include <hip/hip_runtime.h>
#include <cstdio>
#include <cstdint>


#define P1_WGM 2
#define GAS __attribute__((address_space(1)))
#define LAS __attribute__((address_space(3)))
typedef unsigned short bf16_t;
typedef short bf16x8 __attribute__((ext_vector_type(8)));
typedef float f32x4 __attribute__((ext_vector_type(4)));
typedef float f32x2 __attribute__((ext_vector_type(2)));
typedef unsigned u32x4 __attribute__((ext_vector_type(4)));
typedef unsigned u32x2 __attribute__((ext_vector_type(2)));

constexpr int SEQ = 8192, D = 1024, M = 2 * SEQ, DEPTH = 2;
constexpr int IN_TOTAL = 7680;
constexpr int NMIX = 4608;
constexpr int PITCH = NMIX + D;
constexpr int XB_COL = NMIX;
constexpr int C_U = 0, C_ZB = 512, C_ZC = 1024, C_V = 1536, C_ZA = 2048, C_XB = 2560, C_BG = 3072, C_CG = 3584, C_XC = 4096;
constexpr int C_S = 1536, C_MERGED = 1536;
constexpr int K3 = 1536;
constexpr float RMS_EPS = 1e-6f, LN_EPS = 1e-5f;

constexpr size_t MiB = 1u << 20;
constexpr size_t WS_CTL = 0, CTL_ZERO_BYTES = 192 * 1024;
constexpr int CW_PANEL = 40960;
constexpr size_t WS_RSS = 1 * MiB;
constexpr size_t WS_LNS = 4 * MiB;
constexpr size_t WS_WMIX = 5 * MiB;
constexpr size_t WS_W3 = 23 * MiB;
constexpr size_t WS_WO = 29 * MiB;
constexpr size_t WS_WM = 33 * MiB;
constexpr size_t WS_WPOOL = WS_WM + 512 * 1024;
constexpr size_t WS_P = 34 * MiB;
constexpr size_t WS_XB8 = WS_P + (size_t)M * PITCH * 2;
constexpr size_t WS_WG8 = WS_XB8 + (size_t)M * D;
constexpr float WG8_SCALE = 64.0f;
constexpr size_t GATE_GROUP_BYTES = 8 * MiB, GATE_PLANE_BYTES = 2 * MiB;
constexpr size_t WS_END = WS_WG8 + (size_t)DEPTH * 3 * D * D;
static_assert(WS_END <= 256 * MiB, "workspace map");

constexpr int NWAVES = 8;
constexpr int RING_BYTES = 131072;
constexpr int WAVE_LDS = 17920;
constexpr int LDSCTL_OFF = 143360, MISC_OFF = LDSCTL_OFF + 320;
constexpr int LDS_BYTES = 147456;

#define RLX_AGENT __ATOMIC_RELAXED, __HIP_MEMORY_SCOPE_AGENT
#define LDS_WAIT() asm volatile("s_waitcnt lgkmcnt(0)" ::: "memory")
#define VM_WAIT() asm volatile("s_waitcnt vmcnt(0)" ::: "memory")

__device__ __forceinline__ unsigned cvt_pk_bf16(float lo, float hi) { unsigned r; asm volatile("v_cvt_pk_bf16_f32 %0, %1, %2" : "=v"(r) : "v"(lo), "v"(hi)); return r; }
__device__ __forceinline__ unsigned pk4_fp8(float a, float b, float c, float d) { int w = 0; w = __builtin_amdgcn_cvt_pk_fp8_f32(a, b, w, false); w = __builtin_amdgcn_cvt_pk_fp8_f32(c, d, w, true); return (unsigned)w; }
__device__ __forceinline__ float bf_lo(unsigned w) { return __builtin_bit_cast(float, w << 16); }
__device__ __forceinline__ float bf_hi(unsigned w) { return __builtin_bit_cast(float, w & 0xffff0000u); }
__device__ __forceinline__ float sigmoid_f(float x) { return __builtin_amdgcn_rcpf(1.0f + __builtin_amdgcn_exp2f(-1.4426950409f * x)); }
__device__ __forceinline__ float silu_f(float x) { return x * sigmoid_f(x); }
__device__ __forceinline__ f32x2 bf2(unsigned w) { return (f32x2){bf_lo(w), bf_hi(w)}; }
__device__ __forceinline__ f32x2 rcp2(f32x2 d) { return (f32x2){__builtin_amdgcn_rcpf(d.x), __builtin_amdgcn_rcpf(d.y)}; }
__device__ __forceinline__ f32x2 exp2_2(f32x2 t) { return (f32x2){__builtin_amdgcn_exp2f(t.x), __builtin_amdgcn_exp2f(t.y)}; }
__device__ __forceinline__ f32x2 silu2(f32x2 x) { return x * rcp2(exp2_2(x * -1.4426950409f) + 1.0f); }
__device__ __forceinline__ f32x2 gelu2(f32x2 x) { const f32x2 t = x * x * (-2.3022081981f * 0.044715f) + (-2.3022081981f); return x * rcp2(exp2_2(x * t) + 1.0f); }
__device__ __forceinline__ float gelu_tanh_f(float x) { return x * __builtin_amdgcn_rcpf(1.0f + __builtin_amdgcn_exp2f(x * __builtin_fmaf(x * x, -2.3022081981f * 0.044715f, -2.3022081981f))); }

namespace pg8 {
constexpr int BM = 256, BK = 64, HALF = 128, HTB = HALF * BK * 2, STAGE_BYTES = 8 * HTB, NXCD = 8, WGM = 8;
__host__ __device__ __forceinline__ int lds_byte(int r, int c) { const int st = (r >> 4) * 2 + (c >> 5), rr = r & 15, cc = c & 31, ob = rr * 64 + cc * 2; return st * 1024 + (ob ^ (((ob >> 9) & 1) << 5)); }
__host__ __device__ __forceinline__ void stage_rc(int b, int& R, int& C) { const int st = b / 1024, sb = b % 1024, swz = sb ^ (((sb >> 9) & 1) << 5); R = (st >> 1) * 16 + swz / 64; C = (st & 1) * 32 + (swz % 64) / 2; }
__host__ __device__ __forceinline__ int perm32(int rho) { const int n = rho >> 4, i = rho & 15; return 8 * (i >> 2) + 4 * n + (i & 3); }

struct Unit { const char* A; const char* B; int nt; int kind; int pm, pn; };

struct TileOrder {
    int nM, nN, nwg, G, c, wgm;
    __device__ void init(int M_, int N_, int G_, int c_, int wgm_ = WGM) { nM = M_ / BM; nN = N_ / BM; nwg = nM * nN; G = G_; c = c_; wgm = wgm_; }
    __device__ bool tile(int i, int& pm, int& pn) const {
        const long L = (long)i * G + c; if (L >= nwg) return false;
        int wgid = (int)L; { const int q = nwg / NXCD, r = nwg % NXCD, xcd = wgid % NXCD, off = wgid / NXCD; wgid = (xcd < r ? xcd * (q + 1) : r * (q + 1) + (xcd - r) * q) + off; }
        const int nig = wgm * nN, gid = wgid / nig, fm = gid * wgm, gsz = (nM - fm) < wgm ? (nM - fm) : wgm;
        pm = fm + ((wgid % nig) % gsz); pn = (wgid % nig) / gsz; return true;
    }
};

typedef int i32x4 __attribute__((ext_vector_type(4)));
typedef int i32x8 __attribute__((ext_vector_type(8)));
__device__ __forceinline__ i32x8 cat16(bf16x8 lo, bf16x8 hi) { const i32x4 a = __builtin_bit_cast(i32x4, lo), b = __builtin_bit_cast(i32x4, hi); return __builtin_shufflevector(a, b, 0, 1, 2, 3, 4, 5, 6, 7); }
template <class Epi, class Sched, bool ALIGN_EPI, bool FP8 = false>
__device__ __forceinline__ void gemm_phase(LAS unsigned char* lds, const unsigned lda2, const unsigned ldb2, const Sched& S, const Epi& E) {
    int tid = threadIdx.x; asm volatile("" : "+v"(tid));
    const int wid = __builtin_amdgcn_readfirstlane(tid >> 6), lane = tid & 63, wr = wid >> 2, wc = wid & 3, fr = lane & 15, fq = lane >> 4;
    unsigned voffA[2], voffB[2];
#pragma unroll
    for (int i = 0; i < 2; ++i) { int R, C; stage_rc(tid * 16 + i * 8192, R, C); const int Rb = (R & ~31) + perm32(R & 31);
        voffA[i] = (unsigned)R * lda2 + (unsigned)C * 2u; voffB[i] = (unsigned)Rb * ldb2 + (unsigned)C * 2u; }
    const size_t kstep = (size_t)(BK * 2);
    const size_t hA = (size_t)HALF * lda2, hB = (size_t)HALF * ldb2;
    const unsigned ldsw = (unsigned)wid * 1024u;
    const int aoff = lds_byte(wr * 64 + fr, fq * 8), boff = lds_byte(wc * 32 + fr, fq * 8);
#define PG8_SA(b, h) (((b) * 2 + (h)) * HTB)
#define PG8_SB(b, h) ((4 + (b) * 2 + (h)) * HTB)
#define PG8_STAGE(bufoff, gbase, voff) do { _Pragma("unroll") for (int _i = 0; _i < 2; ++_i) \
        __builtin_amdgcn_global_load_lds((const unsigned*)((const char*)(gbase) + (voff)[_i]), (LAS unsigned*)(lds + (bufoff) + ldsw + _i * 8192), 16, 0, 0); } while (0)
#define PG8_LDA(dst, b, h) do { _Pragma("unroll") for (int m = 0; m < 4; ++m) { if constexpr (FP8) dst##8[m] = cat16(*(const LAS bf16x8*)(lds + PG8_SA(b, h) + aoff + m * 2048), *(const LAS bf16x8*)(lds + PG8_SA(b, h) + aoff + m * 2048 + 1024)); \
        else { _Pragma("unroll") for (int k = 0; k < 2; ++k) dst[m][k] = *(const LAS bf16x8*)(lds + PG8_SA(b, h) + aoff + m * 2048 + k * 1024); } } } while (0)
#define PG8_LDB(dst, b, h) do { _Pragma("unroll") for (int n = 0; n < 2; ++n) { if constexpr (FP8) dst##8[n] = cat16(*(const LAS bf16x8*)(lds + PG8_SB(b, h) + boff + n * 2048), *(const LAS bf16x8*)(lds + PG8_SB(b, h) + boff + n * 2048 + 1024)); \
        else { _Pragma("unroll") for (int k = 0; k < 2; ++k) dst[n][k] = *(const LAS bf16x8*)(lds + PG8_SB(b, h) + boff + n * 2048 + k * 1024); } } } while (0)
#define PG8_MMA(ai, bj, At, Bt) do { __builtin_amdgcn_s_setprio(1); \
        if constexpr (FP8) { _Pragma("unroll") for (int m = 0; m < 4; ++m) _Pragma("unroll") for (int n = 0; n < 2; ++n) \
            asm volatile("v_mfma_scale_f32_16x16x128_f8f6f4 %0, %1, %2, %0, %3, %3 op_sel_hi:[0,0,0]" : "+v"(acc[ai][bj][m][n]) : "v"(Bt##8[n]), "v"(At##8[m]), "v"(sc8)); \
            asm volatile("s_nop 15\n\ts_nop 7" ::: "memory"); }   \
        else { _Pragma("unroll") for (int m = 0; m < 4; ++m) _Pragma("unroll") for (int n = 0; n < 2; ++n) _Pragma("unroll") for (int k = 0; k < 2; ++k) \
            acc[ai][bj][m][n] = __builtin_amdgcn_mfma_f32_16x16x32_bf16(Bt[n][k], At[m][k], acc[ai][bj][m][n], 0, 0, 0); } \
        __builtin_amdgcn_s_setprio(0); } while (0)
#define PG8_WAIT_V(n) asm volatile("s_waitcnt vmcnt(" #n ")" ::: "memory")
#define PG8_WAIT_L(n) asm volatile("s_waitcnt lgkmcnt(" #n ")" ::: "memory")
#define PG8_BAR __builtin_amdgcn_s_barrier()
#define PG8_SCHED __builtin_amdgcn_sched_barrier(0)
    Unit cur, nxt; int ui = 0;
    if (!S.next(0, cur)) return;
    f32x4 acc[2][2][4][2];
#pragma unroll
    for (int a = 0; a < 2; ++a)
#pragma unroll
        for (int b = 0; b < 2; ++b)
#pragma unroll
            for (int m = 0; m < 4; ++m)
#pragma unroll
                for (int n = 0; n < 2; ++n) acc[a][b][m][n] = (f32x4){0.f, 0.f, 0.f, 0.f};
    bf16x8 At[4][2], B0[2][2], B1[2][2]; i32x8 At8[4], B08[2], B18[2];
    int sc8 = 0x7f7f7f7f; asm volatile("" : "+v"(sc8));
    const char* cA = cur.A; const char* cB = cur.B;
    PG8_STAGE(PG8_SB(0, 0), cB, voffB); PG8_STAGE(PG8_SB(0, 1), cB + hB, voffB); PG8_STAGE(PG8_SA(0, 0), cA, voffA); PG8_STAGE(PG8_SA(0, 1), cA + hA, voffA);
    if (wr == 1) PG8_BAR;
    PG8_WAIT_V(2); PG8_BAR;
    PG8_STAGE(PG8_SB(1, 0), cB + kstep, voffB); PG8_STAGE(PG8_SA(1, 0), cA + kstep, voffA); PG8_STAGE(PG8_SB(1, 1), cB + hB + kstep, voffB);
    PG8_WAIT_V(6); PG8_BAR;
    for (;;) {
        const bool has_next = S.next(ui + 1, nxt);
        const char* nA = has_next ? nxt.A : cA; const char* nB = has_next ? nxt.B : cB;
        const int nt = cur.nt;
#pragma unroll 1
        for (int t = 0; t < nt; t += 2) {
            const bool last = (t == nt - 2);
            const char* a1 = cA + (size_t)(t + 1) * kstep;
            const char* a2 = last ? nA : cA + (size_t)(t + 2) * kstep; const char* b2 = last ? nB : cB + (size_t)(t + 2) * kstep;
            const char* a3 = a2 + kstep; const char* b3 = b2 + kstep;
            PG8_LDB(B0, 0, 0); PG8_LDB(B1, 0, 1); PG8_SCHED; PG8_LDA(At, 0, 0); PG8_STAGE(PG8_SA(1, 1), a1 + hA, voffA);
            PG8_WAIT_V(8); PG8_WAIT_L(0); PG8_BAR; PG8_MMA(0, 0, At, B0); PG8_MMA(0, 1, At, B1); PG8_BAR; PG8_SCHED;
            PG8_LDA(At, 0, 1); PG8_STAGE(PG8_SB(0, 0), b2, voffB); PG8_STAGE(PG8_SB(0, 1), b2 + hB, voffB); PG8_STAGE(PG8_SA(0, 0), a2, voffA);
            PG8_WAIT_V(8); PG8_WAIT_L(0); PG8_BAR; PG8_MMA(1, 0, At, B0); PG8_MMA(1, 1, At, B1); PG8_BAR; PG8_SCHED;
            PG8_LDB(B0, 1, 0); PG8_LDB(B1, 1, 1); PG8_SCHED; PG8_LDA(At, 1, 0); PG8_STAGE(PG8_SA(0, 1), a2 + hA, voffA);
            PG8_WAIT_V(8); PG8_WAIT_L(0); PG8_BAR; PG8_MMA(0, 0, At, B0); PG8_MMA(0, 1, At, B1); PG8_BAR; PG8_SCHED;
            PG8_LDA(At, 1, 1); PG8_STAGE(PG8_SB(1, 0), b3, voffB); PG8_STAGE(PG8_SB(1, 1), b3 + hB, voffB); PG8_STAGE(PG8_SA(1, 0), a3, voffA);
            PG8_WAIT_V(8); PG8_WAIT_L(0); PG8_BAR; PG8_MMA(1, 0, At, B0); PG8_MMA(1, 1, At, B1); PG8_BAR; PG8_SCHED;
        }
        if constexpr (ALIGN_EPI) { if (wr == 0) PG8_BAR; }
        E(acc, cur, wr, wc, fr, fq);
        if (!has_next) break;
        cur = nxt; cA = nA; cB = nB; ++ui;
        if constexpr (ALIGN_EPI) { if (wr == 1) PG8_BAR; }
    }
    PG8_WAIT_V(0);
    if constexpr (!ALIGN_EPI) { if (wr == 0) PG8_BAR; }
    PG8_BAR;
#undef PG8_SA
#undef PG8_SB
#undef PG8_STAGE
#undef PG8_LDA
#undef PG8_LDB
#undef PG8_MMA
#undef PG8_WAIT_V
#undef PG8_WAIT_L
#undef PG8_BAR
#undef PG8_SCHED
}
}

#define XB_TMO      128
#define XB_XCNT(j)  (256  + 64 * (j))
#define XB_XSUB(j)  (1280 + 64 * (j))
#define XB_XGEN(j)  (2304 + 64 * (j))
#define XB_TOP      3328
#define XB_TOPGEN   3392
#define XCD_BAR_WORDS 3456
#define XB_SPIN_CAP (1u << 18)
__device__ __forceinline__ unsigned xb_ld(unsigned* p)              { return __hip_atomic_load(p, __ATOMIC_RELAXED, __HIP_MEMORY_SCOPE_AGENT); }
__device__ __forceinline__ unsigned xb_add(unsigned* p, unsigned v) { return __hip_atomic_fetch_add(p, v, __ATOMIC_RELAXED, __HIP_MEMORY_SCOPE_AGENT); }
__device__ __forceinline__ unsigned xb_xcc_id() { return (unsigned)__builtin_amdgcn_s_getreg((3 << 11) | 20) & 0xFu; }
#define XB_SPIN(cond, bar) do { unsigned _sp = 0; while (cond) { __builtin_amdgcn_s_sleep(1); \
    if ((++_sp & 255u) == 0u) { if (xb_ld(&(bar)[XB_TMO])) break; if (_sp > XB_SPIN_CAP) { atomicAdd(&(bar)[XB_TMO], 1u); break; } } } } while (0)
struct XcdBarrier { unsigned* bar; unsigned x; volatile LAS unsigned* st; unsigned G; };
__device__ __forceinline__ XcdBarrier xcd_barrier_post(unsigned* bar, volatile LAS unsigned* st, unsigned G) {
    XcdBarrier b; b.bar = bar; b.x = xb_xcc_id(); b.st = st; b.G = G;
    if (threadIdx.x == 0) (void)xb_add(&bar[XB_XCNT(b.x)], 1u);
    return b;
}
__device__ __forceinline__ void xcd_barrier_complete(unsigned* bar, unsigned x, unsigned G, unsigned& nloc, unsigned& nx) {
    unsigned sum, cnt, mine, sp = 0u;
    for (;;) {
        sum = 0u; cnt = 0u; mine = 0u;
#pragma unroll
        for (unsigned j = 0; j < 16; ++j) { const unsigned c = xb_ld(&bar[XB_XCNT(j)]); sum += c; cnt += (c > 0u) ? 1u : 0u; mine = (j == x) ? c : mine; }
        if (sum == G) break;
        __builtin_amdgcn_s_sleep(1);
        if ((++sp & 255u) == 0u) { if (xb_ld(&bar[XB_TMO])) break; if (sp > XB_SPIN_CAP) { atomicAdd(&bar[XB_TMO], 1u); break; } }
    }
    nloc = mine > 0u ? mine : 1u; nx = cnt > 0u ? cnt : 1u;
}
__device__ __forceinline__ void xcd_barrier(const XcdBarrier& b, unsigned* wait_word = nullptr, unsigned wait_target = 0u, unsigned* prog_word = nullptr, bool local_ok = false) {
    asm volatile("s_waitcnt vmcnt(0)" ::: "memory");
    __syncthreads();
    if (threadIdx.x == 0) {
        unsigned* bar = b.bar;
        __builtin_amdgcn_s_waitcnt(0);
        asm volatile("buffer_inv sc1" ::: "memory");
        unsigned nloc = b.st[0], nx = b.st[1];
        if (nloc == 0u) { xcd_barrier_complete(bar, b.x, b.G, nloc, nx); b.st[0] = nloc; b.st[1] = nx; }
        const unsigned old = xb_add(&bar[XB_XSUB(b.x)], 1u);
        const unsigned gen = old / nloc;
        if (old + 1u == (gen + 1u) * nloc) {
            if (!(local_ok && nx == 1u)) { __builtin_amdgcn_fence(__ATOMIC_RELEASE, "agent"); asm volatile("s_waitcnt vmcnt(0)" ::: "memory"); }
            (void)xb_add(&bar[XB_TOP], 1u);
        }
        const unsigned tgt = (gen + 1u) * nx;
        if (wait_word) XB_SPIN(xb_ld(wait_word) < wait_target, bar);
        XB_SPIN(xb_ld(&bar[XB_TOP]) < tgt, bar);
        if (prog_word) (void)xb_add(prog_word, 1u);
        asm volatile("s_waitcnt vmcnt(0)" ::: "memory");
    }
    __syncthreads();
}

struct Args { const float* in[16]; float* out; unsigned char* ws; int ph_lo, ph_hi; };

__device__ __forceinline__ float wave_sum(float v) {
#pragma unroll
    for (int o = 1; o < 64; o <<= 1) v += __shfl_xor(v, o);
    return v;
}

__device__ __forceinline__ void p0_transpose_item(const float* W, int ldw, int k0, int n0, const float* gs, bf16_t* dst, int ldd, LAS float* scr, int lane) {
    float v[32];
    const float* wp = W + (size_t)(k0 + (lane >> 5)) * ldw + n0 + (lane & 31);
#pragma unroll
    for (int i = 0; i < 32; ++i) v[i] = wp[(size_t)(2 * i) * ldw];
    if (gs) {
#pragma unroll
        for (int i = 0; i < 32; ++i) v[i] *= gs[k0 + 2 * i + (lane >> 5)]; }
#pragma unroll
    for (int i = 0; i < 32; ++i) scr[(2 * i + (lane >> 5)) * 33 + (lane & 31)] = v[i];
    LDS_WAIT(); asm volatile("" ::: "memory");
    const int c = lane & 7;
#pragma unroll
    for (int j = 0; j < 4; ++j) { const int n = (lane >> 3) + 8 * j; const LAS float* s = scr + (8 * c) * 33 + n;
        u32x4 o; o.x = cvt_pk_bf16(s[0 * 33], s[1 * 33]); o.y = cvt_pk_bf16(s[2 * 33], s[3 * 33]); o.z = cvt_pk_bf16(s[4 * 33], s[5 * 33]); o.w = cvt_pk_bf16(s[6 * 33], s[7 * 33]);
        *(u32x4*)(dst + (size_t)n * ldd + 8 * c) = o; }
    LDS_WAIT(); asm volatile("" ::: "memory");
}

__device__ __forceinline__ void p0_transpose_item_fp8(const float* W, int ldw, int k0, int n0, const float* gs, float sc, unsigned char* dst, int ldd, LAS float* scr, int lane) {
    float v[32];
    const float* wp = W + (size_t)(k0 + (lane >> 5)) * ldw + n0 + (lane & 31);
#pragma unroll
    for (int i = 0; i < 32; ++i) v[i] = wp[(size_t)(2 * i) * ldw];
#pragma unroll
    for (int i = 0; i < 32; ++i) v[i] *= gs[k0 + 2 * i + (lane >> 5)] * sc;
#pragma unroll
    for (int i = 0; i < 32; ++i) scr[(2 * i + (lane >> 5)) * 33 + (lane & 31)] = v[i];
    LDS_WAIT(); asm volatile("" ::: "memory");
    const int n = lane >> 1, h = lane & 1; const LAS float* s = scr + (32 * h) * 33 + n;
    u32x4 o0, o1;
#pragma unroll
    for (int q = 0; q < 4; ++q) { o0[q] = pk4_fp8(s[(4 * q) * 33], s[(4 * q + 1) * 33], s[(4 * q + 2) * 33], s[(4 * q + 3) * 33]);
                                  o1[q] = pk4_fp8(s[(16 + 4 * q) * 33], s[(17 + 4 * q) * 33], s[(18 + 4 * q) * 33], s[(19 + 4 * q) * 33]); }
    unsigned char* d = dst + (size_t)n * ldd + 32 * h;
    *(u32x4*)d = o0; *(u32x4*)(d + 16) = o1;
    LDS_WAIT(); asm volatile("" ::: "memory");
}

__device__ __forceinline__ void p0_prologue(const Args& a, LAS unsigned char* lds, int gw, int NGW, int wave, int lane) {
    unsigned char* ws = a.ws;
    LAS float* scr = (LAS float*)(lds + wave * WAVE_LDS);
    constexpr int I_IN = (D / 64) * (IN_TOTAL / 32);
    constexpr int I_P = (512 / 64) * (D / 32);
    constexpr int I_O = (D / 64) * (D / 32);
    constexpr int I_LAYER = I_IN + 3 * I_P + I_O;
    { bf16_t* P = (bf16_t*)(ws + WS_P); float* rss = (float*)(ws + WS_RSS);
      for (int m4 = gw * 4; m4 < M; m4 += NGW * 4) {
          f32x4 v[4][4];
#pragma unroll
          for (int r = 0; r < 4; ++r) { const f32x4* xr = (const f32x4*)(a.in[0] + (size_t)(m4 + r) * D) + 2 * lane;
#pragma unroll
              for (int j = 0; j < 2; ++j) { v[r][2 * j] = xr[128 * j]; v[r][2 * j + 1] = xr[128 * j + 1]; } }
#pragma unroll
          for (int r = 0; r < 4; ++r) { float s = 0.f;
#pragma unroll
              for (int j = 0; j < 4; ++j) s += (v[r][j].x * v[r][j].x + v[r][j].y * v[r][j].y) + (v[r][j].z * v[r][j].z + v[r][j].w * v[r][j].w);
              s = wave_sum(s);
              u32x4* o = (u32x4*)(P + (size_t)(m4 + r) * PITCH + XB_COL) + lane;
              u32x2* o8 = (u32x2*)(ws + WS_XB8 + (size_t)(m4 + r) * D) + lane;
#pragma unroll
              for (int j = 0; j < 2; ++j) { const f32x4 p = v[r][2 * j], q = v[r][2 * j + 1];
                  u32x4 w; w.x = cvt_pk_bf16(p.x, p.y); w.y = cvt_pk_bf16(p.z, p.w); w.z = cvt_pk_bf16(q.x, q.y); w.w = cvt_pk_bf16(q.z, q.w); o[64 * j] = w;
                  o8[64 * j] = (u32x2){pk4_fp8(p.x, p.y, p.z, p.w), pk4_fp8(q.x, q.y, q.z, q.w)}; }
              if (lane < 16) rss[(size_t)(m4 + r) * 16 + lane] = (lane == 0) ? s : 0.f; }
      } }
    for (int it = gw; it < DEPTH * I_LAYER; it += NGW) {
        const int l = it / I_LAYER; int r = it % I_LAYER;
        bf16_t* Wmix = (bf16_t*)(ws + WS_WMIX) + (size_t)l * NMIX * D;
        bf16_t* W3 = (bf16_t*)(ws + WS_W3) + (size_t)l * D * K3;
        bf16_t* WoT = (bf16_t*)(ws + WS_WO) + (size_t)l * D * D;
        if (r < I_IN) {
            const int kb = r / (IN_TOTAL / 32), nb = r % (IN_TOTAL / 32), k0 = 64 * kb, n0 = 32 * nb, seg = n0 / 512;
            const float* W = a.in[2] + (size_t)l * D * IN_TOTAL; const float* gs = a.in[1] + l * D;
            if (seg < 9) { const int dseg = (seg == 0) ? 0 : (seg == 1) ? 3 : (seg == 2) ? 4 : (seg == 3) ? 5 : (seg == 4) ? 6 : (seg == 5) ? 7 : (seg == 6) ? 1 : (seg == 7) ? 8 : 2;
                p0_transpose_item(W, IN_TOTAL, k0, n0, gs, Wmix + (size_t)(dseg * 512 + (n0 & 511)) * D + k0, D, scr, lane); }
            else { const int nn = n0 - NMIX;
                p0_transpose_item_fp8(W, IN_TOTAL, k0, n0, gs, WG8_SCALE, ws + WS_WG8 + (size_t)l * 3 * D * D + (size_t)nn * D + k0, D, scr, lane); }
            continue; }
        r -= I_IN;
        if (r < 3 * I_P) { const int br = r / I_P, q = r % I_P, kb = q / (D / 32), nb = q % (D / 32), k0 = 64 * kb, n0 = 32 * nb;
            const float* W = a.in[11 + br] + (size_t)l * 512 * D;
            p0_transpose_item(W, D, k0, n0, nullptr, W3 + (size_t)n0 * K3 + br * 512 + k0, K3, scr, lane); continue; }
        r -= 3 * I_P;
        { const int kb = r / (D / 32), nb = r % (D / 32), k0 = 64 * kb, n0 = 32 * nb;
          const float* W = a.in[14] + (size_t)l * D * D;
          p0_transpose_item(W, D, k0, n0, nullptr, WoT + (size_t)n0 * D + k0, D, scr, lane); }
    }
    { bf16_t* Wm = (bf16_t*)(ws + WS_WM); const float* w_s = a.in[5];
      for (int i = gw * 64 + lane; i < DEPTH * 8 * 128 * 128 / 2; i += NGW * 64) { const int e = 2 * i, s = e & 127, t = (e >> 7) & 127;
          const f32x2 v = *(const f32x2*)(w_s + e); ((unsigned*)Wm)[i] = cvt_pk_bf16(s <= t ? v.x : 0.f, s + 1 <= t ? v.y : 0.f); } }
    { bf16_t* Wp = (bf16_t*)(ws + WS_WPOOL); const float* w_pool = a.in[9]; const float* ps = a.in[10];
      for (int i = gw * 64 + lane; i < DEPTH * 4 * 128 * 128 / 2; i += NGW * 64) { const int e = 2 * i, c = e & 127, d = (e >> 7) & 127, lg = e >> 14;
          const float sc = ps[lg * 128 + d];
          ((unsigned*)Wp)[i] = cvt_pk_bf16(w_pool[(size_t)lg * 16384 + c * 128 + d] * sc, w_pool[(size_t)lg * 16384 + (c + 1) * 128 + d] * sc); } }
}

__device__ __forceinline__ float row_rstd(const float* rss, int row, int fq) {
    const f32x4 p = *(const f32x4*)(rss + (size_t)row * 16 + fq * 4);
    float s = (p.x + p.y) + (p.z + p.w); s += __shfl_xor(s, 16); s += __shfl_xor(s, 32);
    return __builtin_amdgcn_rsqf(s * (1.0f / D) + RMS_EPS);
}
__device__ __forceinline__ float rstd_of(f32x4 p) { float s = (p.x + p.y) + (p.z + p.w); s += __shfl_xor(s, 16); s += __shfl_xor(s, 32); return __builtin_amdgcn_rsqf(s * (1.0f / D) + RMS_EPS); }
#define ZERO_ACC(acc) do { _Pragma("unroll") for (int _a = 0; _a < 2; ++_a) _Pragma("unroll") for (int _b = 0; _b < 2; ++_b) _Pragma("unroll") for (int _m = 0; _m < 4; ++_m) _Pragma("unroll") for (int _n = 0; _n < 2; ++_n) acc[_a][_b][_m][_n] = (f32x4){0.f, 0.f, 0.f, 0.f}; } while (0)

struct SchedP1 {
    pg8::TileOrder T; const char* P; const char* W;
    __device__ __forceinline__ bool next(int i, pg8::Unit& u) const { int pm, pn; if (!T.tile(i, pm, pn)) return false;
        u.pm = pm; u.pn = pn; u.kind = pn >> 1; u.nt = D / 64; u.A = P + ((size_t)pm * 256 * PITCH + XB_COL) * 2; u.B = W + (size_t)pn * 256 * D * 2; return true; }
};
struct EpiP1 {
    bf16_t* P; const float* rss; float* lns;
    __device__ __forceinline__ void operator()(f32x4 (&acc)[2][2][4][2], const pg8::Unit& u, int wr, int wc, int fr, int fq) const {
        const int seg = u.kind;
        const int act = (seg == 3) ? 1 : 0;
        unsigned lrow = (unsigned)(wr * 64 + fr); asm volatile("" : "+v"(lrow));
        const unsigned lp = (lrow * PITCH + (unsigned)(wc * 32) + 8u * (unsigned)fq) * 2u;
        const unsigned lr = lrow * 64u;
        const size_t up = (size_t)u.pm * 256 * PITCH + (size_t)u.pn * 256;
        const size_t ur = (size_t)u.pm * 256 * 16;
        f32x4 pr[2][4];
#pragma unroll
        for (int ai = 0; ai < 2; ++ai)
#pragma unroll
            for (int m = 0; m < 4; ++m) pr[ai][m] = *(const f32x4*)((const char*)(rss + ur + (ai * 128 + m * 16) * 16) + (lr + 16u * fq));
#pragma unroll
        for (int ai = 0; ai < 2; ++ai)
#pragma unroll
            for (int m = 0; m < 4; ++m) {
                const float rs = rstd_of(pr[ai][m]);
                float s1 = 0.f, s2 = 0.f;
#pragma unroll
                for (int bj = 0; bj < 2; ++bj) {
                    f32x4 v0 = acc[ai][bj][m][0] * rs, v1 = acc[ai][bj][m][1] * rs;
                    if (act == 1) {
#pragma unroll
                        for (int j = 0; j < 2; ++j) { const f32x2 g0 = gelu2((f32x2){v0[2 * j], v0[2 * j + 1]}), g1 = gelu2((f32x2){v1[2 * j], v1[2 * j + 1]});
                            v0[2 * j] = g0.x; v0[2 * j + 1] = g0.y; v1[2 * j] = g1.x; v1[2 * j + 1] = g1.y; } }
                    u32x4 w; w.x = cvt_pk_bf16(v0[0], v0[1]); w.y = cvt_pk_bf16(v0[2], v0[3]); w.z = cvt_pk_bf16(v1[0], v1[1]); w.w = cvt_pk_bf16(v1[2], v1[3]);
                    *(u32x4*)((char*)(P + up + (size_t)(ai * 128 + m * 16) * PITCH + bj * 128) + lp) = w;
                    if (seg == 3) {
#pragma unroll
                        for (int q = 0; q < 4; ++q) { const float lo = bf_lo(w[q]), hi = bf_hi(w[q]); s1 += lo + hi; s2 += lo * lo + hi * hi; } }
                }
                if (seg == 3) { s1 += __shfl_xor(s1, 16); s1 += __shfl_xor(s1, 32); s2 += __shfl_xor(s2, 16); s2 += __shfl_xor(s2, 32);
                    if (fq == 0) *(f32x2*)((char*)(lns + ur + (ai * 128 + m * 16) * 16 + ((u.pn - 6) * 4 + wc) * 2) + lr) = (f32x2){s1, s2}; }
            }
        ZERO_ACC(acc);
    }
};

struct SchedG {
    int x, r, n, c0, sq; const char* A8; const char* W8;
    __device__ __forceinline__ bool next(int i, pg8::Unit& u) const { if (i >= n) return false;
        int combo, pl;
        if (i < sq) { pl = 4 * i + (r & 3); combo = c0 + (r >> 2); } else { pl = r & 7; combo = c0 + (sq ? 4 : 0) + 2 * (i - sq) + (r >> 3); }
        const int gate = combo >> 2;
        u.pm = 8 * x + pl; u.pn = combo & 3; u.kind = gate; u.nt = D / 128;
        u.A = A8 + (size_t)u.pm * 256 * D; u.B = W8 + ((size_t)gate * D + (size_t)u.pn * 256) * D; return true; }
};
struct EpiP3G {
    unsigned char* S8; size_t gstride; unsigned rowb; const float* rss;
    __device__ __forceinline__ void operator()(f32x4 (&acc)[2][2][4][2], const pg8::Unit& u, int wr, int wc, int fr, int fq) const {
        unsigned lrow = (unsigned)(wr * 64 + fr); asm volatile("" : "+v"(lrow));
        const unsigned ls = lrow * rowb + (unsigned)(wc * 32) + 8u * (unsigned)fq;
        const unsigned lr = lrow * 64u;
        unsigned char* sb = S8 + (size_t)(u.pm >> 3) * GATE_GROUP_BYTES + (size_t)u.kind * gstride + (size_t)(u.pm & 7) * 256 * rowb + (size_t)u.pn * 256;
        const size_t ur = (size_t)u.pm * 256 * 16;
        f32x4 pr[2][4];
#pragma unroll
        for (int ai = 0; ai < 2; ++ai)
#pragma unroll
            for (int m = 0; m < 4; ++m) pr[ai][m] = *(const f32x4*)((const char*)(rss + ur + (ai * 128 + m * 16) * 16) + (lr + 16u * fq));
#pragma unroll
        for (int ai = 0; ai < 2; ++ai)
#pragma unroll
            for (int m = 0; m < 4; ++m) {
                const float rs = rstd_of(pr[ai][m]) * (-1.4426950409f / WG8_SCALE);
#pragma unroll
                for (int bj = 0; bj < 2; ++bj) { const f32x4 v0 = acc[ai][bj][m][0] * rs, v1 = acc[ai][bj][m][1] * rs;
                    unsigned w0 = 0u, w1 = 0u;
#pragma unroll
                    for (int j = 0; j < 4; ++j) { w0 = __builtin_amdgcn_cvt_pk_u8_f32(__builtin_amdgcn_rcpf(__builtin_fmaf(__builtin_amdgcn_exp2f(v0[j]), 1.0f / 255.0f, 1.0f / 255.0f)), j, w0);
                                                  w1 = __builtin_amdgcn_cvt_pk_u8_f32(__builtin_amdgcn_rcpf(__builtin_fmaf(__builtin_amdgcn_exp2f(v1[j]), 1.0f / 255.0f, 1.0f / 255.0f)), j, w1); }
                    w0 |= (((w0 - 0x01010101u) & ~w0) >> 7) & 0x01010101u; w1 |= (((w1 - 0x01010101u) & ~w1) >> 7) & 0x01010101u;
                    *(u32x2*)(sb + (size_t)(ai * 128 + m * 16) * rowb + bj * 128 + ls) = (u32x2){w0, w1}; }
            }
        ZERO_ACC(acc);
    }
};
struct SchedP3Y {
    int pm, pn; const char* P; const char* W;
    __device__ __forceinline__ bool next(int i, pg8::Unit& u) const { if (i >= 3) return false;
        u.pm = pm; u.pn = pn; u.kind = i; u.nt = 512 / 64;
        u.A = P + ((size_t)pm * 256 * PITCH + (size_t)i * 512) * 2; u.B = W + ((size_t)pn * 256 * K3 + (size_t)i * 512) * 2; return true; }
};
struct EpiP3Y {
    bf16_t* P; const unsigned char* S8; size_t gstride; unsigned rowb;
    __device__ __forceinline__ void operator()(f32x4 (&acc)[2][2][4][2], const pg8::Unit& u, int wr, int wc, int fr, int fq) const {
        const int j = u.kind; const bool fin = (j == 2);
        unsigned lrow = (unsigned)(wr * 64 + fr); asm volatile("" : "+v"(lrow));
        const unsigned ls = lrow * rowb + (unsigned)(wc * 32) + 8u * (unsigned)fq;
        const unsigned lp = (lrow * PITCH + (unsigned)(wc * 32) + 8u * (unsigned)fq) * 2u;
        const unsigned char* sb = S8 + (size_t)(u.pm >> 3) * GATE_GROUP_BYTES + (size_t)(u.pm & 7) * 256 * rowb + (size_t)u.pn * 256;
        const unsigned char* pn_ = sb + (size_t)j * gstride; const unsigned char* pd_ = sb + (size_t)(fin ? 2 : j + 1) * gstride;
        bf16_t* pmg = P + (size_t)u.pm * 256 * PITCH + C_MERGED + (size_t)u.pn * 256;
#pragma unroll
        for (int ai = 0; ai < 2; ++ai)
#pragma unroll
        for (int mh = 0; mh < 2; ++mh) {
            u32x2 sn[2][2], sd[2][2];
#pragma unroll
            for (int mm = 0; mm < 2; ++mm)
#pragma unroll
                for (int bj = 0; bj < 2; ++bj) { const size_t ro = (size_t)(ai * 128 + (mh * 2 + mm) * 16) * rowb + bj * 128;
                    sn[mm][bj] = *(const u32x2*)(pn_ + ro + ls); sd[mm][bj] = *(const u32x2*)(pd_ + ro + ls); }
#pragma unroll
            for (int mm = 0; mm < 2; ++mm)
#pragma unroll
                for (int bj = 0; bj < 2; ++bj) { const int m = mh * 2 + mm;
#pragma unroll
                    for (int n = 0; n < 2; ++n) { const unsigned sdw = fin ? 0xffffffffu : sd[mm][bj][n];
#pragma unroll
                        for (int e = 0; e < 4; ++e) { const float qn = (float)((sn[mm][bj][n] >> (8 * e)) & 0xffu), qd = (float)((sdw >> (8 * e)) & 0xffu);
                            acc[ai][bj][m][n][e] *= qn * __builtin_amdgcn_rcpf(qd); } }
                    if (fin) { const f32x4 v0 = acc[ai][bj][m][0], v1 = acc[ai][bj][m][1];
                        u32x4 w; w.x = cvt_pk_bf16(v0[0], v0[1]); w.y = cvt_pk_bf16(v0[2], v0[3]); w.z = cvt_pk_bf16(v1[0], v1[1]); w.w = cvt_pk_bf16(v1[2], v1[3]);
                        *(u32x4*)((char*)(pmg + (size_t)(ai * 128 + m * 16) * PITCH + bj * 128) + lp) = w; } }
        }
    }
};

struct SchedP4 {
    pg8::TileOrder T; const char* P; const char* W;
    __device__ __forceinline__ bool next(int i, pg8::Unit& u) const { int pm, pn; if (!T.tile(i, pm, pn)) return false;
        u.pm = pm; u.pn = pn; u.kind = 0; u.nt = D / 64; u.A = P + ((size_t)pm * 256 * PITCH + C_MERGED) * 2; u.B = W + (size_t)pn * 256 * D * 2; return true; }
};
struct EpiP4 {
    bf16_t* P; float* rss_out; unsigned char* xb8;
    __device__ __forceinline__ void operator()(f32x4 (&acc)[2][2][4][2], const pg8::Unit& u, int wr, int wc, int fr, int fq) const {
        unsigned lrow = (unsigned)(wr * 64 + fr); asm volatile("" : "+v"(lrow));
        const unsigned lc = (unsigned)(wc * 32) + 8u * (unsigned)fq;
        const unsigned lp = (lrow * PITCH + lc) * 2u, lx = (lrow * D + lc) * 4u, l8 = lrow * D + lc;
        const size_t ux = (size_t)u.pm * 256 * D + (size_t)u.pn * 256;
        bf16_t* pb = P + (size_t)u.pm * 256 * PITCH + (size_t)u.pn * 256 + XB_COL;
        float* rb = rss_out + (size_t)u.pm * 256 * 16 + u.pn * 4 + wc;
#pragma unroll
        for (int ai = 0; ai < 2; ++ai)
#pragma unroll
        for (int mh = 0; mh < 2; ++mh) {
            u32x4 hv[2][2];
#pragma unroll
            for (int mm = 0; mm < 2; ++mm)
#pragma unroll
                for (int bj = 0; bj < 2; ++bj) hv[mm][bj] = *(const u32x4*)((const char*)(pb + (size_t)(ai * 128 + (mh * 2 + mm) * 16) * PITCH + bj * 128) + lp);
#pragma unroll
            for (int mm = 0; mm < 2; ++mm) {
                const int m = mh * 2 + mm; float ss = 0.f;
#pragma unroll
                for (int bj = 0; bj < 2; ++bj) { const size_t ro = (size_t)(ai * 128 + m * 16) * D + bj * 128;
                    const f32x4 v0 = (f32x4){bf_lo(hv[mm][bj].x), bf_hi(hv[mm][bj].x), bf_lo(hv[mm][bj].y), bf_hi(hv[mm][bj].y)} + acc[ai][bj][m][0], v1 = (f32x4){bf_lo(hv[mm][bj].z), bf_hi(hv[mm][bj].z), bf_lo(hv[mm][bj].w), bf_hi(hv[mm][bj].w)} + acc[ai][bj][m][1];
                    ss += (v0[0] * v0[0] + v0[1] * v0[1]) + (v0[2] * v0[2] + v0[3] * v0[3]) + (v1[0] * v1[0] + v1[1] * v1[1]) + (v1[2] * v1[2] + v1[3] * v1[3]);
                    u32x4 w; w.x = cvt_pk_bf16(v0[0], v0[1]); w.y = cvt_pk_bf16(v0[2], v0[3]); w.z = cvt_pk_bf16(v1[0], v1[1]); w.w = cvt_pk_bf16(v1[2], v1[3]);
                    *(u32x4*)((char*)(pb + (size_t)(ai * 128 + m * 16) * PITCH + bj * 128) + lp) = w;
                    *(u32x2*)((xb8 + ux + ro) + l8) = (u32x2){pk4_fp8(v0[0], v0[1], v0[2], v0[3]), pk4_fp8(v1[0], v1[1], v1[2], v1[3])};
 }
                ss += __shfl_xor(ss, 16); ss += __shfl_xor(ss, 32);
                if (fq == 0) *(float*)((char*)(rb + (ai * 128 + m * 16) * 16) + lrow * 64u) = ss;
            }
        }
        ZERO_ACC(acc);
    }
};

struct EpiP4F {

    const bf16_t* P; float* out; float* rss_out; const float* fg; unsigned* cnt; unsigned* tmo;
    __device__ __forceinline__ void operator()(f32x4 (&acc)[2][2][4][2], const pg8::Unit& u, int wr, int wc, int fr, int fq) const {
        unsigned lrow = (unsigned)(wr * 64 + fr); asm volatile("" : "+v"(lrow));
        const unsigned lc = (unsigned)(wc * 32) + 8u * (unsigned)fq;
        const unsigned lx = (lrow * D + lc) * 4u;
        const unsigned lp = (lrow * PITCH + lc) * 2u, l8 = lrow * D + lc;
        const bf16_t* pxb = P + (size_t)u.pm * 256 * PITCH + (size_t)u.pn * 256 + XB_COL;
        const size_t ux = (size_t)u.pm * 256 * D + (size_t)u.pn * 256;
        float* rb = rss_out + (size_t)u.pm * 256 * 16 + u.pn * 4 + wc;
#pragma unroll
        for (int ai = 0; ai < 2; ++ai)
#pragma unroll
        for (int mh = 0; mh < 2; ++mh) {
            f32x4 xo[2][2][2]; u32x4 hv[2][2];
#pragma unroll
            for (int mm = 0; mm < 2; ++mm)
#pragma unroll
                for (int bj = 0; bj < 2; ++bj) hv[mm][bj] = *(const u32x4*)((const char*)(pxb + (size_t)(ai * 128 + (mh * 2 + mm) * 16) * PITCH + bj * 128) + lp);
#pragma unroll
            for (int mm = 0; mm < 2; ++mm)
#pragma unroll
                for (int bj = 0; bj < 2; ++bj)
#pragma unroll
                    for (int n = 0; n < 2; ++n) xo[mm][bj][n] = (f32x4){bf_lo(hv[mm][bj][2 * n]), bf_hi(hv[mm][bj][2 * n]), bf_lo(hv[mm][bj][2 * n + 1]), bf_hi(hv[mm][bj][2 * n + 1])};
#pragma unroll
            for (int mm = 0; mm < 2; ++mm) {
                const int m = mh * 2 + mm; float ss = 0.f;
#pragma unroll
                for (int bj = 0; bj < 2; ++bj) { const f32x4 v0 = xo[mm][bj][0] + acc[ai][bj][m][0], v1 = xo[mm][bj][1] + acc[ai][bj][m][1];
                    acc[ai][bj][m][0] = v0; acc[ai][bj][m][1] = v1;
                    ss += (v0[0] * v0[0] + v0[1] * v0[1]) + (v0[2] * v0[2] + v0[3] * v0[3]) + (v1[0] * v1[0] + v1[1] * v1[1]) + (v1[2] * v1[2] + v1[3] * v1[3]); }
                ss += __shfl_xor(ss, 16); ss += __shfl_xor(ss, 32);
                if (fq == 0) __hip_atomic_store((float*)((char*)(rb + (ai * 128 + m * 16) * 16) + lrow * 64u), ss, __ATOMIC_RELAXED, __HIP_MEMORY_SCOPE_AGENT);
            }
        }
        asm volatile("s_waitcnt vmcnt(0)" ::: "memory");
        const int lane = (int)(threadIdx.x & 63); const int wid = wr * 4 + wc;
        unsigned* pc = cnt + 64 * u.pm;
        if (lane == 0) __hip_atomic_fetch_add(pc, 1u, __ATOMIC_RELAXED, __HIP_MEMORY_SCOPE_AGENT);
        if (wid == 0) {
            asm volatile("buffer_inv sc1" ::: "memory");
            unsigned sp = 0;
            while ((unsigned)__builtin_amdgcn_readfirstlane(__hip_atomic_load(pc, __ATOMIC_RELAXED, __HIP_MEMORY_SCOPE_AGENT)) < 32u) {
                __builtin_amdgcn_s_sleep(1);
                if ((++sp & 255u) == 0u) { if (__hip_atomic_load(tmo, __ATOMIC_RELAXED, __HIP_MEMORY_SCOPE_AGENT)) break; if (sp > (1u << 20)) { if (lane == 0) atomicAdd(tmo, 1u); break; } } }
            asm volatile("s_waitcnt vmcnt(0)" ::: "memory");
        }
        asm volatile("" ::: "memory"); __builtin_amdgcn_s_barrier(); asm volatile("" ::: "memory");
        const unsigned lr = lrow * 64u;
        const size_t ur = (size_t)u.pm * 256 * 16;
        f32x4 pr[2][4];
#pragma unroll
        for (int ai = 0; ai < 2; ++ai)
#pragma unroll
            for (int m = 0; m < 4; ++m) pr[ai][m] = *(const f32x4*)((const char*)(rss_out + ur + (ai * 128 + m * 16) * 16) + (lr + 16u * fq));
        f32x4 gv[2][2];
#pragma unroll
        for (int bj = 0; bj < 2; ++bj) { const float* gp = (const float*)((const char*)(fg + u.pn * 256 + bj * 128) + lc * 4u); gv[bj][0] = *(const f32x4*)gp; gv[bj][1] = *(const f32x4*)(gp + 4); }
#pragma unroll
        for (int ai = 0; ai < 2; ++ai)
#pragma unroll
            for (int m = 0; m < 4; ++m) { const float rs = rstd_of(pr[ai][m]);
#pragma unroll
                for (int bj = 0; bj < 2; ++bj) { float* xq = (float*)((char*)(out + ux + (size_t)(ai * 128 + m * 16) * D + bj * 128) + lx);
                    *(f32x4*)xq = acc[ai][bj][m][0] * rs * gv[bj][0]; *(f32x4*)(xq + 4) = acc[ai][bj][m][1] * rs * gv[bj][1]; } }
        ZERO_ACC(acc);
    }
};

#define LDG(T, uptr, lboff) (*(const T*)((const char*)(uptr) + (lboff)))
#define STG(T, uptr, lboff, val) (*(T*)((char*)(uptr) + (lboff)) = (val))
typedef short s16x4 __attribute__((ext_vector_type(4)));
__device__ __forceinline__ s16x4 lds_tr16(const LAS void* p) { return __builtin_amdgcn_ds_read_tr16_b64_v4i16((LAS s16x4*)p); }
template <int TH> __device__ __forceinline__ void mixer_a_body(bf16_t* P, const float* lns, const bf16_t* Wm, const float* ln_g, const float* ln_b, const float* b_s, LAS unsigned char* wl, int n, int g, int lane) {
    constexpr int SLEN = 64 * (TH + 1), NV = SLEN / 8, NKS = 2 * (TH + 1);
    const int T0 = n * 128;
    constexpr int VB = 136;
    constexpr int OB = 272;
    const int ck = lane & 7, rsub = lane >> 3;
    const int fr = lane & 15, fq = lane >> 4;
    const unsigned lv = (unsigned)(rsub * PITCH + ck * 8) * 2u;
    const unsigned lw = (unsigned)(fr * 128 + fq * 8) * 2u;
    const bf16_t* pv = P + (size_t)T0 * PITCH + C_V + g * 64;
    u32x4 raw[NV];
#pragma unroll
    for (int q = 0; q < NV; ++q) raw[q] = LDG(u32x4, pv + (size_t)(q * 8) * PITCH, lv);
    f32x4 st[TH + 1][4];
#pragma unroll
    for (int h = 0; h <= TH; ++h)
#pragma unroll
        for (int j = 0; j < 4; ++j) st[h][j] = LDG(f32x4, lns + (size_t)(T0 + 64 * h) * 16 + 4 * j, (unsigned)lane * 64u);
    float lg[8], lb[8];
    { const f32x4 g0 = LDG(f32x4, ln_g + g * 64, (unsigned)ck * 32u), g1 = LDG(f32x4, ln_g + g * 64 + 4, (unsigned)ck * 32u), b0 = LDG(f32x4, ln_b + g * 64, (unsigned)ck * 32u), b1 = LDG(f32x4, ln_b + g * 64 + 4, (unsigned)ck * 32u);
#pragma unroll
      for (int j = 0; j < 4; ++j) { lg[j] = g0[j]; lg[4 + j] = g1[j]; lb[j] = b0[j]; lb[4 + j] = b1[j]; } }
    float mean[TH + 1], rstd[TH + 1];
#pragma unroll
    for (int h = 0; h <= TH; ++h) { const f32x4 a = st[h][0], b = st[h][1], c = st[h][2], d = st[h][3];
        const float s1 = (a.x + a.z) + (b.x + b.z) + (c.x + c.z) + (d.x + d.z), s2 = (a.y + a.w) + (b.y + b.w) + (c.y + c.w) + (d.y + d.w);
        mean[h] = s1 * (1.f / 512.f); rstd[h] = __builtin_amdgcn_rsqf(fmaxf(s2 * (1.f / 512.f) - mean[h] * mean[h], 0.f) + LN_EPS); }
#pragma unroll
    for (int q = 0; q < NV; ++q) { const int s = q * 8 + rsub;
        const float mu = __shfl(mean[(q * 8) >> 6], s & 63), rs = __shfl(rstd[(q * 8) >> 6], s & 63);
        unsigned pk[4];
#pragma unroll
        for (int j = 0; j < 4; ++j) pk[j] = cvt_pk_bf16((bf_lo(raw[q][j]) - mu) * rs * lg[2 * j] + lb[2 * j], (bf_hi(raw[q][j]) - mu) * rs * lg[2 * j + 1] + lb[2 * j + 1]);
        LAS unsigned char* wp = wl + s * VB + ck * 16;
        *(LAS u32x2*)wp = (u32x2){pk[0], pk[1]}; *(LAS u32x2*)(wp + 8) = (u32x2){pk[2], pk[3]}; }
    LDS_WAIT(); asm volatile("" ::: "memory");
    f32x4 acc[4][4];
#pragma unroll
    for (int ct = 0; ct < 4; ++ct)
#pragma unroll
        for (int tt = 0; tt < 4; ++tt) acc[ct][tt] = (f32x4){0.f, 0.f, 0.f, 0.f};
    const bf16_t* wmg = Wm + (size_t)g * 128 * 128 + (size_t)(64 * TH) * 128;
    const LAS unsigned char* trp = wl + (8 * fq + (fr >> 2)) * VB + (fr & 3) * 8;
#pragma unroll 1
    for (int ks = 0; ks < NKS; ++ks) {
        bf16x8 af[4], bfr[4];
#pragma unroll
        for (int tt = 0; tt < 4; ++tt) bfr[tt] = LDG(bf16x8, wmg + (16 * tt) * 128 + ks * 32, lw);
#pragma unroll
        for (int ct = 0; ct < 4; ++ct) { const s16x4 a0 = lds_tr16(trp + (ks * 32) * VB + ct * 32), a1 = lds_tr16(trp + (ks * 32 + 4) * VB + ct * 32);
            af[ct] = (bf16x8){a0[0], a0[1], a0[2], a0[3], a1[0], a1[1], a1[2], a1[3]}; }
#pragma unroll
        for (int ct = 0; ct < 4; ++ct)
#pragma unroll
            for (int tt = 0; tt < 4; ++tt) acc[ct][tt] = __builtin_amdgcn_mfma_f32_16x16x32_bf16(af[ct], bfr[tt], acc[ct][tt], 0, 0, 0);
    }
    LDS_WAIT(); asm volatile("" ::: "memory");
#pragma unroll
    for (int tt = 0; tt < 4; ++tt)
#pragma unroll
        for (int ct = 0; ct < 4; ++ct) *(LAS f32x4*)(wl + (16 * tt + fr) * OB + (16 * ct + 4 * fq) * 4) = acc[ct][tt];
    LDS_WAIT(); asm volatile("" ::: "memory");
    bf16_t* po = P + (size_t)(T0 + 64 * TH) * PITCH + g * 64;
    const float* bsp = b_s + g * 128 + 64 * TH;
#pragma unroll
    for (int hf = 0; hf < 2; ++hf) {
        u32x4 uu[4], zz[4]; float bs[4];
#pragma unroll
        for (int q = 0; q < 4; ++q) { uu[q] = LDG(u32x4, po + (size_t)((hf * 4 + q) * 8) * PITCH + C_U, lv); zz[q] = LDG(u32x4, po + (size_t)((hf * 4 + q) * 8) * PITCH + C_ZA, lv);
            bs[q] = LDG(float, bsp + (hf * 4 + q) * 8, (unsigned)rsub * 4u); }
#pragma unroll
        for (int q = 0; q < 4; ++q) { const int t = (hf * 4 + q) * 8 + rsub;
            const f32x4 s0 = *(const LAS f32x4*)(wl + t * OB + ck * 32), s1 = *(const LAS f32x4*)(wl + t * OB + ck * 32 + 16);
            u32x4 w;
#pragma unroll
            for (int j = 0; j < 4; ++j) { const f32x2 s2 = (j < 2 ? (f32x2){s0[2 * j], s0[2 * j + 1]} : (f32x2){s1[2 * j - 4], s1[2 * j - 3]}) + bs[q];
                const f32x2 o = gelu2(bf2(uu[q][j])) * s2 * silu2(bf2(zz[q][j]));
                w[j] = cvt_pk_bf16(o.x, o.y); }
            STG(u32x4, po + (size_t)((hf * 4 + q) * 8) * PITCH + C_U, lv, w); }
    }
    LDS_WAIT(); asm volatile("" ::: "memory");
}
__device__ __forceinline__ void mixer_a_item(bf16_t* P, const float* lns, const bf16_t* Wm, const float* ln_g, const float* ln_b, const float* b_s, LAS unsigned char* wl, int item, int lane) {
    const int th = item & 1, g = (item >> 1) & 7, n = item >> 4;
    if (th) mixer_a_body<1>(P, lns, Wm, ln_g, ln_b, b_s, wl, n, g, lane); else mixer_a_body<0>(P, lns, Wm, ln_g, ln_b, b_s, wl, n, g, lane);
}

__device__ __forceinline__ void mixer_b_item(bf16_t* P, const float* conv_w, const float* conv_b, int item, int lane) {
    const int hb = item & 1, t0 = (item >> 1) * 16;
    const bool seq_start = (t0 % SEQ) == 0;
    bf16_t* pbase = P + (size_t)t0 * PITCH + hb * 256;
    const unsigned l8 = (unsigned)lane * 8u, l16 = (unsigned)lane * 16u;
    const f32x4 w0 = LDG(f32x4, conv_w + hb * 256, l16), w1 = LDG(f32x4, conv_w + 512 + hb * 256, l16), w2 = LDG(f32x4, conv_w + 1024 + hb * 256, l16), cb = LDG(f32x4, conv_b + hb * 256, l16);
    f32x4 pm2 = (f32x4){0.f, 0.f, 0.f, 0.f}, pm1 = pm2;
#pragma unroll
    for (int hf = 0; hf < 2; ++hf) {
        u32x2 xx[10], cc[10], bb[8], zz[8];
#pragma unroll
        for (int r = (hf ? 2 : 0); r < 10; ++r) { const int dt = hf * 8 + r - 2; const bool ok = (dt >= 0) || !seq_start;
            xx[r] = ok ? LDG(u32x2, pbase + (ptrdiff_t)dt * PITCH + C_XB, l8) : (u32x2){0u, 0u}; cc[r] = ok ? LDG(u32x2, pbase + (ptrdiff_t)dt * PITCH + C_CG, l8) : (u32x2){0u, 0u}; }
#pragma unroll
        for (int r = 0; r < 8; ++r) { bb[r] = LDG(u32x2, pbase + (size_t)(hf * 8 + r) * PITCH + C_BG, l8); zz[r] = LDG(u32x2, pbase + (size_t)(hf * 8 + r) * PITCH + C_ZB, l8); }
        if (hf == 0) {
            pm2 = (f32x4){bf_lo(xx[0].x) * bf_lo(cc[0].x), bf_hi(xx[0].x) * bf_hi(cc[0].x), bf_lo(xx[0].y) * bf_lo(cc[0].y), bf_hi(xx[0].y) * bf_hi(cc[0].y)};
            pm1 = (f32x4){bf_lo(xx[1].x) * bf_lo(cc[1].x), bf_hi(xx[1].x) * bf_hi(cc[1].x), bf_lo(xx[1].y) * bf_lo(cc[1].y), bf_hi(xx[1].y) * bf_hi(cc[1].y)}; }
#pragma unroll
        for (int r = 0; r < 8; ++r) {
            const f32x4 p0 = (f32x4){bf_lo(xx[r + 2].x) * bf_lo(cc[r + 2].x), bf_hi(xx[r + 2].x) * bf_hi(cc[r + 2].x), bf_lo(xx[r + 2].y) * bf_lo(cc[r + 2].y), bf_hi(xx[r + 2].y) * bf_hi(cc[r + 2].y)};
            const f32x4 y = cb + w0 * pm2 + w1 * pm1 + w2 * p0;
            const f32x4 bg = (f32x4){bf_lo(bb[r].x), bf_hi(bb[r].x), bf_lo(bb[r].y), bf_hi(bb[r].y)};
            const f32x2 zb0 = silu2(bf2(zz[r].x)), zb1 = silu2(bf2(zz[r].y)); const f32x4 zb = (f32x4){zb0.x, zb0.y, zb1.x, zb1.y};
            const f32x4 o = bg * y * zb;
            u32x2 w; w.x = cvt_pk_bf16(o[0], o[1]); w.y = cvt_pk_bf16(o[2], o[3]); STG(u32x2, pbase + (size_t)(hf * 8 + r) * PITCH + C_ZB, l8, w);
            pm2 = pm1; pm1 = p0; }
    }
}

template <int W> __device__ __forceinline__ void mixer_c_pool(const bf16_t* pxc  , LAS bf16_t* pl, int PL_LD, int tseq, int lane) {
    constexpr int NR = 31 + W;
    unsigned xv[NR];
#pragma unroll
    for (int r = 0; r < NR; ++r) { const int dt = r - (W - 1); xv[r] = (dt >= 0 || tseq > 0) ? LDG(unsigned, pxc + (ptrdiff_t)dt * PITCH, (unsigned)lane * 4u) : 0u; }
    float s0 = 0.f, s1 = 0.f;
#pragma unroll
    for (int r = 0; r < NR; ++r) {
        const int dt = r - (W - 1);
        s0 += bf_lo(xv[r]); s1 += bf_hi(xv[r]);
        if (r >= W) { s0 -= bf_lo(xv[r - W]); s1 -= bf_hi(xv[r - W]); }
        if (dt >= 0) { const int pos = tseq + dt; const float inv = 1.0f / (float)((pos + 1 < W) ? (pos + 1) : W);
            *(LAS unsigned*)(pl + dt * PL_LD + 2 * lane) = cvt_pk_bf16(s0 * inv - bf_lo(xv[r]), s1 * inv - bf_hi(xv[r])); }
    }
}
__device__ __forceinline__ void mixer_c_item(bf16_t* P, const bf16_t* WpT, LAS unsigned char* wl, int item, int lane) {
    const int gi = item & 3, t0 = (item >> 2) * 32;
    constexpr int PL_LD = 136;
    constexpr int OB = 528;
    LAS bf16_t* pl = (LAS bf16_t*)wl;
    const bf16_t* pxc = P + (size_t)t0 * PITCH + C_XC + gi * 128; const int tseq = t0 % SEQ;
    if (gi == 0) mixer_c_pool<2>(pxc, pl, PL_LD, tseq, lane);
    else if (gi == 1) mixer_c_pool<4>(pxc, pl, PL_LD, tseq, lane);
    else if (gi == 2) mixer_c_pool<8>(pxc, pl, PL_LD, tseq, lane);
    else mixer_c_pool<16>(pxc, pl, PL_LD, tseq, lane);
    LDS_WAIT(); asm volatile("" ::: "memory");
    const int fr = lane & 15, fq = lane >> 4;
    const unsigned lw = (unsigned)(fr * 128 + fq * 8) * 2u;
    bf16x8 bfr[2][4];
#pragma unroll
    for (int tt = 0; tt < 2; ++tt)
#pragma unroll
        for (int ks = 0; ks < 4; ++ks) bfr[tt][ks] = *(const LAS bf16x8*)(pl + (tt * 16 + fr) * PL_LD + ks * 32 + fq * 8);
    LDS_WAIT(); asm volatile("" ::: "memory");
    const bf16_t* wg = WpT + (size_t)gi * 128 * 128;
#pragma unroll 2
    for (int dp = 0; dp < 4; ++dp) {
        bf16x8 af[2][4];
#pragma unroll
        for (int d2 = 0; d2 < 2; ++d2)
#pragma unroll
            for (int ks = 0; ks < 4; ++ks) af[d2][ks] = LDG(bf16x8, wg + (size_t)((dp * 2 + d2) * 16) * 128 + ks * 32, lw);
#pragma unroll
        for (int d2 = 0; d2 < 2; ++d2) {
            f32x4 a0 = (f32x4){0.f, 0.f, 0.f, 0.f}, a1 = a0;
#pragma unroll
            for (int ks = 0; ks < 4; ++ks) { a0 = __builtin_amdgcn_mfma_f32_16x16x32_bf16(af[d2][ks], bfr[0][ks], a0, 0, 0, 0); a1 = __builtin_amdgcn_mfma_f32_16x16x32_bf16(af[d2][ks], bfr[1][ks], a1, 0, 0, 0); }
            *(LAS f32x4*)(wl + fr * OB + ((dp * 2 + d2) * 16 + 4 * fq) * 4) = a0; *(LAS f32x4*)(wl + (16 + fr) * OB + ((dp * 2 + d2) * 16 + 4 * fq) * 4) = a1; }
    }
    LDS_WAIT(); asm volatile("" ::: "memory");
    bf16_t* pz = P + (size_t)t0 * PITCH + C_ZC + gi * 128;
    const int r4 = lane >> 4, c16 = lane & 15;
    const unsigned lz = (unsigned)(r4 * PITCH + c16 * 8) * 2u;
    u32x4 zv[8];
#pragma unroll
    for (int q = 0; q < 8; ++q) zv[q] = LDG(u32x4, pz + (size_t)(q * 4) * PITCH, lz);
#pragma unroll
    for (int q = 0; q < 8; ++q) { const int t = q * 4 + r4;
        const f32x4 s0 = *(const LAS f32x4*)(wl + t * OB + c16 * 32), s1 = *(const LAS f32x4*)(wl + t * OB + c16 * 32 + 16);
        u32x4 w;
#pragma unroll
        for (int j = 0; j < 4; ++j) { const float sa = (j < 2 ? s0[2 * j] : s1[2 * j - 4]), sb = (j < 2 ? s0[2 * j + 1] : s1[2 * j - 3]);
            { const f32x2 o = (f32x2){sa, sb} * silu2(bf2(zv[q][j])); w[j] = cvt_pk_bf16(o.x, o.y); } }
        STG(u32x4, pz + (size_t)(q * 4) * PITCH, lz, w); }
    LDS_WAIT(); asm volatile("" ::: "memory");
}

__global__ void __launch_bounds__(NWAVES * 64, 2) hybrid_fwd(Args args) {
    extern __shared__ __attribute__((aligned(16))) unsigned char lds_raw[];
    LAS unsigned char* lds = (LAS unsigned char*)lds_raw;
    volatile LAS unsigned* MISC = (volatile LAS unsigned*)(lds + MISC_OFF);
    const int tid = threadIdx.x, lane = tid & 63, wave = __builtin_amdgcn_readfirstlane(tid >> 6);
    const int G = gridDim.x; const int bx = blockIdx.x;
    const int vcu = (G % 8 == 0) ? (bx % 8) * (G / 8) + bx / 8 : bx;
    const int gw = vcu * NWAVES + wave, NGW = G * NWAVES;
    unsigned char* ws = args.ws;
    for (int u = tid; u < (LDS_BYTES - LDSCTL_OFF) / 4; u += NWAVES * 64) ((LAS unsigned*)(lds + LDSCTL_OFF))[u] = 0u;
    __syncthreads();
    const XcdBarrier bar = xcd_barrier_post((unsigned*)(ws + WS_CTL), MISC + 8, (unsigned)G);
    (void)xcd_barrier_post((unsigned*)(ws + WS_CTL) + (1 + (bx & 7)) * XCD_BAR_WORDS, MISC + 10, (unsigned)(G / 8));
    const int lo = args.ph_lo, hi = args.ph_hi;
#define IN(k) (lo <= (k) && (k) < hi)
#define SEAM(k) do { if (IN(k) && IN((k) + 1)) xcd_barrier(bar); } while (0)
#define CW_PROG 47104
#define GSEAM_W(k, nbr, tgt) GSEAM_X(k, nbr, tgt, false)
#define GSEAM_X(k, nbr, tgt, loc) do { if (IN(k) && IN((k) + 1)) { XcdBarrier gb; gb.bar = (unsigned*)(args.ws + WS_CTL) + (1 + ((int)blockIdx.x & 7)) * XCD_BAR_WORDS; gb.x = bar.x; gb.st = MISC + 10; gb.G = gridDim.x / 8; \
        unsigned* pw_ = (unsigned*)(args.ws + WS_CTL) + CW_PROG; const int nb_ = (nbr); \
        xcd_barrier(gb, nb_ >= 0 ? pw_ + 64 * nb_ : nullptr, (unsigned)(tgt), ((int)blockIdx.x >> 3) == 0 ? pw_ + 64 * ((int)blockIdx.x & 7) : nullptr, (loc)); } } while (0)
#define GSEAM(k) GSEAM_X(k, -1, 0, true)

    bf16_t* P = (bf16_t*)(ws + WS_P);
    float* rss = (float*)(ws + WS_RSS);
    float* lns = (float*)(ws + WS_LNS);

    if (IN(0)) { p0_prologue(args, lds, gw, NGW, wave, lane); }
    SEAM(0);

    for (int l = 0; l < DEPTH; ++l) {
        const int pb = 1 + 4 * l;
        const bf16_t* Wmix = (const bf16_t*)(ws + WS_WMIX) + (size_t)l * NMIX * D;
        const bf16_t* W3 = (const bf16_t*)(ws + WS_W3) + (size_t)l * D * K3;
        const bf16_t* WoT = (const bf16_t*)(ws + WS_WO) + (size_t)l * D * D;
        const float* rss_l = rss + (size_t)l * M * 16;
        if (IN(pb)) {
            const int jg = bx >> 3; const bool five = (G == 256) && (bx < 128);
            for (int pass = 0; pass < 2; ++pass) {
                if ((pass == 0) != five) {
                    SchedG S; S.x = bx & 7; S.r = jg & 15; S.n = five ? 1 : 2; S.c0 = five ? 4 : 0; S.sq = five ? 0 : 2;     S.A8 = (const char*)(ws + WS_XB8); S.W8 = (const char*)(ws + WS_WG8 + (size_t)l * 3 * D * D);
                    EpiP3G E{(unsigned char*)args.out, GATE_PLANE_BYTES, (unsigned)D, rss_l};
                    pg8::gemm_phase<EpiP3G, SchedG, true, true>(lds, D, D, S, E);
                } else {
                    SchedP1 S; S.T.init(M, NMIX, G, bx, P1_WGM); S.P = (const char*)P; S.W = (const char*)Wmix;
                    EpiP1 E{P, rss_l, lns};
                    pg8::gemm_phase<EpiP1, SchedP1, true>(lds, PITCH * 2, D * 2, S, E);
                }
            }
        }
        GSEAM_W(pb, (bx & 3) != 0 ? (bx & 7) - 1 : -1, 1 + 4 * l);
        if (IN(pb + 1)) {
            const bf16_t* Wm = (const bf16_t*)(ws + WS_WM) + (size_t)l * 8 * 128 * 128;
            const bf16_t* WpT = (const bf16_t*)(ws + WS_WPOOL) + (size_t)l * 4 * 128 * 128;
            LAS unsigned char* wl = lds + wave * WAVE_LDS;
            int ln = lane; asm volatile("" : "+v"(ln));
            { const int x = bx & 7, e = bx >> 3;
              SchedG S; S.x = x; S.r = e & 15; S.A8 = (const char*)(ws + WS_XB8); S.W8 = (const char*)(ws + WS_WG8 + (size_t)l * 3 * D * D);
              EpiP3G E{(unsigned char*)args.out, GATE_PLANE_BYTES, (unsigned)D, rss_l};
              if (G != 256) { for (int li = e * NWAVES + wave; li < 768; li += (G / 8) * NWAVES) { const int j = 256 * x + (li & 255);
                  if (li < 256) mixer_a_item(P, lns, Wm, args.in[3] + l * 512, args.in[4] + l * 512, args.in[6] + l * 1024, wl, j, ln);
                  else if (li < 512) mixer_b_item(P, args.in[7] + l * 1536, args.in[8] + l * 512, j, ln);
                  else mixer_c_item(P, WpT, wl, j, ln); } }
              else if (e < 16) {
                for (int li = e * 8 + wave; li < 512; li += 128) { const int j = 256 * x + (li & 255);
                  if (li < 256) mixer_a_item(P, lns, Wm, args.in[3] + l * 512, args.in[4] + l * 512, args.in[6] + l * 1024, wl, j, ln);
                  else mixer_b_item(P, args.in[7] + l * 1536, args.in[8] + l * 512, j, ln); }
                __syncthreads();
                S.n = 1; S.c0 = 10; S.sq = 0;
                pg8::gemm_phase<EpiP3G, SchedG, true, true>(lds, D, D, S, E); }
              else {
                S.n = 2; S.c0 = 6; S.sq = 2;
                pg8::gemm_phase<EpiP3G, SchedG, true, true>(lds, D, D, S, E);
                for (int li = 512 + (e - 16) * 8 + wave; li < 768; li += 128) mixer_c_item(P, WpT, wl, 256 * x + (li & 255), ln); } }
        }
        GSEAM(pb + 1);
        if (IN(pb + 2)) {
            pg8::TileOrder T; T.init(M, D, G, bx); int pm3, pn3;
            if (T.tile(0, pm3, pn3)) {
                SchedP3Y S; S.pm = pm3; S.pn = pn3; S.P = (const char*)P; S.W = (const char*)W3; EpiP3Y E{P, (const unsigned char*)args.out, GATE_PLANE_BYTES, (unsigned)D};
                pg8::gemm_phase<EpiP3Y, SchedP3Y, true>(lds, PITCH * 2, K3 * 2, S, E);
            }
        }
        GSEAM(pb + 2);
        if (IN(pb + 3)) {
            SchedP4 S; S.T.init(M, D, G, bx); S.P = (const char*)P; S.W = (const char*)WoT;
            if (l == 0) { EpiP4 E{P, rss + (size_t)(l + 1) * M * 16, ws + WS_XB8};
                pg8::gemm_phase<EpiP4, SchedP4, true>(lds, PITCH * 2, D * 2, S, E); }
            else { EpiP4F E{P, args.out, rss + (size_t)2 * M * 16, args.in[15], (unsigned*)(ws + WS_CTL) + CW_PANEL, (unsigned*)(ws + WS_CTL) + XB_TMO};
                pg8::gemm_phase<EpiP4F, SchedP4, true>(lds, PITCH * 2, D * 2, S, E); }
        }
        if (l + 1 < DEPTH) GSEAM_X(pb + 3, (bx & 3) != 3 ? (bx & 7) + 1 : -1, 2 + 4 * l, true);
    }
#undef IN
#undef SEAM
#undef GSEAM
}

extern "C" void kernel_launch(void* const* d_in, const int* in_sizes, int n_in, void* d_out, int out_size, void* d_ws, size_t ws_size, hipStream_t stream) {
    static int grid = 0;
    if (grid == 0) {
        if (n_in != 16 || in_sizes[0] != M * D || out_size != M * D || ws_size < WS_END) { fprintf(stderr, "kernel_launch: unexpected shapes (n_in %d, in0 %d, out %d, ws %zu); nothing launched\n", n_in, n_in > 0 ? in_sizes[0] : -1, out_size, ws_size); grid = -1; return; }
        int dev = 0, cus = 0, per_cu = 0;
        if (hipGetDevice(&dev) != hipSuccess || hipDeviceGetAttribute(&cus, hipDeviceAttributeMultiprocessorCount, dev) != hipSuccess) { grid = -1; return; }
        if (hipFuncSetAttribute((const void*)hybrid_fwd, hipFuncAttributeMaxDynamicSharedMemorySize, LDS_BYTES) != hipSuccess) { fprintf(stderr, "kernel_launch: hipFuncSetAttribute failed\n"); grid = -1; return; }
        if (hipOccupancyMaxActiveBlocksPerMultiprocessor(&per_cu, (const void*)hybrid_fwd, NWAVES * 64, LDS_BYTES) != hipSuccess || per_cu < 1) { fprintf(stderr, "kernel_launch: occupancy query reports %d blocks per CU\n", per_cu); (void)hipGetLastError(); grid = -1; return; }
        if (cus != 256) { fprintf(stderr, "kernel_launch: built for a 256-CU device (the unit assignment is written for 256 workgroups); this one has %d CUs; nothing launched\n", cus); grid = -1; return; }
        grid = cus;
    }
    if (grid < 0) return;
    if (hipMemsetAsync((char*)d_ws + WS_CTL, 0, CTL_ZERO_BYTES, stream) != hipSuccess) return;
    Args a{};
    for (int i = 0; i < 16; ++i) a.in[i] = (const float*)d_in[i];
    a.out = (float*)d_out; a.ws = (unsigned char*)d_ws;
    a.ph_lo = 0; a.ph_hi = 9;
    hipLaunchKernelGGL(hybrid_fwd, dim3(grid), dim3(NWAVES * 64), LDS_BYTES, stream, a);
}
```

```cpp
#include <hip/hip_runtime.h>
#include <cstdio>
#include <cstdint>


#define P1_WGM 2
#define GAS __attribute__((address_space(1)))
#define LAS __attribute__((address_space(3)))
typedef unsigned short bf16_t;
typedef short bf16x8 __attribute__((ext_vector_type(8)));
typedef float f32x4 __attribute__((ext_vector_type(4)));
typedef float f32x2 __attribute__((ext_vector_type(2)));
typedef unsigned u32x4 __attribute__((ext_vector_type(4)));
typedef unsigned u32x2 __attribute__((ext_vector_type(2)));

constexpr int SEQ = 8192, D = 1024, M = 2 * SEQ, DEPTH = 2;
constexpr int IN_TOTAL = 7680;
constexpr int NMIX = 4608;
constexpr int PITCH = NMIX + D;
constexpr int XB_COL = NMIX;
constexpr int C_U = 0, C_ZB = 512, C_ZC = 1024, C_V = 1536, C_ZA = 2048, C_XB = 2560, C_BG = 3072, C_CG = 3584, C_XC = 4096;
constexpr int C_S = 1536, C_MERGED = 1536;
constexpr int K3 = 1536;
constexpr float RMS_EPS = 1e-6f, LN_EPS = 1e-5f;

constexpr size_t MiB = 1u << 20;
constexpr size_t WS_CTL = 0, CTL_ZERO_BYTES = 192 * 1024;
constexpr int CW_PANEL = 40960;
constexpr size_t WS_RSS = 1 * MiB;
constexpr size_t WS_LNS = 4 * MiB;
constexpr size_t WS_WMIX = 5 * MiB;
constexpr size_t WS_W3 = 23 * MiB;
constexpr size_t WS_WO = 29 * MiB;
constexpr size_t WS_WM = 33 * MiB;
constexpr size_t WS_WPOOL = WS_WM + 512 * 1024;
constexpr size_t WS_P = 34 * MiB;
constexpr size_t WS_XB8 = WS_P + (size_t)M * PITCH * 2;
constexpr size_t WS_WG8 = WS_XB8 + (size_t)M * D;
constexpr float WG8_SCALE = 64.0f;
constexpr size_t GATE_GROUP_BYTES = 8 * MiB, GATE_PLANE_BYTES = 2 * MiB;
constexpr size_t WS_END = WS_WG8 + (size_t)DEPTH * 3 * D * D;
static_assert(WS_END <= 256 * MiB, "workspace map");

constexpr int NWAVES = 8;
constexpr int RING_BYTES = 131072;
constexpr int WAVE_LDS = 17920;
constexpr int LDSCTL_OFF = 143360, MISC_OFF = LDSCTL_OFF + 320;
constexpr int LDS_BYTES = 147456;

#define RLX_AGENT __ATOMIC_RELAXED, __HIP_MEMORY_SCOPE_AGENT
#define LDS_WAIT() asm volatile("s_waitcnt lgkmcnt(0)" ::: "memory")
#define VM_WAIT() asm volatile("s_waitcnt vmcnt(0)" ::: "memory")

__device__ __forceinline__ unsigned cvt_pk_bf16(float lo, float hi) { unsigned r; asm volatile("v_cvt_pk_bf16_f32 %0, %1, %2" : "=v"(r) : "v"(lo), "v"(hi)); return r; }
__device__ __forceinline__ unsigned pk4_fp8(float a, float b, float c, float d) { int w = 0; w = __builtin_amdgcn_cvt_pk_fp8_f32(a, b, w, false); w = __builtin_amdgcn_cvt_pk_fp8_f32(c, d, w, true); return (unsigned)w; }
__device__ __forceinline__ float bf_lo(unsigned w) { return __builtin_bit_cast(float, w << 16); }
__device__ __forceinline__ float bf_hi(unsigned w) { return __builtin_bit_cast(float, w & 0xffff0000u); }
__device__ __forceinline__ float sigmoid_f(float x) { return __builtin_amdgcn_rcpf(1.0f + __builtin_amdgcn_exp2f(-1.4426950409f * x)); }
__device__ __forceinline__ float silu_f(float x) { return x * sigmoid_f(x); }
__device__ __forceinline__ f32x2 bf2(unsigned w) { return (f32x2){bf_lo(w), bf_hi(w)}; }
__device__ __forceinline__ f32x2 rcp2(f32x2 d) { return (f32x2){__builtin_amdgcn_rcpf(d.x), __builtin_amdgcn_rcpf(d.y)}; }
__device__ __forceinline__ f32x2 exp2_2(f32x2 t) { return (f32x2){__builtin_amdgcn_exp2f(t.x), __builtin_amdgcn_exp2f(t.y)}; }
__device__ __forceinline__ f32x2 silu2(f32x2 x) { return x * rcp2(exp2_2(x * -1.4426950409f) + 1.0f); }
__device__ __forceinline__ f32x2 gelu2(f32x2 x) { const f32x2 t = x * x * (-2.3022081981f * 0.044715f) + (-2.3022081981f); return x * rcp2(exp2_2(x * t) + 1.0f); }
__device__ __forceinline__ float gelu_tanh_f(float x) { return x * __builtin_amdgcn_rcpf(1.0f + __builtin_amdgcn_exp2f(x * __builtin_fmaf(x * x, -2.3022081981f * 0.044715f, -2.3022081981f))); }

namespace pg8 {
constexpr int BM = 256, BK = 64, HALF = 128, HTB = HALF * BK * 2, STAGE_BYTES = 8 * HTB, NXCD = 8, WGM = 8;
__host__ __device__ __forceinline__ int lds_byte(int r, int c) { const int st = (r >> 4) * 2 + (c >> 5), rr = r & 15, cc = c & 31, ob = rr * 64 + cc * 2; return st * 1024 + (ob ^ (((ob >> 9) & 1) << 5)); }
__host__ __device__ __forceinline__ void stage_rc(int b, int& R, int& C) { const int st = b / 1024, sb = b % 1024, swz = sb ^ (((sb >> 9) & 1) << 5); R = (st >> 1) * 16 + swz / 64; C = (st & 1) * 32 + (swz % 64) / 2; }
__host__ __device__ __forceinline__ int perm32(int rho) { const int n = rho >> 4, i = rho & 15; return 8 * (i >> 2) + 4 * n + (i & 3); }

struct Unit { const char* A; const char* B; int nt; int kind; int pm, pn; };

struct TileOrder {
    int nM, nN, nwg, G, c, wgm;
    __device__ void init(int M_, int N_, int G_, int c_, int wgm_ = WGM) { nM = M_ / BM; nN = N_ / BM; nwg = nM * nN; G = G_; c = c_; wgm = wgm_; }
    __device__ bool tile(int i, int& pm, int& pn) const {
        const long L = (long)i * G + c; if (L >= nwg) return false;
        int wgid = (int)L; { const int q = nwg / NXCD, r = nwg % NXCD, xcd = wgid % NXCD, off = wgid / NXCD; wgid = (xcd < r ? xcd * (q + 1) : r * (q + 1) + (xcd - r) * q) + off; }
        const int nig = wgm * nN, gid = wgid / nig, fm = gid * wgm, gsz = (nM - fm) < wgm ? (nM - fm) : wgm;
        pm = fm + ((wgid % nig) % gsz); pn = (wgid % nig) / gsz; return true;
    }
};

typedef int i32x4 __attribute__((ext_vector_type(4)));
typedef int i32x8 __attribute__((ext_vector_type(8)));
__device__ __forceinline__ i32x8 cat16(bf16x8 lo, bf16x8 hi) { const i32x4 a = __builtin_bit_cast(i32x4, lo), b = __builtin_bit_cast(i32x4, hi); return __builtin_shufflevector(a, b, 0, 1, 2, 3, 4, 5, 6, 7); }
template <class Epi, class Sched, bool ALIGN_EPI, bool FP8 = false>
__device__ __forceinline__ void gemm_phase(LAS unsigned char* lds, const unsigned lda2, const unsigned ldb2, const Sched& S, const Epi& E) {
    int tid = threadIdx.x; asm volatile("" : "+v"(tid));
    const int wid = __builtin_amdgcn_readfirstlane(tid >> 6), lane = tid & 63, wr = wid >> 2, wc = wid & 3, fr = lane & 15, fq = lane >> 4;
    unsigned voffA[2], voffB[2];
#pragma unroll
    for (int i = 0; i < 2; ++i) { int R, C; stage_rc(tid * 16 + i * 8192, R, C); const int Rb = (R & ~31) + perm32(R & 31);
        voffA[i] = (unsigned)R * lda2 + (unsigned)C * 2u; voffB[i] = (unsigned)Rb * ldb2 + (unsigned)C * 2u; }
    const size_t kstep = (size_t)(BK * 2);
    const size_t hA = (size_t)HALF * lda2, hB = (size_t)HALF * ldb2;
    const unsigned ldsw = (unsigned)wid * 1024u;
    const int aoff = lds_byte(wr * 64 + fr, fq * 8), boff = lds_byte(wc * 32 + fr, fq * 8);
#define PG8_SA(b, h) (((b) * 2 + (h)) * HTB)
#define PG8_SB(b, h) ((4 + (b) * 2 + (h)) * HTB)
#define PG8_STAGE(bufoff, gbase, voff) do { _Pragma("unroll") for (int _i = 0; _i < 2; ++_i) \
        __builtin_amdgcn_global_load_lds((const unsigned*)((const char*)(gbase) + (voff)[_i]), (LAS unsigned*)(lds + (bufoff) + ldsw + _i * 8192), 16, 0, 0); } while (0)
#define PG8_LDA(dst, b, h) do { _Pragma("unroll") for (int m = 0; m < 4; ++m) { if constexpr (FP8) dst##8[m] = cat16(*(const LAS bf16x8*)(lds + PG8_SA(b, h) + aoff + m * 2048), *(const LAS bf16x8*)(lds + PG8_SA(b, h) + aoff + m * 2048 + 1024)); \
        else { _Pragma("unroll") for (int k = 0; k < 2; ++k) dst[m][k] = *(const LAS bf16x8*)(lds + PG8_SA(b, h) + aoff + m * 2048 + k * 1024); } } } while (0)
#define PG8_LDB(dst, b, h) do { _Pragma("unroll") for (int n = 0; n < 2; ++n) { if constexpr (FP8) dst##8[n] = cat16(*(const LAS bf16x8*)(lds + PG8_SB(b, h) + boff + n * 2048), *(const LAS bf16x8*)(lds + PG8_SB(b, h) + boff + n * 2048 + 1024)); \
        else { _Pragma("unroll") for (int k = 0; k < 2; ++k) dst[n][k] = *(const LAS bf16x8*)(lds + PG8_SB(b, h) + boff + n * 2048 + k * 1024); } } } while (0)
#define PG8_MMA(ai, bj, At, Bt) do { __builtin_amdgcn_s_setprio(1); \
        if constexpr (FP8) { _Pragma("unroll") for (int m = 0; m < 4; ++m) _Pragma("unroll") for (int n = 0; n < 2; ++n) \
            asm volatile("v_mfma_scale_f32_16x16x128_f8f6f4 %0, %1, %2, %0, %3, %3 op_sel_hi:[0,0,0]" : "+v"(acc[ai][bj][m][n]) : "v"(Bt##8[n]), "v"(At##8[m]), "v"(sc8)); \
            asm volatile("s_nop 15\n\ts_nop 7" ::: "memory"); }   \
        else { _Pragma("unroll") for (int m = 0; m < 4; ++m) _Pragma("unroll") for (int n = 0; n < 2; ++n) _Pragma("unroll") for (int k = 0; k < 2; ++k) \
            acc[ai][bj][m][n] = __builtin_amdgcn_mfma_f32_16x16x32_bf16(Bt[n][k], At[m][k], acc[ai][bj][m][n], 0, 0, 0); } \
        __builtin_amdgcn_s_setprio(0); } while (0)
#define PG8_WAIT_V(n) asm volatile("s_waitcnt vmcnt(" #n ")" ::: "memory")
#define PG8_WAIT_L(n) asm volatile("s_waitcnt lgkmcnt(" #n ")" ::: "memory")
#define PG8_BAR __builtin_amdgcn_s_barrier()
#define PG8_SCHED __builtin_amdgcn_sched_barrier(0)
    Unit cur, nxt; int ui = 0;
    if (!S.next(0, cur)) return;
    f32x4 acc[2][2][4][2];
#pragma unroll
    for (int a = 0; a < 2; ++a)
#pragma unroll
        for (int b = 0; b < 2; ++b)
#pragma unroll
            for (int m = 0; m < 4; ++m)
#pragma unroll
                for (int n = 0; n < 2; ++n) acc[a][b][m][n] = (f32x4){0.f, 0.f, 0.f, 0.f};
    bf16x8 At[4][2], B0[2][2], B1[2][2]; i32x8 At8[4], B08[2], B18[2];
    int sc8 = 0x7f7f7f7f; asm volatile("" : "+v"(sc8));
    const char* cA = cur.A; const char* cB = cur.B;
    PG8_STAGE(PG8_SB(0, 0), cB, voffB); PG8_STAGE(PG8_SB(0, 1), cB + hB, voffB); PG8_STAGE(PG8_SA(0, 0), cA, voffA); PG8_STAGE(PG8_SA(0, 1), cA + hA, voffA);
    if (wr == 1) PG8_BAR;
    PG8_WAIT_V(2); PG8_BAR;
    PG8_STAGE(PG8_SB(1, 0), cB + kstep, voffB); PG8_STAGE(PG8_SA(1, 0), cA + kstep, voffA); PG8_STAGE(PG8_SB(1, 1), cB + hB + kstep, voffB);
    PG8_WAIT_V(6); PG8_BAR;
    for (;;) {
        const bool has_next = S.next(ui + 1, nxt);
        const char* nA = has_next ? nxt.A : cA; const char* nB = has_next ? nxt.B : cB;
        const int nt = cur.nt;
#pragma unroll 1
        for (int t = 0; t < nt; t += 2) {
            const bool last = (t == nt - 2);
            const char* a1 = cA + (size_t)(t + 1) * kstep;
            const char* a2 = last ? nA : cA + (size_t)(t + 2) * kstep; const char* b2 = last ? nB : cB + (size_t)(t + 2) * kstep;
            const char* a3 = a2 + kstep; const char* b3 = b2 + kstep;
            PG8_LDB(B0, 0, 0); PG8_LDB(B1, 0, 1); PG8_SCHED; PG8_LDA(At, 0, 0); PG8_STAGE(PG8_SA(1, 1), a1 + hA, voffA);
            PG8_WAIT_V(8); PG8_WAIT_L(0); PG8_BAR; PG8_MMA(0, 0, At, B0); PG8_MMA(0, 1, At, B1); PG8_BAR; PG8_SCHED;
            PG8_LDA(At, 0, 1); PG8_STAGE(PG8_SB(0, 0), b2, voffB); PG8_STAGE(PG8_SB(0, 1), b2 + hB, voffB); PG8_STAGE(PG8_SA(0, 0), a2, voffA);
            PG8_WAIT_V(8); PG8_WAIT_L(0); PG8_BAR; PG8_MMA(1, 0, At, B0); PG8_MMA(1, 1, At, B1); PG8_BAR; PG8_SCHED;
            PG8_LDB(B0, 1, 0); PG8_LDB(B1, 1, 1); PG8_SCHED; PG8_LDA(At, 1, 0); PG8_STAGE(PG8_SA(0, 1), a2 + hA, voffA);
            PG8_WAIT_V(8); PG8_WAIT_L(0); PG8_BAR; PG8_MMA(0, 0, At, B0); PG8_MMA(0, 1, At, B1); PG8_BAR; PG8_SCHED;
            PG8_LDA(At, 1, 1); PG8_STAGE(PG8_SB(1, 0), b3, voffB); PG8_STAGE(PG8_SB(1, 1), b3 + hB, voffB); PG8_STAGE(PG8_SA(1, 0), a3, voffA);
            PG8_WAIT_V(8); PG8_WAIT_L(0); PG8_BAR; PG8_MMA(1, 0, At, B0); PG8_MMA(1, 1, At, B1); PG8_BAR; PG8_SCHED;
        }
        if constexpr (ALIGN_EPI) { if (wr == 0) PG8_BAR; }
        E(acc, cur, wr, wc, fr, fq);
        if (!has_next) break;
        cur = nxt; cA = nA; cB = nB; ++ui;
        if constexpr (ALIGN_EPI) { if (wr == 1) PG8_BAR; }
    }
    PG8_WAIT_V(0);
    if constexpr (!ALIGN_EPI) { if (wr == 0) PG8_BAR; }
    PG8_BAR;
#undef PG8_SA
#undef PG8_SB
#undef PG8_STAGE
#undef PG8_LDA
#undef PG8_LDB
#undef PG8_MMA
#undef PG8_WAIT_V
#undef PG8_WAIT_L
#undef PG8_BAR
#undef PG8_SCHED
}
}

#define XB_TMO      128
#define XB_XCNT(j)  (256  + 64 * (j))
#define XB_XSUB(j)  (1280 + 64 * (j))
#define XB_XGEN(j)  (2304 + 64 * (j))
#define XB_TOP      3328
#define XB_TOPGEN   3392
#define XCD_BAR_WORDS 3456
#define XB_SPIN_CAP (1u << 18)
__device__ __forceinline__ unsigned xb_ld(unsigned* p)              { return __hip_atomic_load(p, __ATOMIC_RELAXED, __HIP_MEMORY_SCOPE_AGENT); }
__device__ __forceinline__ unsigned xb_add(unsigned* p, unsigned v) { return __hip_atomic_fetch_add(p, v, __ATOMIC_RELAXED, __HIP_MEMORY_SCOPE_AGENT); }
__device__ __forceinline__ unsigned xb_xcc_id() { return (unsigned)__builtin_amdgcn_s_getreg((3 << 11) | 20) & 0xFu; }
#define XB_SPIN(cond, bar) do { unsigned _sp = 0; while (cond) { __builtin_amdgcn_s_sleep(1); \
    if ((++_sp & 255u) == 0u) { if (xb_ld(&(bar)[XB_TMO])) break; if (_sp > XB_SPIN_CAP) { atomicAdd(&(bar)[XB_TMO], 1u); break; } } } } while (0)
struct XcdBarrier { unsigned* bar; unsigned x; volatile LAS unsigned* st; unsigned G; };
__device__ __forceinline__ XcdBarrier xcd_barrier_post(unsigned* bar, volatile LAS unsigned* st, unsigned G) {
    XcdBarrier b; b.bar = bar; b.x = xb_xcc_id(); b.st = st; b.G = G;
    if (threadIdx.x == 0) (void)xb_add(&bar[XB_XCNT(b.x)], 1u);
    return b;
}
__device__ __forceinline__ void xcd_barrier_complete(unsigned* bar, unsigned x, unsigned G, unsigned& nloc, unsigned& nx) {
    unsigned sum, cnt, mine, sp = 0u;
    for (;;) {
        sum = 0u; cnt = 0u; mine = 0u;
#pragma unroll
        for (unsigned j = 0; j < 16; ++j) { const unsigned c = xb_ld(&bar[XB_XCNT(j)]); sum += c; cnt += (c > 0u) ? 1u : 0u; mine = (j == x) ? c : mine; }
        if (sum == G) break;
        __builtin_amdgcn_s_sleep(1);
        if ((++sp & 255u) == 0u) { if (xb_ld(&bar[XB_TMO])) break; if (sp > XB_SPIN_CAP) { atomicAdd(&bar[XB_TMO], 1u); break; } }
    }
    nloc = mine > 0u ? mine : 1u; nx = cnt > 0u ? cnt : 1u;
}
__device__ __forceinline__ void xcd_barrier(const XcdBarrier& b, unsigned* wait_word = nullptr, unsigned wait_target = 0u, unsigned* prog_word = nullptr, bool local_ok = false) {
    asm volatile("s_waitcnt vmcnt(0)" ::: "memory");
    __syncthreads();
    if (threadIdx.x == 0) {
        unsigned* bar = b.bar;
        __builtin_amdgcn_s_waitcnt(0);
        asm volatile("buffer_inv sc1" ::: "memory");
        unsigned nloc = b.st[0], nx = b.st[1];
        if (nloc == 0u) { xcd_barrier_complete(bar, b.x, b.G, nloc, nx); b.st[0] = nloc; b.st[1] = nx; }
        const unsigned old = xb_add(&bar[XB_XSUB(b.x)], 1u);
        const unsigned gen = old / nloc;
        if (old + 1u == (gen + 1u) * nloc) {
            if (!(local_ok && nx == 1u)) { __builtin_amdgcn_fence(__ATOMIC_RELEASE, "agent"); asm volatile("s_waitcnt vmcnt(0)" ::: "memory"); }
            (void)xb_add(&bar[XB_TOP], 1u);
        }
        const unsigned tgt = (gen + 1u) * nx;
        if (wait_word) XB_SPIN(xb_ld(wait_word) < wait_target, bar);
        XB_SPIN(xb_ld(&bar[XB_TOP]) < tgt, bar);
        if (prog_word) (void)xb_add(prog_word, 1u);
        asm volatile("s_waitcnt vmcnt(0)" ::: "memory");
    }
    __syncthreads();
}

struct Args { const float* in[16]; float* out; unsigned char* ws; int ph_lo, ph_hi; };

__device__ __forceinline__ float wave_sum(float v) {
#pragma unroll
    for (int o = 1; o < 64; o <<= 1) v += __shfl_xor(v, o);
    return v;
}

__device__ __forceinline__ void p0_transpose_item(const float* W, int ldw, int k0, int n0, const float* gs, bf16_t* dst, int ldd, LAS float* scr, int lane) {
    float v[32];
    const float* wp = W + (size_t)(k0 + (lane >> 5)) * ldw + n0 + (lane & 31);
#pragma unroll
    for (int i = 0; i < 32; ++i) v[i] = __builtin_nontemporal_load(wp + (size_t)(2 * i) * ldw);
    if (gs) {
#pragma unroll
        for (int i = 0; i < 32; ++i) v[i] *= gs[k0 + 2 * i + (lane >> 5)]; }
#pragma unroll
    for (int i = 0; i < 32; ++i) scr[(2 * i + (lane >> 5)) * 33 + (lane & 31)] = v[i];
    LDS_WAIT(); asm volatile("" ::: "memory");
    const int c = lane & 7;
#pragma unroll
    for (int j = 0; j < 4; ++j) { const int n = (lane >> 3) + 8 * j; const LAS float* s = scr + (8 * c) * 33 + n;
        u32x4 o; o.x = cvt_pk_bf16(s[0 * 33], s[1 * 33]); o.y = cvt_pk_bf16(s[2 * 33], s[3 * 33]); o.z = cvt_pk_bf16(s[4 * 33], s[5 * 33]); o.w = cvt_pk_bf16(s[6 * 33], s[7 * 33]);
        *(u32x4*)(dst + (size_t)n * ldd + 8 * c) = o; }
    LDS_WAIT(); asm volatile("" ::: "memory");
}

__device__ __forceinline__ void p0_transpose_item_fp8(const float* W, int ldw, int k0, int n0, const float* gs, float sc, unsigned char* dst, int ldd, LAS float* scr, int lane) {
    float v[32];
    const float* wp = W + (size_t)(k0 + (lane >> 5)) * ldw + n0 + (lane & 31);
#pragma unroll
    for (int i = 0; i < 32; ++i) v[i] = __builtin_nontemporal_load(wp + (size_t)(2 * i) * ldw);
#pragma unroll
    for (int i = 0; i < 32; ++i) v[i] *= gs[k0 + 2 * i + (lane >> 5)] * sc;
#pragma unroll
    for (int i = 0; i < 32; ++i) scr[(2 * i + (lane >> 5)) * 33 + (lane & 31)] = v[i];
    LDS_WAIT(); asm volatile("" ::: "memory");
    const int n = lane >> 1, h = lane & 1; const LAS float* s = scr + (32 * h) * 33 + n;
    u32x4 o0, o1;
#pragma unroll
    for (int q = 0; q < 4; ++q) { o0[q] = pk4_fp8(s[(4 * q) * 33], s[(4 * q + 1) * 33], s[(4 * q + 2) * 33], s[(4 * q + 3) * 33]);
                                  o1[q] = pk4_fp8(s[(16 + 4 * q) * 33], s[(17 + 4 * q) * 33], s[(18 + 4 * q) * 33], s[(19 + 4 * q) * 33]); }
    unsigned char* d = dst + (size_t)n * ldd + 32 * h;
    *(u32x4*)d = o0; *(u32x4*)(d + 16) = o1;
    LDS_WAIT(); asm volatile("" ::: "memory");
}

__device__ __forceinline__ void p0_prologue(const Args& a, LAS unsigned char* lds, int gw, int NGW, int wave, int lane) {
    unsigned char* ws = a.ws;
    LAS float* scr = (LAS float*)(lds + wave * WAVE_LDS);
    constexpr int I_IN = (D / 64) * (IN_TOTAL / 32);
    constexpr int I_P = (512 / 64) * (D / 32);
    constexpr int I_O = (D / 64) * (D / 32);
    constexpr int I_LAYER = I_IN + 3 * I_P + I_O;
    { bf16_t* P = (bf16_t*)(ws + WS_P); float* rss = (float*)(ws + WS_RSS);
      for (int m4 = gw * 4; m4 < M; m4 += NGW * 4) {
          f32x4 v[4][4];
#pragma unroll
          for (int r = 0; r < 4; ++r) { const f32x4* xr = (const f32x4*)(a.in[0] + (size_t)(m4 + r) * D) + 2 * lane;
#pragma unroll
              for (int j = 0; j < 2; ++j) { v[r][2 * j] = __builtin_nontemporal_load(xr + 128 * j); v[r][2 * j + 1] = __builtin_nontemporal_load(xr + 128 * j + 1); } }
#pragma unroll
          for (int r = 0; r < 4; ++r) { float s = 0.f;
#pragma unroll
              for (int j = 0; j < 4; ++j) s += (v[r][j].x * v[r][j].x + v[r][j].y * v[r][j].y) + (v[r][j].z * v[r][j].z + v[r][j].w * v[r][j].w);
              s = wave_sum(s);
              u32x4* o = (u32x4*)(P + (size_t)(m4 + r) * PITCH + XB_COL) + lane;
              u32x2* o8 = (u32x2*)(ws + WS_XB8 + (size_t)(m4 + r) * D) + lane;
#pragma unroll
              for (int j = 0; j < 2; ++j) { const f32x4 p = v[r][2 * j], q = v[r][2 * j + 1];
                  u32x4 w; w.x = cvt_pk_bf16(p.x, p.y); w.y = cvt_pk_bf16(p.z, p.w); w.z = cvt_pk_bf16(q.x, q.y); w.w = cvt_pk_bf16(q.z, q.w); o[64 * j] = w;
                  o8[64 * j] = (u32x2){pk4_fp8(p.x, p.y, p.z, p.w), pk4_fp8(q.x, q.y, q.z, q.w)}; }
              if (lane < 16) rss[(size_t)(m4 + r) * 16 + lane] = (lane == 0) ? s : 0.f; }
      } }
    for (int it = gw; it < DEPTH * I_LAYER; it += NGW) {
        const int l = it / I_LAYER; int r = it % I_LAYER;
        bf16_t* Wmix = (bf16_t*)(ws + WS_WMIX) + (size_t)l * NMIX * D;
        bf16_t* W3 = (bf16_t*)(ws + WS_W3) + (size_t)l * D * K3;
        bf16_t* WoT = (bf16_t*)(ws + WS_WO) + (size_t)l * D * D;
        if (r < I_IN) {
            const int kb = r / (IN_TOTAL / 32), nb = r % (IN_TOTAL / 32), k0 = 64 * kb, n0 = 32 * nb, seg = n0 / 512;
            const float* W = a.in[2] + (size_t)l * D * IN_TOTAL; const float* gs = a.in[1] + l * D;
            if (seg < 9) { const int dseg = (seg == 0) ? 0 : (seg == 1) ? 3 : (seg == 2) ? 4 : (seg == 3) ? 5 : (seg == 4) ? 6 : (seg == 5) ? 7 : (seg == 6) ? 1 : (seg == 7) ? 8 : 2;
                p0_transpose_item(W, IN_TOTAL, k0, n0, gs, Wmix + (size_t)(dseg * 512 + (n0 & 511)) * D + k0, D, scr, lane); }
            else { const int nn = n0 - NMIX;
                p0_transpose_item_fp8(W, IN_TOTAL, k0, n0, gs, WG8_SCALE, ws + WS_WG8 + (size_t)l * 3 * D * D + (size_t)nn * D + k0, D, scr, lane); }
            continue; }
        r -= I_IN;
        if (r < 3 * I_P) { const int br = r / I_P, q = r % I_P, kb = q / (D / 32), nb = q % (D / 32), k0 = 64 * kb, n0 = 32 * nb;
            const float* W = a.in[11 + br] + (size_t)l * 512 * D;
            p0_transpose_item(W, D, k0, n0, nullptr, W3 + (size_t)n0 * K3 + br * 512 + k0, K3, scr, lane); continue; }
        r -= 3 * I_P;
        { const int kb = r / (D / 32), nb = r % (D / 32), k0 = 64 * kb, n0 = 32 * nb;
          const float* W = a.in[14] + (size_t)l * D * D;
          p0_transpose_item(W, D, k0, n0, nullptr, WoT + (size_t)n0 * D + k0, D, scr, lane); }
    }
    { bf16_t* Wm = (bf16_t*)(ws + WS_WM); const float* w_s = a.in[5];
      for (int i = gw * 64 + lane; i < DEPTH * 8 * 128 * 128 / 2; i += NGW * 64) { const int e = 2 * i, s = e & 127, t = (e >> 7) & 127;
          const f32x2 v = *(const f32x2*)(w_s + e); ((unsigned*)Wm)[i] = cvt_pk_bf16(s <= t ? v.x : 0.f, s + 1 <= t ? v.y : 0.f); } }
    { bf16_t* Wp = (bf16_t*)(ws + WS_WPOOL); const float* w_pool = a.in[9]; const float* ps = a.in[10];
      for (int i = gw * 64 + lane; i < DEPTH * 4 * 128 * 128 / 2; i += NGW * 64) { const int e = 2 * i, c = e & 127, d = (e >> 7) & 127, lg = e >> 14;
          const float sc = ps[lg * 128 + d];
          ((unsigned*)Wp)[i] = cvt_pk_bf16(w_pool[(size_t)lg * 16384 + c * 128 + d] * sc, w_pool[(size_t)lg * 16384 + (c + 1) * 128 + d] * sc); } }
}

__device__ __forceinline__ float row_rstd(const float* rss, int row, int fq) {
    const f32x4 p = *(const f32x4*)(rss + (size_t)row * 16 + fq * 4);
    float s = (p.x + p.y) + (p.z + p.w); s += __shfl_xor(s, 16); s += __shfl_xor(s, 32);
    return __builtin_amdgcn_rsqf(s * (1.0f / D) + RMS_EPS);
}
__device__ __forceinline__ float rstd_of(f32x4 p) { float s = (p.x + p.y) + (p.z + p.w); s += __shfl_xor(s, 16); s += __shfl_xor(s, 32); return __builtin_amdgcn_rsqf(s * (1.0f / D) + RMS_EPS); }
#define ZERO_ACC(acc) do { _Pragma("unroll") for (int _a = 0; _a < 2; ++_a) _Pragma("unroll") for (int _b = 0; _b < 2; ++_b) _Pragma("unroll") for (int _m = 0; _m < 4; ++_m) _Pragma("unroll") for (int _n = 0; _n < 2; ++_n) acc[_a][_b][_m][_n] = (f32x4){0.f, 0.f, 0.f, 0.f}; } while (0)

struct SchedP1 {
    pg8::TileOrder T; const char* P; const char* W;
    __device__ __forceinline__ bool next(int i, pg8::Unit& u) const { int pm, pn; if (!T.tile(i, pm, pn)) return false;
        u.pm = pm; u.pn = pn; u.kind = pn >> 1; u.nt = D / 64; u.A = P + ((size_t)pm * 256 * PITCH + XB_COL) * 2; u.B = W + (size_t)pn * 256 * D * 2; return true; }
};
struct EpiP1 {
    bf16_t* P; const float* rss; float* lns;
    __device__ __forceinline__ void operator()(f32x4 (&acc)[2][2][4][2], const pg8::Unit& u, int wr, int wc, int fr, int fq) const {
        const int seg = u.kind;
        const int act = (seg == 3) ? 1 : 0;
        unsigned lrow = (unsigned)(wr * 64 + fr); asm volatile("" : "+v"(lrow));
        const unsigned lp = (lrow * PITCH + (unsigned)(wc * 32) + 8u * (unsigned)fq) * 2u;
        const unsigned lr = lrow * 64u;
        const size_t up = (size_t)u.pm * 256 * PITCH + (size_t)u.pn * 256;
        const size_t ur = (size_t)u.pm * 256 * 16;
        f32x4 pr[2][4];
#pragma unroll
        for (int ai = 0; ai < 2; ++ai)
#pragma unroll
            for (int m = 0; m < 4; ++m) pr[ai][m] = *(const f32x4*)((const char*)(rss + ur + (ai * 128 + m * 16) * 16) + (lr + 16u * fq));
#pragma unroll
        for (int ai = 0; ai < 2; ++ai)
#pragma unroll
            for (int m = 0; m < 4; ++m) {
                const float rs = rstd_of(pr[ai][m]);
                float s1 = 0.f, s2 = 0.f;
#pragma unroll
                for (int bj = 0; bj < 2; ++bj) {
                    f32x4 v0 = acc[ai][bj][m][0] * rs, v1 = acc[ai][bj][m][1] * rs;
                    if (act == 1) {
#pragma unroll
                        for (int j = 0; j < 2; ++j) { const f32x2 g0 = gelu2((f32x2){v0[2 * j], v0[2 * j + 1]}), g1 = gelu2((f32x2){v1[2 * j], v1[2 * j + 1]});
                            v0[2 * j] = g0.x; v0[2 * j + 1] = g0.y; v1[2 * j] = g1.x; v1[2 * j + 1] = g1.y; } }
                    u32x4 w; w.x = cvt_pk_bf16(v0[0], v0[1]); w.y = cvt_pk_bf16(v0[2], v0[3]); w.z = cvt_pk_bf16(v1[0], v1[1]); w.w = cvt_pk_bf16(v1[2], v1[3]);
                    *(u32x4*)((char*)(P + up + (size_t)(ai * 128 + m * 16) * PITCH + bj * 128) + lp) = w;
                    if (seg == 3) {
#pragma unroll
                        for (int q = 0; q < 4; ++q) { const float lo = bf_lo(w[q]), hi = bf_hi(w[q]); s1 += lo + hi; s2 += lo * lo + hi * hi; } }
                }
                if (seg == 3) { s1 += __shfl_xor(s1, 16); s1 += __shfl_xor(s1, 32); s2 += __shfl_xor(s2, 16); s2 += __shfl_xor(s2, 32);
                    if (fq == 0) *(f32x2*)((char*)(lns + ur + (ai * 128 + m * 16) * 16 + ((u.pn - 6) * 4 + wc) * 2) + lr) = (f32x2){s1, s2}; }
            }
        ZERO_ACC(acc);
    }
};

struct SchedG {
    int x, r, n, c0, sq; const char* A8; const char* W8;
    __device__ __forceinline__ bool next(int i, pg8::Unit& u) const { if (i >= n) return false;
        int combo, pl;
        if (i < sq) { pl = 4 * i + (r & 3); combo = c0 + (r >> 2); } else { pl = r & 7; combo = c0 + (sq ? 4 : 0) + 2 * (i - sq) + (r >> 3); }
        const int gate = combo >> 2;
        u.pm = 8 * x + pl; u.pn = combo & 3; u.kind = gate; u.nt = D / 128;
        u.A = A8 + (size_t)u.pm * 256 * D; u.B = W8 + ((size_t)gate * D + (size_t)u.pn * 256) * D; return true; }
};
struct EpiP3G {
    unsigned char* S8; size_t gstride; unsigned rowb; const float* rss;
    __device__ __forceinline__ void operator()(f32x4 (&acc)[2][2][4][2], const pg8::Unit& u, int wr, int wc, int fr, int fq) const {
        unsigned lrow = (unsigned)(wr * 64 + fr); asm volatile("" : "+v"(lrow));
        const unsigned ls = lrow * rowb + (unsigned)(wc * 32) + 8u * (unsigned)fq;
        const unsigned lr = lrow * 64u;
        unsigned char* sb = S8 + (size_t)(u.pm >> 3) * GATE_GROUP_BYTES + (size_t)u.kind * gstride + (size_t)(u.pm & 7) * 256 * rowb + (size_t)u.pn * 256;
        const size_t ur = (size_t)u.pm * 256 * 16;
        f32x4 pr[2][4];
#pragma unroll
        for (int ai = 0; ai < 2; ++ai)
#pragma unroll
            for (int m = 0; m < 4; ++m) pr[ai][m] = *(const f32x4*)((const char*)(rss + ur + (ai * 128 + m * 16) * 16) + (lr + 16u * fq));
#pragma unroll
        for (int ai = 0; ai < 2; ++ai)
#pragma unroll
            for (int m = 0; m < 4; ++m) {
                const float rs = rstd_of(pr[ai][m]) * (-1.4426950409f / WG8_SCALE);
#pragma unroll
                for (int bj = 0; bj < 2; ++bj) { const f32x4 v0 = acc[ai][bj][m][0] * rs, v1 = acc[ai][bj][m][1] * rs;
                    unsigned w0 = 0u, w1 = 0u;
#pragma unroll
                    for (int j = 0; j < 4; ++j) { w0 = __builtin_amdgcn_cvt_pk_u8_f32(__builtin_amdgcn_rcpf(__builtin_fmaf(__builtin_amdgcn_exp2f(v0[j]), 1.0f / 255.0f, 1.0f / 255.0f)), j, w0);
                                                  w1 = __builtin_amdgcn_cvt_pk_u8_f32(__builtin_amdgcn_rcpf(__builtin_fmaf(__builtin_amdgcn_exp2f(v1[j]), 1.0f / 255.0f, 1.0f / 255.0f)), j, w1); }
                    w0 |= (((w0 - 0x01010101u) & ~w0) >> 7) & 0x01010101u; w1 |= (((w1 - 0x01010101u) & ~w1) >> 7) & 0x01010101u;
                    *(u32x2*)(sb + (size_t)(ai * 128 + m * 16) * rowb + bj * 128 + ls) = (u32x2){w0, w1}; }
            }
        ZERO_ACC(acc);
    }
};
struct SchedP3Y {
    int pm, pn; const char* P; const char* W;
    __device__ __forceinline__ bool next(int i, pg8::Unit& u) const { if (i >= 3) return false;
        u.pm = pm; u.pn = pn; u.kind = i; u.nt = 512 / 64;
        u.A = P + ((size_t)pm * 256 * PITCH + (size_t)i * 512) * 2; u.B = W + ((size_t)pn * 256 * K3 + (size_t)i * 512) * 2; return true; }
};
struct EpiP3Y {
    bf16_t* P; const unsigned char* S8; size_t gstride; unsigned rowb;
    __device__ __forceinline__ void operator()(f32x4 (&acc)[2][2][4][2], const pg8::Unit& u, int wr, int wc, int fr, int fq) const {
        const int j = u.kind; const bool fin = (j == 2);
        unsigned lrow = (unsigned)(wr * 64 + fr); asm volatile("" : "+v"(lrow));
        const unsigned ls = lrow * rowb + (unsigned)(wc * 32) + 8u * (unsigned)fq;
        const unsigned lp = (lrow * PITCH + (unsigned)(wc * 32) + 8u * (unsigned)fq) * 2u;
        const unsigned char* sb = S8 + (size_t)(u.pm >> 3) * GATE_GROUP_BYTES + (size_t)(u.pm & 7) * 256 * rowb + (size_t)u.pn * 256;
        const unsigned char* pn_ = sb + (size_t)j * gstride; const unsigned char* pd_ = sb + (size_t)(fin ? 2 : j + 1) * gstride;
        bf16_t* pmg = P + (size_t)u.pm * 256 * PITCH + C_MERGED + (size_t)u.pn * 256;
#pragma unroll
        for (int ai = 0; ai < 2; ++ai)
#pragma unroll
        for (int mh = 0; mh < 2; ++mh) {
            u32x2 sn[2][2], sd[2][2];
#pragma unroll
            for (int mm = 0; mm < 2; ++mm)
#pragma unroll
                for (int bj = 0; bj < 2; ++bj) { const size_t ro = (size_t)(ai * 128 + (mh * 2 + mm) * 16) * rowb + bj * 128;
                    sn[mm][bj] = *(const u32x2*)(pn_ + ro + ls); sd[mm][bj] = *(const u32x2*)(pd_ + ro + ls); }
#pragma unroll
            for (int mm = 0; mm < 2; ++mm)
#pragma unroll
                for (int bj = 0; bj < 2; ++bj) { const int m = mh * 2 + mm;
#pragma unroll
                    for (int n = 0; n < 2; ++n) { const unsigned sdw = fin ? 0xffffffffu : sd[mm][bj][n];
#pragma unroll
                        for (int e = 0; e < 4; ++e) { const float qn = (float)((sn[mm][bj][n] >> (8 * e)) & 0xffu), qd = (float)((sdw >> (8 * e)) & 0xffu);
                            acc[ai][bj][m][n][e] *= qn * __builtin_amdgcn_rcpf(qd); } }
                    if (fin) { const f32x4 v0 = acc[ai][bj][m][0], v1 = acc[ai][bj][m][1];
                        u32x4 w; w.x = cvt_pk_bf16(v0[0], v0[1]); w.y = cvt_pk_bf16(v0[2], v0[3]); w.z = cvt_pk_bf16(v1[0], v1[1]); w.w = cvt_pk_bf16(v1[2], v1[3]);
                        *(u32x4*)((char*)(pmg + (size_t)(ai * 128 + m * 16) * PITCH + bj * 128) + lp) = w; } }
        }
    }
};

struct SchedP4 {
    pg8::TileOrder T; const char* P; const char* W;
    __device__ __forceinline__ bool next(int i, pg8::Unit& u) const { int pm, pn; if (!T.tile(i, pm, pn)) return false;
        u.pm = pm; u.pn = pn; u.kind = 0; u.nt = D / 64; u.A = P + ((size_t)pm * 256 * PITCH + C_MERGED) * 2; u.B = W + (size_t)pn * 256 * D * 2; return true; }
};
struct EpiP4 {
    bf16_t* P; float* rss_out; unsigned char* xb8;
    __device__ __forceinline__ void operator()(f32x4 (&acc)[2][2][4][2], const pg8::Unit& u, int wr, int wc, int fr, int fq) const {
        unsigned lrow = (unsigned)(wr * 64 + fr); asm volatile("" : "+v"(lrow));
        const unsigned lc = (unsigned)(wc * 32) + 8u * (unsigned)fq;
        const unsigned lp = (lrow * PITCH + lc) * 2u, lx = (lrow * D + lc) * 4u, l8 = lrow * D + lc;
        const size_t ux = (size_t)u.pm * 256 * D + (size_t)u.pn * 256;
        bf16_t* pb = P + (size_t)u.pm * 256 * PITCH + (size_t)u.pn * 256 + XB_COL;
        float* rb = rss_out + (size_t)u.pm * 256 * 16 + u.pn * 4 + wc;
#pragma unroll
        for (int ai = 0; ai < 2; ++ai)
#pragma unroll
        for (int mh = 0; mh < 2; ++mh) {
            u32x4 hv[2][2];
#pragma unroll
            for (int mm = 0; mm < 2; ++mm)
#pragma unroll
                for (int bj = 0; bj < 2; ++bj) hv[mm][bj] = *(const u32x4*)((const char*)(pb + (size_t)(ai * 128 + (mh * 2 + mm) * 16) * PITCH + bj * 128) + lp);
#pragma unroll
            for (int mm = 0; mm < 2; ++mm) {
                const int m = mh * 2 + mm; float ss = 0.f;
#pragma unroll
                for (int bj = 0; bj < 2; ++bj) { const size_t ro = (size_t)(ai * 128 + m * 16) * D + bj * 128;
                    const f32x4 v0 = (f32x4){bf_lo(hv[mm][bj].x), bf_hi(hv[mm][bj].x), bf_lo(hv[mm][bj].y), bf_hi(hv[mm][bj].y)} + acc[ai][bj][m][0], v1 = (f32x4){bf_lo(hv[mm][bj].z), bf_hi(hv[mm][bj].z), bf_lo(hv[mm][bj].w), bf_hi(hv[mm][bj].w)} + acc[ai][bj][m][1];
                    ss += (v0[0] * v0[0] + v0[1] * v0[1]) + (v0[2] * v0[2] + v0[3] * v0[3]) + (v1[0] * v1[0] + v1[1] * v1[1]) + (v1[2] * v1[2] + v1[3] * v1[3]);
                    u32x4 w; w.x = cvt_pk_bf16(v0[0], v0[1]); w.y = cvt_pk_bf16(v0[2], v0[3]); w.z = cvt_pk_bf16(v1[0], v1[1]); w.w = cvt_pk_bf16(v1[2], v1[3]);
                    *(u32x4*)((char*)(pb + (size_t)(ai * 128 + m * 16) * PITCH + bj * 128) + lp) = w;
                    *(u32x2*)((xb8 + ux + ro) + l8) = (u32x2){pk4_fp8(v0[0], v0[1], v0[2], v0[3]), pk4_fp8(v1[0], v1[1], v1[2], v1[3])};
 }
                ss += __shfl_xor(ss, 16); ss += __shfl_xor(ss, 32);
                if (fq == 0) *(float*)((char*)(rb + (ai * 128 + m * 16) * 16) + lrow * 64u) = ss;
            }
        }
        ZERO_ACC(acc);
    }
};

struct EpiP4F {

    const bf16_t* P; float* out; float* rss_out; const float* fg; unsigned* cnt; unsigned* tmo;
    __device__ __forceinline__ void operator()(f32x4 (&acc)[2][2][4][2], const pg8::Unit& u, int wr, int wc, int fr, int fq) const {
        unsigned lrow = (unsigned)(wr * 64 + fr); asm volatile("" : "+v"(lrow));
        const unsigned lc = (unsigned)(wc * 32) + 8u * (unsigned)fq;
        const unsigned lx = (lrow * D + lc) * 4u;
        const unsigned lp = (lrow * PITCH + lc) * 2u, l8 = lrow * D + lc;
        const bf16_t* pxb = P + (size_t)u.pm * 256 * PITCH + (size_t)u.pn * 256 + XB_COL;
        const size_t ux = (size_t)u.pm * 256 * D + (size_t)u.pn * 256;
        float* rb = rss_out + (size_t)u.pm * 256 * 16 + u.pn * 4 + wc;
#pragma unroll
        for (int ai = 0; ai < 2; ++ai)
#pragma unroll
        for (int mh = 0; mh < 2; ++mh) {
            f32x4 xo[2][2][2]; u32x4 hv[2][2];
#pragma unroll
            for (int mm = 0; mm < 2; ++mm)
#pragma unroll
                for (int bj = 0; bj < 2; ++bj) hv[mm][bj] = *(const u32x4*)((const char*)(pxb + (size_t)(ai * 128 + (mh * 2 + mm) * 16) * PITCH + bj * 128) + lp);
#pragma unroll
            for (int mm = 0; mm < 2; ++mm)
#pragma unroll
                for (int bj = 0; bj < 2; ++bj)
#pragma unroll
                    for (int n = 0; n < 2; ++n) xo[mm][bj][n] = (f32x4){bf_lo(hv[mm][bj][2 * n]), bf_hi(hv[mm][bj][2 * n]), bf_lo(hv[mm][bj][2 * n + 1]), bf_hi(hv[mm][bj][2 * n + 1])};
#pragma unroll
            for (int mm = 0; mm < 2; ++mm) {
                const int m = mh * 2 + mm; float ss = 0.f;
#pragma unroll
                for (int bj = 0; bj < 2; ++bj) { const f32x4 v0 = xo[mm][bj][0] + acc[ai][bj][m][0], v1 = xo[mm][bj][1] + acc[ai][bj][m][1];
                    acc[ai][bj][m][0] = v0; acc[ai][bj][m][1] = v1;
                    ss += (v0[0] * v0[0] + v0[1] * v0[1]) + (v0[2] * v0[2] + v0[3] * v0[3]) + (v1[0] * v1[0] + v1[1] * v1[1]) + (v1[2] * v1[2] + v1[3] * v1[3]); }
                ss += __shfl_xor(ss, 16); ss += __shfl_xor(ss, 32);
                if (fq == 0) __hip_atomic_store((float*)((char*)(rb + (ai * 128 + m * 16) * 16) + lrow * 64u), ss, __ATOMIC_RELAXED, __HIP_MEMORY_SCOPE_AGENT);
            }
        }
        asm volatile("s_waitcnt vmcnt(0)" ::: "memory");
        const int lane = (int)(threadIdx.x & 63); const int wid = wr * 4 + wc;
        unsigned* pc = cnt + 64 * u.pm;
        if (lane == 0) __hip_atomic_fetch_add(pc, 1u, __ATOMIC_RELAXED, __HIP_MEMORY_SCOPE_AGENT);
        if (wid == 0) {
            asm volatile("buffer_inv sc1" ::: "memory");
            unsigned sp = 0;
            while ((unsigned)__builtin_amdgcn_readfirstlane(__hip_atomic_load(pc, __ATOMIC_RELAXED, __HIP_MEMORY_SCOPE_AGENT)) < 32u) {
                __builtin_amdgcn_s_sleep(1);
                if ((++sp & 255u) == 0u) { if (__hip_atomic_load(tmo, __ATOMIC_RELAXED, __HIP_MEMORY_SCOPE_AGENT)) break; if (sp > (1u << 20)) { if (lane == 0) atomicAdd(tmo, 1u); break; } } }
            asm volatile("s_waitcnt vmcnt(0)" ::: "memory");
        }
        asm volatile("" ::: "memory"); __builtin_amdgcn_s_barrier(); asm volatile("" ::: "memory");
        const unsigned lr = lrow * 64u;
        const size_t ur = (size_t)u.pm * 256 * 16;
        f32x4 pr[2][4];
#pragma unroll
        for (int ai = 0; ai < 2; ++ai)
#pragma unroll
            for (int m = 0; m < 4; ++m) pr[ai][m] = *(const f32x4*)((const char*)(rss_out + ur + (ai * 128 + m * 16) * 16) + (lr + 16u * fq));
        f32x4 gv[2][2];
#pragma unroll
        for (int bj = 0; bj < 2; ++bj) { const float* gp = (const float*)((const char*)(fg + u.pn * 256 + bj * 128) + lc * 4u); gv[bj][0] = *(const f32x4*)gp; gv[bj][1] = *(const f32x4*)(gp + 4); }
#pragma unroll
        for (int ai = 0; ai < 2; ++ai)
#pragma unroll
            for (int m = 0; m < 4; ++m) { const float rs = rstd_of(pr[ai][m]);
#pragma unroll
                for (int bj = 0; bj < 2; ++bj) { float* xq = (float*)((char*)(out + ux + (size_t)(ai * 128 + m * 16) * D + bj * 128) + lx);
                    *(f32x4*)xq = acc[ai][bj][m][0] * rs * gv[bj][0]; *(f32x4*)(xq + 4) = acc[ai][bj][m][1] * rs * gv[bj][1]; } }
        ZERO_ACC(acc);
    }
};

#define LDG(T, uptr, lboff) (*(const T*)((const char*)(uptr) + (lboff)))
#define STG(T, uptr, lboff, val) (*(T*)((char*)(uptr) + (lboff)) = (val))
typedef short s16x4 __attribute__((ext_vector_type(4)));
__device__ __forceinline__ s16x4 lds_tr16(const LAS void* p) { return __builtin_amdgcn_ds_read_tr16_b64_v4i16((LAS s16x4*)p); }
template <int TH> __device__ __forceinline__ void mixer_a_body(bf16_t* P, const float* lns, const bf16_t* Wm, const float* ln_g, const float* ln_b, const float* b_s, LAS unsigned char* wl, int n, int g, int lane) {
    constexpr int SLEN = 64 * (TH + 1), NV = SLEN / 8, NKS = 2 * (TH + 1);
    const int T0 = n * 128;
    constexpr int VB = 136;
    constexpr int OB = 272;
    const int ck = lane & 7, rsub = lane >> 3;
    const int fr = lane & 15, fq = lane >> 4;
    const unsigned lv = (unsigned)(rsub * PITCH + ck * 8) * 2u;
    const unsigned lw = (unsigned)(fr * 128 + fq * 8) * 2u;
    const bf16_t* pv = P + (size_t)T0 * PITCH + C_V + g * 64;
    u32x4 raw[NV];
#pragma unroll
    for (int q = 0; q < NV; ++q) raw[q] = LDG(u32x4, pv + (size_t)(q * 8) * PITCH, lv);
    f32x4 st[TH + 1][4];
#pragma unroll
    for (int h = 0; h <= TH; ++h)
#pragma unroll
        for (int j = 0; j < 4; ++j) st[h][j] = LDG(f32x4, lns + (size_t)(T0 + 64 * h) * 16 + 4 * j, (unsigned)lane * 64u);
    float lg[8], lb[8];
    { const f32x4 g0 = LDG(f32x4, ln_g + g * 64, (unsigned)ck * 32u), g1 = LDG(f32x4, ln_g + g * 64 + 4, (unsigned)ck * 32u), b0 = LDG(f32x4, ln_b + g * 64, (unsigned)ck * 32u), b1 = LDG(f32x4, ln_b + g * 64 + 4, (unsigned)ck * 32u);
#pragma unroll
      for (int j = 0; j < 4; ++j) { lg[j] = g0[j]; lg[4 + j] = g1[j]; lb[j] = b0[j]; lb[4 + j] = b1[j]; } }
    float mean[TH + 1], rstd[TH + 1];
#pragma unroll
    for (int h = 0; h <= TH; ++h) { const f32x4 a = st[h][0], b = st[h][1], c = st[h][2], d = st[h][3];
        const float s1 = (a.x + a.z) + (b.x + b.z) + (c.x + c.z) + (d.x + d.z), s2 = (a.y + a.w) + (b.y + b.w) + (c.y + c.w) + (d.y + d.w);
        mean[h] = s1 * (1.f / 512.f); rstd[h] = __builtin_amdgcn_rsqf(fmaxf(s2 * (1.f / 512.f) - mean[h] * mean[h], 0.f) + LN_EPS); }
#pragma unroll
    for (int q = 0; q < NV; ++q) { const int s = q * 8 + rsub;
        const float mu = __shfl(mean[(q * 8) >> 6], s & 63), rs = __shfl(rstd[(q * 8) >> 6], s & 63);
        unsigned pk[4];
#pragma unroll
        for (int j = 0; j < 4; ++j) pk[j] = cvt_pk_bf16((bf_lo(raw[q][j]) - mu) * rs * lg[2 * j] + lb[2 * j], (bf_hi(raw[q][j]) - mu) * rs * lg[2 * j + 1] + lb[2 * j + 1]);
        LAS unsigned char* wp = wl + s * VB + ck * 16;
        *(LAS u32x2*)wp = (u32x2){pk[0], pk[1]}; *(LAS u32x2*)(wp + 8) = (u32x2){pk[2], pk[3]}; }
    LDS_WAIT(); asm volatile("" ::: "memory");
    f32x4 acc[4][4];
#pragma unroll
    for (int ct = 0; ct < 4; ++ct)
#pragma unroll
        for (int tt = 0; tt < 4; ++tt) acc[ct][tt] = (f32x4){0.f, 0.f, 0.f, 0.f};
    const bf16_t* wmg = Wm + (size_t)g * 128 * 128 + (size_t)(64 * TH) * 128;
    const LAS unsigned char* trp = wl + (8 * fq + (fr >> 2)) * VB + (fr & 3) * 8;
#pragma unroll 1
    for (int ks = 0; ks < NKS; ++ks) {
        bf16x8 af[4], bfr[4];
#pragma unroll
        for (int tt = 0; tt < 4; ++tt) bfr[tt] = LDG(bf16x8, wmg + (16 * tt) * 128 + ks * 32, lw);
#pragma unroll
        for (int ct = 0; ct < 4; ++ct) { const s16x4 a0 = lds_tr16(trp + (ks * 32) * VB + ct * 32), a1 = lds_tr16(trp + (ks * 32 + 4) * VB + ct * 32);
            af[ct] = (bf16x8){a0[0], a0[1], a0[2], a0[3], a1[0], a1[1], a1[2], a1[3]}; }
#pragma unroll
        for (int ct = 0; ct < 4; ++ct)
#pragma unroll
            for (int tt = 0; tt < 4; ++tt) acc[ct][tt] = __builtin_amdgcn_mfma_f32_16x16x32_bf16(af[ct], bfr[tt], acc[ct][tt], 0, 0, 0);
    }
    LDS_WAIT(); asm volatile("" ::: "memory");
#pragma unroll
    for (int tt = 0; tt < 4; ++tt)
#pragma unroll
        for (int ct = 0; ct < 4; ++ct) *(LAS f32x4*)(wl + (16 * tt + fr) * OB + (16 * ct + 4 * fq) * 4) = acc[ct][tt];
    LDS_WAIT(); asm volatile("" ::: "memory");
    bf16_t* po = P + (size_t)(T0 + 64 * TH) * PITCH + g * 64;
    const float* bsp = b_s + g * 128 + 64 * TH;
#pragma unroll
    for (int hf = 0; hf < 2; ++hf) {
        u32x4 uu[4], zz[4]; float bs[4];
#pragma unroll
        for (int q = 0; q < 4; ++q) { uu[q] = LDG(u32x4, po + (size_t)((hf * 4 + q) * 8) * PITCH + C_U, lv); zz[q] = LDG(u32x4, po + (size_t)((hf * 4 + q) * 8) * PITCH + C_ZA, lv);
            bs[q] = LDG(float, bsp + (hf * 4 + q) * 8, (unsigned)rsub * 4u); }
#pragma unroll
        for (int q = 0; q < 4; ++q) { const int t = (hf * 4 + q) * 8 + rsub;
            const f32x4 s0 = *(const LAS f32x4*)(wl + t * OB + ck * 32), s1 = *(const LAS f32x4*)(wl + t * OB + ck * 32 + 16);
            u32x4 w;
#pragma unroll
            for (int j = 0; j < 4; ++j) { const f32x2 s2 = (j < 2 ? (f32x2){s0[2 * j], s0[2 * j + 1]} : (f32x2){s1[2 * j - 4], s1[2 * j - 3]}) + bs[q];
                const f32x2 o = gelu2(bf2(uu[q][j])) * s2 * silu2(bf2(zz[q][j]));
                w[j] = cvt_pk_bf16(o.x, o.y); }
            STG(u32x4, po + (size_t)((hf * 4 + q) * 8) * PITCH + C_U, lv, w); }
    }
    LDS_WAIT(); asm volatile("" ::: "memory");
}
__device__ __forceinline__ void mixer_a_item(bf16_t* P, const float* lns, const bf16_t* Wm, const float* ln_g, const float* ln_b, const float* b_s, LAS unsigned char* wl, int item, int lane) {
    const int th = item & 1, g = (item >> 1) & 7, n = item >> 4;
    if (th) mixer_a_body<1>(P, lns, Wm, ln_g, ln_b, b_s, wl, n, g, lane); else mixer_a_body<0>(P, lns, Wm, ln_g, ln_b, b_s, wl, n, g, lane);
}

__device__ __forceinline__ void mixer_b_item(bf16_t* P, const float* conv_w, const float* conv_b, int item, int lane) {
    const int hb = item & 1, t0 = (item >> 1) * 16;
    const bool seq_start = (t0 % SEQ) == 0;
    bf16_t* pbase = P + (size_t)t0 * PITCH + hb * 256;
    const unsigned l8 = (unsigned)lane * 8u, l16 = (unsigned)lane * 16u;
    const f32x4 w0 = LDG(f32x4, conv_w + hb * 256, l16), w1 = LDG(f32x4, conv_w + 512 + hb * 256, l16), w2 = LDG(f32x4, conv_w + 1024 + hb * 256, l16), cb = LDG(f32x4, conv_b + hb * 256, l16);
    f32x4 pm2 = (f32x4){0.f, 0.f, 0.f, 0.f}, pm1 = pm2;
#pragma unroll
    for (int hf = 0; hf < 2; ++hf) {
        u32x2 xx[10], cc[10], bb[8], zz[8];
#pragma unroll
        for (int r = (hf ? 2 : 0); r < 10; ++r) { const int dt = hf * 8 + r - 2; const bool ok = (dt >= 0) || !seq_start;
            xx[r] = ok ? LDG(u32x2, pbase + (ptrdiff_t)dt * PITCH + C_XB, l8) : (u32x2){0u, 0u}; cc[r] = ok ? LDG(u32x2, pbase + (ptrdiff_t)dt * PITCH + C_CG, l8) : (u32x2){0u, 0u}; }
#pragma unroll
        for (int r = 0; r < 8; ++r) { bb[r] = LDG(u32x2, pbase + (size_t)(hf * 8 + r) * PITCH + C_BG, l8); zz[r] = LDG(u32x2, pbase + (size_t)(hf * 8 + r) * PITCH + C_ZB, l8); }
        if (hf == 0) {
            pm2 = (f32x4){bf_lo(xx[0].x) * bf_lo(cc[0].x), bf_hi(xx[0].x) * bf_hi(cc[0].x), bf_lo(xx[0].y) * bf_lo(cc[0].y), bf_hi(xx[0].y) * bf_hi(cc[0].y)};
            pm1 = (f32x4){bf_lo(xx[1].x) * bf_lo(cc[1].x), bf_hi(xx[1].x) * bf_hi(cc[1].x), bf_lo(xx[1].y) * bf_lo(cc[1].y), bf_hi(xx[1].y) * bf_hi(cc[1].y)}; }
#pragma unroll
        for (int r = 0; r < 8; ++r) {
            const f32x4 p0 = (f32x4){bf_lo(xx[r + 2].x) * bf_lo(cc[r + 2].x), bf_hi(xx[r + 2].x) * bf_hi(cc[r + 2].x), bf_lo(xx[r + 2].y) * bf_lo(cc[r + 2].y), bf_hi(xx[r + 2].y) * bf_hi(cc[r + 2].y)};
            const f32x4 y = cb + w0 * pm2 + w1 * pm1 + w2 * p0;
            const f32x4 bg = (f32x4){bf_lo(bb[r].x), bf_hi(bb[r].x), bf_lo(bb[r].y), bf_hi(bb[r].y)};
            const f32x2 zb0 = silu2(bf2(zz[r].x)), zb1 = silu2(bf2(zz[r].y)); const f32x4 zb = (f32x4){zb0.x, zb0.y, zb1.x, zb1.y};
            const f32x4 o = bg * y * zb;
            u32x2 w; w.x = cvt_pk_bf16(o[0], o[1]); w.y = cvt_pk_bf16(o[2], o[3]); STG(u32x2, pbase + (size_t)(hf * 8 + r) * PITCH + C_ZB, l8, w);
            pm2 = pm1; pm1 = p0; }
    }
}

template <int W> __device__ __forceinline__ void mixer_c_pool(const bf16_t* pxc  , LAS bf16_t* pl, int PL_LD, int tseq, int lane) {
    constexpr int NR = 31 + W;
    unsigned xv[NR];
#pragma unroll
    for (int r = 0; r < NR; ++r) { const int dt = r - (W - 1); xv[r] = (dt >= 0 || tseq > 0) ? LDG(unsigned, pxc + (ptrdiff_t)dt * PITCH, (unsigned)lane * 4u) : 0u; }
    float s0 = 0.f, s1 = 0.f;
#pragma unroll
    for (int r = 0; r < NR; ++r) {
        const int dt = r - (W - 1);
        s0 += bf_lo(xv[r]); s1 += bf_hi(xv[r]);
        if (r >= W) { s0 -= bf_lo(xv[r - W]); s1 -= bf_hi(xv[r - W]); }
        if (dt >= 0) { const int pos = tseq + dt; const float inv = 1.0f / (float)((pos + 1 < W) ? (pos + 1) : W);
            *(LAS unsigned*)(pl + dt * PL_LD + 2 * lane) = cvt_pk_bf16(s0 * inv - bf_lo(xv[r]), s1 * inv - bf_hi(xv[r])); }
    }
}
__device__ __forceinline__ void mixer_c_item(bf16_t* P, const bf16_t* WpT, LAS unsigned char* wl, int item, int lane) {
    const int gi = item & 3, t0 = (item >> 2) * 32;
    constexpr int PL_LD = 136;
    constexpr int OB = 528;
    LAS bf16_t* pl = (LAS bf16_t*)wl;
    const bf16_t* pxc = P + (size_t)t0 * PITCH + C_XC + gi * 128; const int tseq = t0 % SEQ;
    if (gi == 0) mixer_c_pool<2>(pxc, pl, PL_LD, tseq, lane);
    else if (gi == 1) mixer_c_pool<4>(pxc, pl, PL_LD, tseq, lane);
    else if (gi == 2) mixer_c_pool<8>(pxc, pl, PL_LD, tseq, lane);
    else mixer_c_pool<16>(pxc, pl, PL_LD, tseq, lane);
    LDS_WAIT(); asm volatile("" ::: "memory");
    const int fr = lane & 15, fq = lane >> 4;
    const unsigned lw = (unsigned)(fr * 128 + fq * 8) * 2u;
    bf16x8 bfr[2][4];
#pragma unroll
    for (int tt = 0; tt < 2; ++tt)
#pragma unroll
        for (int ks = 0; ks < 4; ++ks) bfr[tt][ks] = *(const LAS bf16x8*)(pl + (tt * 16 + fr) * PL_LD + ks * 32 + fq * 8);
    LDS_WAIT(); asm volatile("" ::: "memory");
    const bf16_t* wg = WpT + (size_t)gi * 128 * 128;
#pragma unroll 2
    for (int dp = 0; dp < 4; ++dp) {
        bf16x8 af[2][4];
#pragma unroll
        for (int d2 = 0; d2 < 2; ++d2)
#pragma unroll
            for (int ks = 0; ks < 4; ++ks) af[d2][ks] = LDG(bf16x8, wg + (size_t)((dp * 2 + d2) * 16) * 128 + ks * 32, lw);
#pragma unroll
        for (int d2 = 0; d2 < 2; ++d2) {
            f32x4 a0 = (f32x4){0.f, 0.f, 0.f, 0.f}, a1 = a0;
#pragma unroll
            for (int ks = 0; ks < 4; ++ks) { a0 = __builtin_amdgcn_mfma_f32_16x16x32_bf16(af[d2][ks], bfr[0][ks], a0, 0, 0, 0); a1 = __builtin_amdgcn_mfma_f32_16x16x32_bf16(af[d2][ks], bfr[1][ks], a1, 0, 0, 0); }
            *(LAS f32x4*)(wl + fr * OB + ((dp * 2 + d2) * 16 + 4 * fq) * 4) = a0; *(LAS f32x4*)(wl + (16 + fr) * OB + ((dp * 2 + d2) * 16 + 4 * fq) * 4) = a1; }
    }
    LDS_WAIT(); asm volatile("" ::: "memory");
    bf16_t* pz = P + (size_t)t0 * PITCH + C_ZC + gi * 128;
    const int r4 = lane >> 4, c16 = lane & 15;
    const unsigned lz = (unsigned)(r4 * PITCH + c16 * 8) * 2u;
    u32x4 zv[8];
#pragma unroll
    for (int q = 0; q < 8; ++q) zv[q] = LDG(u32x4, pz + (size_t)(q * 4) * PITCH, lz);
#pragma unroll
    for (int q = 0; q < 8; ++q) { const int t = q * 4 + r4;
        const f32x4 s0 = *(const LAS f32x4*)(wl + t * OB + c16 * 32), s1 = *(const LAS f32x4*)(wl + t * OB + c16 * 32 + 16);
        u32x4 w;
#pragma unroll
        for (int j = 0; j < 4; ++j) { const float sa = (j < 2 ? s0[2 * j] : s1[2 * j - 4]), sb = (j < 2 ? s0[2 * j + 1] : s1[2 * j - 3]);
            { const f32x2 o = (f32x2){sa, sb} * silu2(bf2(zv[q][j])); w[j] = cvt_pk_bf16(o.x, o.y); } }
        STG(u32x4, pz + (size_t)(q * 4) * PITCH, lz, w); }
    LDS_WAIT(); asm volatile("" ::: "memory");
}

__global__ void __launch_bounds__(NWAVES * 64, 2) hybrid_fwd(Args args) {
    extern __shared__ __attribute__((aligned(16))) unsigned char lds_raw[];
    LAS unsigned char* lds = (LAS unsigned char*)lds_raw;
    volatile LAS unsigned* MISC = (volatile LAS unsigned*)(lds + MISC_OFF);
    const int tid = threadIdx.x, lane = tid & 63, wave = __builtin_amdgcn_readfirstlane(tid >> 6);
    const int G = gridDim.x; const int bx = blockIdx.x;
    const int vcu = (G % 8 == 0) ? (bx % 8) * (G / 8) + bx / 8 : bx;
    const int gw = vcu * NWAVES + wave, NGW = G * NWAVES;
    unsigned char* ws = args.ws;
    for (int u = tid; u < (LDS_BYTES - LDSCTL_OFF) / 4; u += NWAVES * 64) ((LAS unsigned*)(lds + LDSCTL_OFF))[u] = 0u;
    __syncthreads();
    const XcdBarrier bar = xcd_barrier_post((unsigned*)(ws + WS_CTL), MISC + 8, (unsigned)G);
    (void)xcd_barrier_post((unsigned*)(ws + WS_CTL) + (1 + (bx & 7)) * XCD_BAR_WORDS, MISC + 10, (unsigned)(G / 8));
    const int lo = args.ph_lo, hi = args.ph_hi;
#define IN(k) (lo <= (k) && (k) < hi)
#define SEAM(k) do { if (IN(k) && IN((k) + 1)) xcd_barrier(bar); } while (0)
#define CW_PROG 47104
#define GSEAM_W(k, nbr, tgt) GSEAM_X(k, nbr, tgt, false)
#define GSEAM_X(k, nbr, tgt, loc) do { if (IN(k) && IN((k) + 1)) { XcdBarrier gb; gb.bar = (unsigned*)(args.ws + WS_CTL) + (1 + ((int)blockIdx.x & 7)) * XCD_BAR_WORDS; gb.x = bar.x; gb.st = MISC + 10; gb.G = gridDim.x / 8; \
        unsigned* pw_ = (unsigned*)(args.ws + WS_CTL) + CW_PROG; const int nb_ = (nbr); \
        xcd_barrier(gb, nb_ >= 0 ? pw_ + 64 * nb_ : nullptr, (unsigned)(tgt), ((int)blockIdx.x >> 3) == 0 ? pw_ + 64 * ((int)blockIdx.x & 7) : nullptr, (loc)); } } while (0)
#define GSEAM(k) GSEAM_X(k, -1, 0, true)

    bf16_t* P = (bf16_t*)(ws + WS_P);
    float* rss = (float*)(ws + WS_RSS);
    float* lns = (float*)(ws + WS_LNS);

    if (IN(0)) { p0_prologue(args, lds, gw, NGW, wave, lane); }
    SEAM(0);

    for (int l = 0; l < DEPTH; ++l) {
        const int pb = 1 + 4 * l;
        const bf16_t* Wmix = (const bf16_t*)(ws + WS_WMIX) + (size_t)l * NMIX * D;
        const bf16_t* W3 = (const bf16_t*)(ws + WS_W3) + (size_t)l * D * K3;
        const bf16_t* WoT = (const bf16_t*)(ws + WS_WO) + (size_t)l * D * D;
        const float* rss_l = rss + (size_t)l * M * 16;
        if (IN(pb)) {
            const int jg = bx >> 3; const bool five = (G == 256) && (bx < 128);
            for (int pass = 0; pass < 2; ++pass) {
                if ((pass == 0) != five) {
                    SchedG S; S.x = bx & 7; S.r = jg & 15; S.n = five ? 1 : 2; S.c0 = five ? 4 : 0; S.sq = five ? 0 : 2;     S.A8 = (const char*)(ws + WS_XB8); S.W8 = (const char*)(ws + WS_WG8 + (size_t)l * 3 * D * D);
                    EpiP3G E{(unsigned char*)args.out, GATE_PLANE_BYTES, (unsigned)D, rss_l};
                    pg8::gemm_phase<EpiP3G, SchedG, true, true>(lds, D, D, S, E);
                } else {
                    SchedP1 S; S.T.init(M, NMIX, G, bx, P1_WGM); S.P = (const char*)P; S.W = (const char*)Wmix;
                    EpiP1 E{P, rss_l, lns};
                    pg8::gemm_phase<EpiP1, SchedP1, true>(lds, PITCH * 2, D * 2, S, E);
                }
            }
        }
        GSEAM_W(pb, (bx & 3) != 0 ? (bx & 7) - 1 : -1, 1 + 4 * l);
        if (IN(pb + 1)) {
            const bf16_t* Wm = (const bf16_t*)(ws + WS_WM) + (size_t)l * 8 * 128 * 128;
            const bf16_t* WpT = (const bf16_t*)(ws + WS_WPOOL) + (size_t)l * 4 * 128 * 128;
            LAS unsigned char* wl = lds + wave * WAVE_LDS;
            int ln = lane; asm volatile("" : "+v"(ln));
            { const int x = bx & 7, e = bx >> 3;
              SchedG S; S.x = x; S.r = e & 15; S.A8 = (const char*)(ws + WS_XB8); S.W8 = (const char*)(ws + WS_WG8 + (size_t)l * 3 * D * D);
              EpiP3G E{(unsigned char*)args.out, GATE_PLANE_BYTES, (unsigned)D, rss_l};
              if (G != 256) { for (int li = e * NWAVES + wave; li < 768; li += (G / 8) * NWAVES) { const int j = 256 * x + (li & 255);
                  if (li < 256) mixer_a_item(P, lns, Wm, args.in[3] + l * 512, args.in[4] + l * 512, args.in[6] + l * 1024, wl, j, ln);
                  else if (li < 512) mixer_b_item(P, args.in[7] + l * 1536, args.in[8] + l * 512, j, ln);
                  else mixer_c_item(P, WpT, wl, j, ln); } }
              else if (e < 16) {
                for (int li = e * 8 + wave; li < 512; li += 128) { const int j = 256 * x + (li & 255);
                  if (li < 256) mixer_a_item(P, lns, Wm, args.in[3] + l * 512, args.in[4] + l * 512, args.in[6] + l * 1024, wl, j, ln);
                  else mixer_b_item(P, args.in[7] + l * 1536, args.in[8] + l * 512, j, ln); }
                __syncthreads();
                S.n = 1; S.c0 = 10; S.sq = 0;
                pg8::gemm_phase<EpiP3G, SchedG, true, true>(lds, D, D, S, E); }
              else {
                S.n = 2; S.c0 = 6; S.sq = 2;
                pg8::gemm_phase<EpiP3G, SchedG, true, true>(lds, D, D, S, E);
                for (int li = 512 + (e - 16) * 8 + wave; li < 768; li += 128) mixer_c_item(P, WpT, wl, 256 * x + (li & 255), ln); } }
        }
        GSEAM(pb + 1);
        if (IN(pb + 2)) {
            pg8::TileOrder T; T.init(M, D, G, bx); int pm3, pn3;
            if (T.tile(0, pm3, pn3)) {
                SchedP3Y S; S.pm = pm3; S.pn = pn3; S.P = (const char*)P; S.W = (const char*)W3; EpiP3Y E{P, (const unsigned char*)args.out, GATE_PLANE_BYTES, (unsigned)D};
                pg8::gemm_phase<EpiP3Y, SchedP3Y, true>(lds, PITCH * 2, K3 * 2, S, E);
            }
        }
        GSEAM(pb + 2);
        if (IN(pb + 3)) {
            SchedP4 S; S.T.init(M, D, G, bx); S.P = (const char*)P; S.W = (const char*)WoT;
            if (l == 0) { EpiP4 E{P, rss + (size_t)(l + 1) * M * 16, ws + WS_XB8};
                pg8::gemm_phase<EpiP4, SchedP4, true>(lds, PITCH * 2, D * 2, S, E); }
            else { EpiP4F E{P, args.out, rss + (size_t)2 * M * 16, args.in[15], (unsigned*)(ws + WS_CTL) + CW_PANEL, (unsigned*)(ws + WS_CTL) + XB_TMO};
                pg8::gemm_phase<EpiP4F, SchedP4, true>(lds, PITCH * 2, D * 2, S, E); }
        }
        if (l + 1 < DEPTH) GSEAM_X(pb + 3, (bx & 3) != 3 ? (bx & 7) + 1 : -1, 2 + 4 * l, true);
    }
#undef IN
#undef SEAM
#undef GSEAM
}

extern "C" void kernel_launch(void* const* d_in, const int* in_sizes, int n_in, void* d_out, int out_size, void* d_ws, size_t ws_size, hipStream_t stream) {
    static int grid = 0;
    if (grid == 0) {
        if (n_in != 16 || in_sizes[0] != M * D || out_size != M * D || ws_size < WS_END) { fprintf(stderr, "kernel_launch: unexpected shapes (n_in %d, in0 %d, out %d, ws %zu); nothing launched\n", n_in, n_in > 0 ? in_sizes[0] : -1, out_size, ws_size); grid = -1; return; }
        int dev = 0, cus = 0, per_cu = 0;
        if (hipGetDevice(&dev) != hipSuccess || hipDeviceGetAttribute(&cus, hipDeviceAttributeMultiprocessorCount, dev) != hipSuccess) { grid = -1; return; }
        if (hipFuncSetAttribute((const void*)hybrid_fwd, hipFuncAttributeMaxDynamicSharedMemorySize, LDS_BYTES) != hipSuccess) { fprintf(stderr, "kernel_launch: hipFuncSetAttribute failed\n"); grid = -1; return; }
        if (hipOccupancyMaxActiveBlocksPerMultiprocessor(&per_cu, (const void*)hybrid_fwd, NWAVES * 64, LDS_BYTES) != hipSuccess || per_cu < 1) { fprintf(stderr, "kernel_launch: occupancy query reports %d blocks per CU\n", per_cu); (void)hipGetLastError(); grid = -1; return; }
        if (cus != 256) { fprintf(stderr, "kernel_launch: built for a 256-CU device (the unit assignment is written for 256 workgroups); this one has %d CUs; nothing launched\n", cus); grid = -1; return; }
        grid = cus;
    }
    if (grid < 0) return;
    if (hipMemsetAsync((char*)d_ws + WS_CTL, 0, CTL_ZERO_BYTES, stream) != hipSuccess) return;
    Args a{};
    for (int i = 0; i < 16; ++i) a.in[i] = (const float*)d_in[i];
    a.out = (float*)d_out; a.ws = (unsigned char*)d_ws;
    a.ph_lo = 0; a.ph_hi = 9;
    hipLaunchKernelGGL(hybrid_fwd, dim3(grid), dim3(NWAVES * 64), LDS_BYTES, stream, a);
}
```

```cpp
#include <hip/hip_runtime.h>
#include <cstdio>
#include <cstdint>


#define P1_WGM 2
#define GAS __attribute__((address_space(1)))
#define LAS __attribute__((address_space(3)))
typedef unsigned short bf16_t;
typedef short bf16x8 __attribute__((ext_vector_type(8)));
typedef float f32x4 __attribute__((ext_vector_type(4)));
typedef float f32x2 __attribute__((ext_vector_type(2)));
typedef unsigned u32x4 __attribute__((ext_vector_type(4)));
typedef unsigned u32x2 __attribute__((ext_vector_type(2)));

constexpr int SEQ = 8192, D = 1024, M = 2 * SEQ, DEPTH = 2;
constexpr int IN_TOTAL = 7680;
constexpr int NMIX = 4608;
constexpr int PITCH = NMIX + D;
constexpr int XB_COL = NMIX;
constexpr int C_U = 0, C_ZB = 512, C_ZC = 1024, C_V = 1536, C_ZA = 2048, C_XB = 2560, C_BG = 3072, C_CG = 3584, C_XC = 4096;
constexpr int C_S = 1536, C_MERGED = 1536;
constexpr int K3 = 1536;
constexpr float RMS_EPS = 1e-6f, LN_EPS = 1e-5f;

constexpr size_t MiB = 1u << 20;
constexpr size_t WS_CTL = 0, CTL_ZERO_BYTES = 192 * 1024;
constexpr int CW_PANEL = 40960;
constexpr size_t WS_RSS = 1 * MiB;
constexpr size_t WS_LNS = 4 * MiB;
constexpr size_t WS_WMIX = 5 * MiB;
constexpr size_t WS_W3 = 23 * MiB;
constexpr size_t WS_WO = 29 * MiB;
constexpr size_t WS_WM = 33 * MiB;
constexpr size_t WS_WPOOL = WS_WM + 512 * 1024;
constexpr size_t WS_P = 34 * MiB;
constexpr size_t WS_XB8 = WS_P + (size_t)M * PITCH * 2;
constexpr size_t WS_WG8 = WS_XB8 + (size_t)M * D;
constexpr float WG8_SCALE = 64.0f;
constexpr size_t GATE_GROUP_BYTES = 8 * MiB, GATE_PLANE_BYTES = 2 * MiB;
constexpr size_t WS_END = WS_WG8 + (size_t)DEPTH * 3 * D * D;
static_assert(WS_END <= 256 * MiB, "workspace map");

constexpr int NWAVES = 8;
constexpr int RING_BYTES = 131072;
constexpr int WAVE_LDS = 17920;
constexpr int LDSCTL_OFF = 143360, MISC_OFF = LDSCTL_OFF + 320;
constexpr int LDS_BYTES = 147456;

#define RLX_AGENT __ATOMIC_RELAXED, __HIP_MEMORY_SCOPE_AGENT
#define LDS_WAIT() asm volatile("s_waitcnt lgkmcnt(0)" ::: "memory")
#define VM_WAIT() asm volatile("s_waitcnt vmcnt(0)" ::: "memory")

__device__ __forceinline__ unsigned cvt_pk_bf16(float lo, float hi) { unsigned r; asm volatile("v_cvt_pk_bf16_f32 %0, %1, %2" : "=v"(r) : "v"(lo), "v"(hi)); return r; }
__device__ __forceinline__ unsigned pk4_fp8(float a, float b, float c, float d) { int w = 0; w = __builtin_amdgcn_cvt_pk_fp8_f32(a, b, w, false); w = __builtin_amdgcn_cvt_pk_fp8_f32(c, d, w, true); return (unsigned)w; }
__device__ __forceinline__ float bf_lo(unsigned w) { return __builtin_bit_cast(float, w << 16); }
__device__ __forceinline__ float bf_hi(unsigned w) { return __builtin_bit_cast(float, w & 0xffff0000u); }
__device__ __forceinline__ float sigmoid_f(float x) { return __builtin_amdgcn_rcpf(1.0f + __builtin_amdgcn_exp2f(-1.4426950409f * x)); }
__device__ __forceinline__ float silu_f(float x) { return x * sigmoid_f(x); }
__device__ __forceinline__ f32x2 bf2(unsigned w) { return (f32x2){bf_lo(w), bf_hi(w)}; }
__device__ __forceinline__ f32x2 rcp2(f32x2 d) { return (f32x2){__builtin_amdgcn_rcpf(d.x), __builtin_amdgcn_rcpf(d.y)}; }
__device__ __forceinline__ f32x2 exp2_2(f32x2 t) { return (f32x2){__builtin_amdgcn_exp2f(t.x), __builtin_amdgcn_exp2f(t.y)}; }
__device__ __forceinline__ f32x2 silu2(f32x2 x) { return x * rcp2(exp2_2(x * -1.4426950409f) + 1.0f); }
__device__ __forceinline__ f32x2 gelu2(f32x2 x) { const f32x2 t = x * x * (-2.3022081981f * 0.044715f) + (-2.3022081981f); return x * rcp2(exp2_2(x * t) + 1.0f); }
__device__ __forceinline__ float gelu_tanh_f(float x) { return x * __builtin_amdgcn_rcpf(1.0f + __builtin_amdgcn_exp2f(x * __builtin_fmaf(x * x, -2.3022081981f * 0.044715f, -2.3022081981f))); }

namespace pg8 {
constexpr int BM = 256, BK = 64, HALF = 128, HTB = HALF * BK * 2, STAGE_BYTES = 8 * HTB, NXCD = 8, WGM = 8;
__host__ __device__ __forceinline__ int lds_byte(int r, int c) { const int st = (r >> 4) * 2 + (c >> 5), rr = r & 15, cc = c & 31, ob = rr * 64 + cc * 2; return st * 1024 + (ob ^ (((ob >> 9) & 1) << 5)); }
__host__ __device__ __forceinline__ void stage_rc(int b, int& R, int& C) { const int st = b / 1024, sb = b % 1024, swz = sb ^ (((sb >> 9) & 1) << 5); R = (st >> 1) * 16 + swz / 64; C = (st & 1) * 32 + (swz % 64) / 2; }
__host__ __device__ __forceinline__ int perm32(int rho) { const int n = rho >> 4, i = rho & 15; return 8 * (i >> 2) + 4 * n + (i & 3); }

#define PG8_ZERO(acc) do { bf16x8 z_ = (bf16x8){0, 0, 0, 0, 0, 0, 0, 0}; _Pragma("unroll") for (int _a = 0; _a < 2; ++_a) _Pragma("unroll") for (int _b = 0; _b < 2; ++_b) _Pragma("unroll") for (int _m = 0; _m < 4; ++_m) _Pragma("unroll") for (int _n = 0; _n < 2; ++_n) { asm volatile("" : "+v"(z_)); acc[_a][_b][_m][_n] = __builtin_amdgcn_mfma_f32_16x16x32_bf16(z_, z_, (f32x4){0.f, 0.f, 0.f, 0.f}, 0, 0, 0); } } while (0)
struct Unit { const char* A; const char* B; int nt; int kind; int pm, pn; };

struct TileOrder {
    int nM, nN, nwg, G, c, wgm;
    __device__ void init(int M_, int N_, int G_, int c_, int wgm_ = WGM) { nM = M_ / BM; nN = N_ / BM; nwg = nM * nN; G = G_; c = c_; wgm = wgm_; }
    __device__ bool tile(int i, int& pm, int& pn) const {
        const long L = (long)i * G + c; if (L >= nwg) return false;
        int wgid = (int)L; { const int q = nwg / NXCD, r = nwg % NXCD, xcd = wgid % NXCD, off = wgid / NXCD; wgid = (xcd < r ? xcd * (q + 1) : r * (q + 1) + (xcd - r) * q) + off; }
        const int nig = wgm * nN, gid = wgid / nig, fm = gid * wgm, gsz = (nM - fm) < wgm ? (nM - fm) : wgm;
        pm = fm + ((wgid % nig) % gsz); pn = (wgid % nig) / gsz; return true;
    }
};

typedef int i32x4 __attribute__((ext_vector_type(4)));
typedef int i32x8 __attribute__((ext_vector_type(8)));
__device__ __forceinline__ i32x8 cat16(bf16x8 lo, bf16x8 hi) { const i32x4 a = __builtin_bit_cast(i32x4, lo), b = __builtin_bit_cast(i32x4, hi); return __builtin_shufflevector(a, b, 0, 1, 2, 3, 4, 5, 6, 7); }
template <class Epi, class Sched, bool ALIGN_EPI, bool FP8 = false>
__device__ __forceinline__ void gemm_phase(LAS unsigned char* lds, const unsigned lda2, const unsigned ldb2, const Sched& S, const Epi& E) {
    int tid = threadIdx.x; asm volatile("" : "+v"(tid));
    const int wid = __builtin_amdgcn_readfirstlane(tid >> 6), lane = tid & 63, wr = wid >> 2, wc = wid & 3, fr = lane & 15, fq = lane >> 4;
    unsigned voffA[2], voffB[2];
#pragma unroll
    for (int i = 0; i < 2; ++i) { int R, C; stage_rc(tid * 16 + i * 8192, R, C); const int Rb = (R & ~31) + perm32(R & 31);
        voffA[i] = (unsigned)R * lda2 + (unsigned)C * 2u; voffB[i] = (unsigned)Rb * ldb2 + (unsigned)C * 2u; }
    const size_t kstep = (size_t)(BK * 2);
    const size_t hA = (size_t)HALF * lda2, hB = (size_t)HALF * ldb2;
    const unsigned ldsw = (unsigned)wid * 1024u;
    const int aoff = lds_byte(wr * 64 + fr, fq * 8), boff = lds_byte(wc * 32 + fr, fq * 8);
#define PG8_SA(b, h) (((b) * 2 + (h)) * HTB)
#define PG8_SB(b, h) ((4 + (b) * 2 + (h)) * HTB)
#define PG8_STAGE(bufoff, gbase, voff) do { _Pragma("unroll") for (int _i = 0; _i < 2; ++_i) \
        __builtin_amdgcn_global_load_lds((const unsigned*)((const char*)(gbase) + (voff)[_i]), (LAS unsigned*)(lds + (bufoff) + ldsw + _i * 8192), 16, 0, 0); } while (0)
#define PG8_LDA(dst, b, h) do { _Pragma("unroll") for (int m = 0; m < 4; ++m) { if constexpr (FP8) dst##8[m] = cat16(*(const LAS bf16x8*)(lds + PG8_SA(b, h) + aoff + m * 2048), *(const LAS bf16x8*)(lds + PG8_SA(b, h) + aoff + m * 2048 + 1024)); \
        else { _Pragma("unroll") for (int k = 0; k < 2; ++k) dst[m][k] = *(const LAS bf16x8*)(lds + PG8_SA(b, h) + aoff + m * 2048 + k * 1024); } } } while (0)
#define PG8_LDB(dst, b, h) do { _Pragma("unroll") for (int n = 0; n < 2; ++n) { if constexpr (FP8) dst##8[n] = cat16(*(const LAS bf16x8*)(lds + PG8_SB(b, h) + boff + n * 2048), *(const LAS bf16x8*)(lds + PG8_SB(b, h) + boff + n * 2048 + 1024)); \
        else { _Pragma("unroll") for (int k = 0; k < 2; ++k) dst[n][k] = *(const LAS bf16x8*)(lds + PG8_SB(b, h) + boff + n * 2048 + k * 1024); } } } while (0)
#define PG8_MMA(ai, bj, At, Bt) do { __builtin_amdgcn_s_setprio(1); \
        if constexpr (FP8) { _Pragma("unroll") for (int m = 0; m < 4; ++m) _Pragma("unroll") for (int n = 0; n < 2; ++n) \
            asm volatile("v_mfma_scale_f32_16x16x128_f8f6f4 %0, %1, %2, %0, %3, %3 op_sel_hi:[0,0,0]" : "+v"(acc[ai][bj][m][n]) : "v"(Bt##8[n]), "v"(At##8[m]), "v"(sc8)); \
            }   \
        else { _Pragma("unroll") for (int m = 0; m < 4; ++m) _Pragma("unroll") for (int n = 0; n < 2; ++n) _Pragma("unroll") for (int k = 0; k < 2; ++k) \
            acc[ai][bj][m][n] = __builtin_amdgcn_mfma_f32_16x16x32_bf16(Bt[n][k], At[m][k], acc[ai][bj][m][n], 0, 0, 0); } \
        __builtin_amdgcn_s_setprio(0); } while (0)
#define PG8_WAIT_V(n) asm volatile("s_waitcnt vmcnt(" #n ")" ::: "memory")
#define PG8_WAIT_L(n) asm volatile("s_waitcnt lgkmcnt(" #n ")" ::: "memory")
#define PG8_BAR __builtin_amdgcn_s_barrier()
#define PG8_SCHED __builtin_amdgcn_sched_barrier(0)
    Unit cur, nxt; int ui = 0;
    if (!S.next(0, cur)) return;
    f32x4 acc[2][2][4][2];
    PG8_ZERO(acc);
    bf16x8 At[4][2], B0[2][2], B1[2][2]; i32x8 At8[4], B08[2], B18[2];
    int sc8 = 0x7f7f7f7f; asm volatile("" : "+v"(sc8));
    const char* cA = cur.A; const char* cB = cur.B;
    PG8_STAGE(PG8_SB(0, 0), cB, voffB); PG8_STAGE(PG8_SB(0, 1), cB + hB, voffB); PG8_STAGE(PG8_SA(0, 0), cA, voffA); PG8_STAGE(PG8_SA(0, 1), cA + hA, voffA);
    if (wr == 1) PG8_BAR;
    PG8_WAIT_V(2); PG8_BAR;
    PG8_STAGE(PG8_SB(1, 0), cB + kstep, voffB); PG8_STAGE(PG8_SA(1, 0), cA + kstep, voffA); PG8_STAGE(PG8_SB(1, 1), cB + hB + kstep, voffB);
    PG8_WAIT_V(6); PG8_BAR;
    for (;;) {
        const bool has_next = S.next(ui + 1, nxt);
        const char* nA = has_next ? nxt.A : cA; const char* nB = has_next ? nxt.B : cB;
        const int nt = cur.nt;
#pragma unroll 1
        for (int t = 0; t < nt; t += 2) {
            const bool last = (t == nt - 2);
            const char* a1 = cA + (size_t)(t + 1) * kstep;
            const char* a2 = last ? nA : cA + (size_t)(t + 2) * kstep; const char* b2 = last ? nB : cB + (size_t)(t + 2) * kstep;
            const char* a3 = a2 + kstep; const char* b3 = b2 + kstep;
            PG8_LDB(B0, 0, 0); PG8_LDB(B1, 0, 1); PG8_SCHED; PG8_LDA(At, 0, 0); PG8_STAGE(PG8_SA(1, 1), a1 + hA, voffA);
            PG8_WAIT_V(8); PG8_WAIT_L(0); PG8_BAR; PG8_MMA(0, 0, At, B0); PG8_MMA(0, 1, At, B1); PG8_BAR; PG8_SCHED;
            PG8_LDA(At, 0, 1); PG8_STAGE(PG8_SB(0, 0), b2, voffB); PG8_STAGE(PG8_SB(0, 1), b2 + hB, voffB); PG8_STAGE(PG8_SA(0, 0), a2, voffA);
            PG8_WAIT_V(8); PG8_WAIT_L(0); PG8_BAR; PG8_MMA(1, 0, At, B0); PG8_MMA(1, 1, At, B1); PG8_BAR; PG8_SCHED;
            PG8_LDB(B0, 1, 0); PG8_LDB(B1, 1, 1); PG8_SCHED; PG8_LDA(At, 1, 0); PG8_STAGE(PG8_SA(0, 1), a2 + hA, voffA);
            PG8_WAIT_V(8); PG8_WAIT_L(0); PG8_BAR; PG8_MMA(0, 0, At, B0); PG8_MMA(0, 1, At, B1); PG8_BAR; PG8_SCHED;
            PG8_LDA(At, 1, 1); PG8_STAGE(PG8_SB(1, 0), b3, voffB); PG8_STAGE(PG8_SB(1, 1), b3 + hB, voffB); PG8_STAGE(PG8_SA(1, 0), a3, voffA);
            PG8_WAIT_V(8); PG8_WAIT_L(0); PG8_BAR; PG8_MMA(1, 0, At, B0); PG8_MMA(1, 1, At, B1); PG8_BAR; PG8_SCHED;
        }
        if constexpr (ALIGN_EPI) { if (wr == 0) PG8_BAR; }
        if constexpr (FP8) asm volatile("s_nop 15\n\ts_nop 7" ::: "memory");
        E(acc, cur, wr, wc, fr, fq);
        if (!has_next) break;
        cur = nxt; cA = nA; cB = nB; ++ui;
        if constexpr (ALIGN_EPI) { if (wr == 1) PG8_BAR; }
    }
    PG8_WAIT_V(0);
    if constexpr (!ALIGN_EPI) { if (wr == 0) PG8_BAR; }
    PG8_BAR;
#undef PG8_SA
#undef PG8_SB
#undef PG8_STAGE
#undef PG8_LDA
#undef PG8_LDB
#undef PG8_MMA
#undef PG8_WAIT_V
#undef PG8_WAIT_L
#undef PG8_BAR
#undef PG8_SCHED
}
}

#define XB_TMO      128
#define XB_XCNT(j)  (256  + 64 * (j))
#define XB_XSUB(j)  (1280 + 64 * (j))
#define XB_XGEN(j)  (2304 + 64 * (j))
#define XB_TOP      3328
#define XB_TOPGEN   3392
#define XCD_BAR_WORDS 3456
#define XB_SPIN_CAP (1u << 18)
__device__ __forceinline__ unsigned xb_ld(unsigned* p)              { return __hip_atomic_load(p, __ATOMIC_RELAXED, __HIP_MEMORY_SCOPE_AGENT); }
__device__ __forceinline__ unsigned xb_add(unsigned* p, unsigned v) { return __hip_atomic_fetch_add(p, v, __ATOMIC_RELAXED, __HIP_MEMORY_SCOPE_AGENT); }
__device__ __forceinline__ unsigned xb_xcc_id() { return (unsigned)__builtin_amdgcn_s_getreg((3 << 11) | 20) & 0xFu; }
#define XB_SPIN(cond, bar) do { unsigned _sp = 0; while (cond) { __builtin_amdgcn_s_sleep(1); \
    if ((++_sp & 255u) == 0u) { if (xb_ld(&(bar)[XB_TMO])) break; if (_sp > XB_SPIN_CAP) { atomicAdd(&(bar)[XB_TMO], 1u); break; } } } } while (0)
struct XcdBarrier { unsigned* bar; unsigned x; volatile LAS unsigned* st; unsigned G; };
__device__ __forceinline__ XcdBarrier xcd_barrier_post(unsigned* bar, volatile LAS unsigned* st, unsigned G) {
    XcdBarrier b; b.bar = bar; b.x = xb_xcc_id(); b.st = st; b.G = G;
    if (threadIdx.x == 0) (void)xb_add(&bar[XB_XCNT(b.x)], 1u);
    return b;
}
__device__ __forceinline__ void xcd_barrier_complete(unsigned* bar, unsigned x, unsigned G, unsigned& nloc, unsigned& nx) {
    unsigned sum, cnt, mine, sp = 0u;
    for (;;) {
        sum = 0u; cnt = 0u; mine = 0u;
#pragma unroll
        for (unsigned j = 0; j < 16; ++j) { const unsigned c = xb_ld(&bar[XB_XCNT(j)]); sum += c; cnt += (c > 0u) ? 1u : 0u; mine = (j == x) ? c : mine; }
        if (sum == G) break;
        __builtin_amdgcn_s_sleep(1);
        if ((++sp & 255u) == 0u) { if (xb_ld(&bar[XB_TMO])) break; if (sp > XB_SPIN_CAP) { atomicAdd(&bar[XB_TMO], 1u); break; } }
    }
    nloc = mine > 0u ? mine : 1u; nx = cnt > 0u ? cnt : 1u;
}
__device__ __forceinline__ void xcd_barrier(const XcdBarrier& b, unsigned* wait_word = nullptr, unsigned wait_target = 0u, unsigned* prog_word = nullptr, bool local_ok = false) {
    asm volatile("s_waitcnt vmcnt(0)" ::: "memory");
    __syncthreads();
    if (threadIdx.x == 0) {
        unsigned* bar = b.bar;
        __builtin_amdgcn_s_waitcnt(0);
        asm volatile("buffer_inv sc1" ::: "memory");
        unsigned nloc = b.st[0], nx = b.st[1];
        if (nloc == 0u) { xcd_barrier_complete(bar, b.x, b.G, nloc, nx); b.st[0] = nloc; b.st[1] = nx; }
        const unsigned old = xb_add(&bar[XB_XSUB(b.x)], 1u);
        const unsigned gen = old / nloc;
        if (old + 1u == (gen + 1u) * nloc) {
            if (!(local_ok && nx == 1u)) { __builtin_amdgcn_fence(__ATOMIC_RELEASE, "agent"); asm volatile("s_waitcnt vmcnt(0)" ::: "memory"); }
            (void)xb_add(&bar[XB_TOP], 1u);
        }
        const unsigned tgt = (gen + 1u) * nx;
        if (wait_word) XB_SPIN(xb_ld(wait_word) < wait_target, bar);
        XB_SPIN(xb_ld(&bar[XB_TOP]) < tgt, bar);
        if (prog_word) (void)xb_add(prog_word, 1u);
        asm volatile("s_waitcnt vmcnt(0)" ::: "memory");
    }
    __syncthreads();
}

struct Args { const float* in[16]; float* out; unsigned char* ws; int ph_lo, ph_hi; };

__device__ __forceinline__ float wave_sum(float v) {
#pragma unroll
    for (int o = 1; o < 64; o <<= 1) v += __shfl_xor(v, o);
    return v;
}

__device__ __forceinline__ void p0_transpose_item(const float* W, int ldw, int k0, int n0, const float* gs, bf16_t* dst, int ldd, LAS float* scr, int lane) {
    float v[32];
    const float* wp = W + (size_t)(k0 + (lane >> 5)) * ldw + n0 + (lane & 31);
#pragma unroll
    for (int i = 0; i < 32; ++i) v[i] = __builtin_nontemporal_load(wp + (size_t)(2 * i) * ldw);
    if (gs) {
#pragma unroll
        for (int i = 0; i < 32; ++i) v[i] *= gs[k0 + 2 * i + (lane >> 5)]; }
#pragma unroll
    for (int i = 0; i < 32; ++i) scr[(2 * i + (lane >> 5)) * 33 + (lane & 31)] = v[i];
    LDS_WAIT(); asm volatile("" ::: "memory");
    const int c = lane & 7;
#pragma unroll
    for (int j = 0; j < 4; ++j) { const int n = (lane >> 3) + 8 * j; const LAS float* s = scr + (8 * c) * 33 + n;
        u32x4 o; o.x = cvt_pk_bf16(s[0 * 33], s[1 * 33]); o.y = cvt_pk_bf16(s[2 * 33], s[3 * 33]); o.z = cvt_pk_bf16(s[4 * 33], s[5 * 33]); o.w = cvt_pk_bf16(s[6 * 33], s[7 * 33]);
        *(u32x4*)(dst + (size_t)n * ldd + 8 * c) = o; }
    LDS_WAIT(); asm volatile("" ::: "memory");
}

__device__ __forceinline__ void p0_transpose_item_fp8(const float* W, int ldw, int k0, int n0, const float* gs, float sc, unsigned char* dst, int ldd, LAS float* scr, int lane) {
    float v[32];
    const float* wp = W + (size_t)(k0 + (lane >> 5)) * ldw + n0 + (lane & 31);
#pragma unroll
    for (int i = 0; i < 32; ++i) v[i] = __builtin_nontemporal_load(wp + (size_t)(2 * i) * ldw);
#pragma unroll
    for (int i = 0; i < 32; ++i) v[i] *= gs[k0 + 2 * i + (lane >> 5)] * sc;
#pragma unroll
    for (int i = 0; i < 32; ++i) scr[(2 * i + (lane >> 5)) * 33 + (lane & 31)] = v[i];
    LDS_WAIT(); asm volatile("" ::: "memory");
    const int n = lane >> 1, h = lane & 1; const LAS float* s = scr + (32 * h) * 33 + n;
    u32x4 o0, o1;
#pragma unroll
    for (int q = 0; q < 4; ++q) { o0[q] = pk4_fp8(s[(4 * q) * 33], s[(4 * q + 1) * 33], s[(4 * q + 2) * 33], s[(4 * q + 3) * 33]);
                                  o1[q] = pk4_fp8(s[(16 + 4 * q) * 33], s[(17 + 4 * q) * 33], s[(18 + 4 * q) * 33], s[(19 + 4 * q) * 33]); }
    unsigned char* d = dst + (size_t)n * ldd + 32 * h;
    *(u32x4*)d = o0; *(u32x4*)(d + 16) = o1;
    LDS_WAIT(); asm volatile("" ::: "memory");
}

__device__ __forceinline__ void p0_prologue(const Args& a, LAS unsigned char* lds, int gw, int NGW, int wave, int lane) {
    unsigned char* ws = a.ws;
    LAS float* scr = (LAS float*)(lds + wave * WAVE_LDS);
    constexpr int I_IN = (D / 64) * (IN_TOTAL / 32);
    constexpr int I_P = (512 / 64) * (D / 32);
    constexpr int I_O = (D / 64) * (D / 32);
    constexpr int I_LAYER = I_IN + 3 * I_P + I_O;
    { bf16_t* P = (bf16_t*)(ws + WS_P); float* rss = (float*)(ws + WS_RSS);
      for (int m4 = gw * 4; m4 < M; m4 += NGW * 4) {
          f32x4 v[4][4];
#pragma unroll
          for (int r = 0; r < 4; ++r) { const f32x4* xr = (const f32x4*)(a.in[0] + (size_t)(m4 + r) * D) + 2 * lane;
#pragma unroll
              for (int j = 0; j < 2; ++j) { v[r][2 * j] = __builtin_nontemporal_load(xr + 128 * j); v[r][2 * j + 1] = __builtin_nontemporal_load(xr + 128 * j + 1); } }
#pragma unroll
          for (int r = 0; r < 4; ++r) { float s = 0.f;
#pragma unroll
              for (int j = 0; j < 4; ++j) s += (v[r][j].x * v[r][j].x + v[r][j].y * v[r][j].y) + (v[r][j].z * v[r][j].z + v[r][j].w * v[r][j].w);
              s = wave_sum(s);
              u32x4* o = (u32x4*)(P + (size_t)(m4 + r) * PITCH + XB_COL) + lane;
              u32x2* o8 = (u32x2*)(ws + WS_XB8 + (size_t)(m4 + r) * D) + lane;
#pragma unroll
              for (int j = 0; j < 2; ++j) { const f32x4 p = v[r][2 * j], q = v[r][2 * j + 1];
                  u32x4 w; w.x = cvt_pk_bf16(p.x, p.y); w.y = cvt_pk_bf16(p.z, p.w); w.z = cvt_pk_bf16(q.x, q.y); w.w = cvt_pk_bf16(q.z, q.w); o[64 * j] = w;
                  o8[64 * j] = (u32x2){pk4_fp8(p.x, p.y, p.z, p.w), pk4_fp8(q.x, q.y, q.z, q.w)}; }
              if (lane < 16) rss[(size_t)(m4 + r) * 16 + lane] = (lane == 0) ? s : 0.f; }
      } }
    for (int it = gw; it < DEPTH * I_LAYER; it += NGW) {
        const int l = it / I_LAYER; int r = it % I_LAYER;
        bf16_t* Wmix = (bf16_t*)(ws + WS_WMIX) + (size_t)l * NMIX * D;
        bf16_t* W3 = (bf16_t*)(ws + WS_W3) + (size_t)l * D * K3;
        bf16_t* WoT = (bf16_t*)(ws + WS_WO) + (size_t)l * D * D;
        if (r < I_IN) {
            const int kb = r / (IN_TOTAL / 32), nb = r % (IN_TOTAL / 32), k0 = 64 * kb, n0 = 32 * nb, seg = n0 / 512;
            const float* W = a.in[2] + (size_t)l * D * IN_TOTAL; const float* gs = a.in[1] + l * D;
            if (seg < 9) { const int dseg = (seg == 0) ? 0 : (seg == 1) ? 3 : (seg == 2) ? 4 : (seg == 3) ? 5 : (seg == 4) ? 6 : (seg == 5) ? 7 : (seg == 6) ? 1 : (seg == 7) ? 8 : 2;
                p0_transpose_item(W, IN_TOTAL, k0, n0, gs, Wmix + (size_t)(dseg * 512 + (n0 & 511)) * D + k0, D, scr, lane); }
            else { const int nn = n0 - NMIX;
                p0_transpose_item_fp8(W, IN_TOTAL, k0, n0, gs, WG8_SCALE, ws + WS_WG8 + (size_t)l * 3 * D * D + (size_t)nn * D + k0, D, scr, lane); }
            continue; }
        r -= I_IN;
        if (r < 3 * I_P) { const int br = r / I_P, q = r % I_P, kb = q / (D / 32), nb = q % (D / 32), k0 = 64 * kb, n0 = 32 * nb;
            const float* W = a.in[11 + br] + (size_t)l * 512 * D;
            p0_transpose_item(W, D, k0, n0, nullptr, W3 + (size_t)n0 * K3 + br * 512 + k0, K3, scr, lane); continue; }
        r -= 3 * I_P;
        { const int kb = r / (D / 32), nb = r % (D / 32), k0 = 64 * kb, n0 = 32 * nb;
          const float* W = a.in[14] + (size_t)l * D * D;
          p0_transpose_item(W, D, k0, n0, nullptr, WoT + (size_t)n0 * D + k0, D, scr, lane); }
    }
    { bf16_t* Wm = (bf16_t*)(ws + WS_WM); const float* w_s = a.in[5];
      for (int i = gw * 64 + lane; i < DEPTH * 8 * 128 * 128 / 2; i += NGW * 64) { const int e = 2 * i, s = e & 127, t = (e >> 7) & 127;
          const f32x2 v = *(const f32x2*)(w_s + e); ((unsigned*)Wm)[i] = cvt_pk_bf16(s <= t ? v.x : 0.f, s + 1 <= t ? v.y : 0.f); } }
    { bf16_t* Wp = (bf16_t*)(ws + WS_WPOOL); const float* w_pool = a.in[9]; const float* ps = a.in[10];
      for (int i = gw * 64 + lane; i < DEPTH * 4 * 128 * 128 / 2; i += NGW * 64) { const int e = 2 * i, c = e & 127, d = (e >> 7) & 127, lg = e >> 14;
          const float sc = ps[lg * 128 + d];
          ((unsigned*)Wp)[i] = cvt_pk_bf16(w_pool[(size_t)lg * 16384 + c * 128 + d] * sc, w_pool[(size_t)lg * 16384 + (c + 1) * 128 + d] * sc); } }
}

__device__ __forceinline__ float row_rstd(const float* rss, int row, int fq) {
    const f32x4 p = *(const f32x4*)(rss + (size_t)row * 16 + fq * 4);
    float s = (p.x + p.y) + (p.z + p.w); s += __shfl_xor(s, 16); s += __shfl_xor(s, 32);
    return __builtin_amdgcn_rsqf(s * (1.0f / D) + RMS_EPS);
}
__device__ __forceinline__ float rstd_of(f32x4 p) { float s = (p.x + p.y) + (p.z + p.w); s += __shfl_xor(s, 16); s += __shfl_xor(s, 32); return __builtin_amdgcn_rsqf(s * (1.0f / D) + RMS_EPS); }
#define ZERO_ACC(acc) do { bf16x8 z_ = (bf16x8){0, 0, 0, 0, 0, 0, 0, 0}; asm volatile("" : "+v"(z_)); _Pragma("unroll") for (int _a = 0; _a < 2; ++_a) _Pragma("unroll") for (int _b = 0; _b < 2; ++_b) _Pragma("unroll") for (int _m = 0; _m < 4; ++_m) _Pragma("unroll") for (int _n = 0; _n < 2; ++_n) { asm volatile("" : "+v"(z_)); acc[_a][_b][_m][_n] = __builtin_amdgcn_mfma_f32_16x16x32_bf16(z_, z_, (f32x4){0.f, 0.f, 0.f, 0.f}, 0, 0, 0); } } while (0)

struct SchedP1 {
    pg8::TileOrder T; const char* P; const char* W;
    __device__ __forceinline__ bool next(int i, pg8::Unit& u) const { int pm, pn; if (!T.tile(i, pm, pn)) return false;
        u.pm = pm; u.pn = pn; u.kind = pn >> 1; u.nt = D / 64; u.A = P + ((size_t)pm * 256 * PITCH + XB_COL) * 2; u.B = W + (size_t)pn * 256 * D * 2; return true; }
};
struct EpiP1 {
    bf16_t* P; const float* rss; float* lns;
    __device__ __forceinline__ void operator()(f32x4 (&acc)[2][2][4][2], const pg8::Unit& u, int wr, int wc, int fr, int fq) const {
        const int seg = u.kind;
        const int act = (seg == 3) ? 1 : 0;
        unsigned lrow = (unsigned)(wr * 64 + fr); asm volatile("" : "+v"(lrow));
        const unsigned lp = (lrow * PITCH + (unsigned)(wc * 32) + 8u * (unsigned)fq) * 2u;
        const unsigned lr = lrow * 64u;
        const size_t up = (size_t)u.pm * 256 * PITCH + (size_t)u.pn * 256;
        const size_t ur = (size_t)u.pm * 256 * 16;
        f32x4 pr[2][4];
#pragma unroll
        for (int ai = 0; ai < 2; ++ai)
#pragma unroll
            for (int m = 0; m < 4; ++m) pr[ai][m] = *(const f32x4*)((const char*)(rss + ur + (ai * 128 + m * 16) * 16) + (lr + 16u * fq));
#pragma unroll
        for (int ai = 0; ai < 2; ++ai)
#pragma unroll
            for (int m = 0; m < 4; ++m) {
                const float rs = rstd_of(pr[ai][m]);
                float s1 = 0.f, s2 = 0.f;
#pragma unroll
                for (int bj = 0; bj < 2; ++bj) {
                    f32x4 v0 = acc[ai][bj][m][0] * rs, v1 = acc[ai][bj][m][1] * rs;
                    if (act == 1) {
#pragma unroll
                        for (int j = 0; j < 2; ++j) { const f32x2 g0 = gelu2((f32x2){v0[2 * j], v0[2 * j + 1]}), g1 = gelu2((f32x2){v1[2 * j], v1[2 * j + 1]});
                            v0[2 * j] = g0.x; v0[2 * j + 1] = g0.y; v1[2 * j] = g1.x; v1[2 * j + 1] = g1.y; } }
                    u32x4 w; w.x = cvt_pk_bf16(v0[0], v0[1]); w.y = cvt_pk_bf16(v0[2], v0[3]); w.z = cvt_pk_bf16(v1[0], v1[1]); w.w = cvt_pk_bf16(v1[2], v1[3]);
                    *(u32x4*)((char*)(P + up + (size_t)(ai * 128 + m * 16) * PITCH + bj * 128) + lp) = w;
                    if (seg == 3) {
#pragma unroll
                        for (int q = 0; q < 4; ++q) { const float lo = bf_lo(w[q]), hi = bf_hi(w[q]); s1 += lo + hi; s2 += lo * lo + hi * hi; } }
                }
                if (seg == 3) { s1 += __shfl_xor(s1, 16); s1 += __shfl_xor(s1, 32); s2 += __shfl_xor(s2, 16); s2 += __shfl_xor(s2, 32);
                    if (fq == 0) *(f32x2*)((char*)(lns + ur + (ai * 128 + m * 16) * 16 + ((u.pn - 6) * 4 + wc) * 2) + lr) = (f32x2){s1, s2}; }
            }
        ZERO_ACC(acc);
    }
};

struct SchedG {
    int x, r, n, c0, sq; const char* A8; const char* W8;
    __device__ __forceinline__ bool next(int i, pg8::Unit& u) const { if (i >= n) return false;
        int combo, pl;
        if (i < sq) { pl = 4 * i + (r & 3); combo = c0 + (r >> 2); } else { pl = r & 7; combo = c0 + (sq ? 4 : 0) + 2 * (i - sq) + (r >> 3); }
        const int gate = combo >> 2;
        u.pm = 8 * x + pl; u.pn = combo & 3; u.kind = gate; u.nt = D / 128;
        u.A = A8 + (size_t)u.pm * 256 * D; u.B = W8 + ((size_t)gate * D + (size_t)u.pn * 256) * D; return true; }
};
struct EpiP3G {
    unsigned char* S8; size_t gstride; unsigned rowb; const float* rss;
    __device__ __forceinline__ void operator()(f32x4 (&acc)[2][2][4][2], const pg8::Unit& u, int wr, int wc, int fr, int fq) const {
        unsigned lrow = (unsigned)(wr * 64 + fr); asm volatile("" : "+v"(lrow));
        const unsigned ls = lrow * rowb + (unsigned)(wc * 32) + 8u * (unsigned)fq;
        const unsigned lr = lrow * 64u;
        unsigned char* sb = S8 + (size_t)(u.pm >> 3) * GATE_GROUP_BYTES + (size_t)u.kind * gstride + (size_t)((u.pm & 7) * 4 + u.pn) * 65536 + (size_t)((wr * 4 + wc) * 8192);
        const unsigned lt = ((unsigned)fq * 16u + (unsigned)fr) * 8u;
        const size_t ur = (size_t)u.pm * 256 * 16;
        f32x4 pr[2][4];
#pragma unroll
        for (int ai = 0; ai < 2; ++ai)
#pragma unroll
            for (int m = 0; m < 4; ++m) pr[ai][m] = *(const f32x4*)((const char*)(rss + ur + (ai * 128 + m * 16) * 16) + (lr + 16u * fq));
#pragma unroll
        for (int ai = 0; ai < 2; ++ai)
#pragma unroll
            for (int m = 0; m < 4; ++m) {
                const float rs = rstd_of(pr[ai][m]) * (-1.4426950409f / WG8_SCALE);
#pragma unroll
                for (int bj = 0; bj < 2; ++bj) { const f32x4 v0 = acc[ai][bj][m][0] * rs, v1 = acc[ai][bj][m][1] * rs;
                    unsigned w0 = 0u, w1 = 0u;
#pragma unroll
                    for (int j = 0; j < 4; ++j) { w0 = __builtin_amdgcn_cvt_pk_u8_f32(__builtin_amdgcn_rcpf(__builtin_fmaf(__builtin_amdgcn_exp2f(v0[j]), 1.0f / 255.0f, 1.0f / 255.0f)), j, w0);
                                                  w1 = __builtin_amdgcn_cvt_pk_u8_f32(__builtin_amdgcn_rcpf(__builtin_fmaf(__builtin_amdgcn_exp2f(v1[j]), 1.0f / 255.0f, 1.0f / 255.0f)), j, w1); }
                    w0 |= (((w0 - 0x01010101u) & ~w0) >> 7) & 0x01010101u; w1 |= (((w1 - 0x01010101u) & ~w1) >> 7) & 0x01010101u;
                    *(u32x2*)(sb + (size_t)(((ai * 4 + m) * 2 + bj) * 512) + lt) = (u32x2){w0, w1}; }
            }
        ZERO_ACC(acc);
    }
};
struct SchedP3Y {
    int pm, pn; const char* P; const char* W;
    __device__ __forceinline__ bool next(int i, pg8::Unit& u) const { if (i >= 3) return false;
        u.pm = pm; u.pn = pn; u.kind = i; u.nt = 512 / 64;
        u.A = P + ((size_t)pm * 256 * PITCH + (size_t)i * 512) * 2; u.B = W + ((size_t)pn * 256 * K3 + (size_t)i * 512) * 2; return true; }
};
struct EpiP3Y {
    bf16_t* P; const unsigned char* S8; size_t gstride; unsigned rowb;
    __device__ __forceinline__ void operator()(f32x4 (&acc)[2][2][4][2], const pg8::Unit& u, int wr, int wc, int fr, int fq) const {
        const int j = u.kind; const bool fin = (j == 2);
        unsigned lrow = (unsigned)(wr * 64 + fr); asm volatile("" : "+v"(lrow));
        const unsigned ls = lrow * rowb + (unsigned)(wc * 32) + 8u * (unsigned)fq;
        const unsigned lp = (lrow * PITCH + (unsigned)(wc * 32) + 8u * (unsigned)fq) * 2u;
        const unsigned char* sb = S8 + (size_t)(u.pm >> 3) * GATE_GROUP_BYTES + (size_t)((u.pm & 7) * 4 + u.pn) * 65536 + (size_t)((wr * 4 + wc) * 8192);
        const unsigned lt = ((unsigned)fq * 16u + (unsigned)fr) * 8u;
        const unsigned char* pn_ = sb + (size_t)j * gstride; const unsigned char* pd_ = sb + (size_t)(fin ? 2 : j + 1) * gstride;
        bf16_t* pmg = P + (size_t)u.pm * 256 * PITCH + C_MERGED + (size_t)u.pn * 256;
        u32x2 sn[2][4][2], sd[2][4][2];
#pragma unroll
        for (int ai = 0; ai < 2; ++ai)
#pragma unroll
            for (int m = 0; m < 4; ++m)
#pragma unroll
                for (int bj = 0; bj < 2; ++bj) { const size_t ro = (size_t)(((ai * 4 + m) * 2 + bj) * 512);
                    sn[ai][m][bj] = *(const u32x2*)(pn_ + ro + lt); sd[ai][m][bj] = fin ? (u32x2){0xffffffffu, 0xffffffffu} : *(const u32x2*)(pd_ + ro + lt); }
#pragma unroll
        for (int ai = 0; ai < 2; ++ai)
#pragma unroll
            for (int m = 0; m < 4; ++m)
#pragma unroll
                for (int bj = 0; bj < 2; ++bj) asm volatile("" : "+v"(sn[ai][m][bj]), "+v"(sd[ai][m][bj]));
#pragma unroll
        for (int ai = 0; ai < 2; ++ai)
#pragma unroll
            for (int m = 0; m < 4; ++m)
#pragma unroll
                for (int bj = 0; bj < 2; ++bj) {
#pragma unroll
                    for (int n = 0; n < 2; ++n) { const unsigned sdw = fin ? 0xffffffffu : sd[ai][m][bj][n];
#pragma unroll
                        for (int e = 0; e < 4; ++e) { const float qn = (float)((sn[ai][m][bj][n] >> (8 * e)) & 0xffu), qd = (float)((sdw >> (8 * e)) & 0xffu);
                            acc[ai][bj][m][n][e] *= qn * __builtin_amdgcn_rcpf(qd); } }
                    if (fin) { const f32x4 v0 = acc[ai][bj][m][0], v1 = acc[ai][bj][m][1];
                        u32x4 w; w.x = cvt_pk_bf16(v0[0], v0[1]); w.y = cvt_pk_bf16(v0[2], v0[3]); w.z = cvt_pk_bf16(v1[0], v1[1]); w.w = cvt_pk_bf16(v1[2], v1[3]);
                        *(u32x4*)((char*)(pmg + (size_t)(ai * 128 + m * 16) * PITCH + bj * 128) + lp) = w; } }
    }
};

struct SchedP4 {
    pg8::TileOrder T; const char* P; const char* W;
    __device__ __forceinline__ bool next(int i, pg8::Unit& u) const { int pm, pn; if (!T.tile(i, pm, pn)) return false;
        u.pm = pm; u.pn = pn; u.kind = 0; u.nt = D / 64; u.A = P + ((size_t)pm * 256 * PITCH + C_MERGED) * 2; u.B = W + (size_t)pn * 256 * D * 2; return true; }
};
struct EpiP4 {
    bf16_t* P; float* rss_out; unsigned char* xb8;
    __device__ __forceinline__ void operator()(f32x4 (&acc)[2][2][4][2], const pg8::Unit& u, int wr, int wc, int fr, int fq) const {
        unsigned lrow = (unsigned)(wr * 64 + fr); asm volatile("" : "+v"(lrow));
        const unsigned lc = (unsigned)(wc * 32) + 8u * (unsigned)fq;
        const unsigned lp = (lrow * PITCH + lc) * 2u, lx = (lrow * D + lc) * 4u, l8 = lrow * D + lc;
        const size_t ux = (size_t)u.pm * 256 * D + (size_t)u.pn * 256;
        bf16_t* pb = P + (size_t)u.pm * 256 * PITCH + (size_t)u.pn * 256 + XB_COL;
        float* rb = rss_out + (size_t)u.pm * 256 * 16 + u.pn * 4 + wc;
#pragma unroll
        for (int ai = 0; ai < 2; ++ai)
#pragma unroll
        for (int mh = 0; mh < 2; ++mh) {
            u32x4 hv[2][2];
#pragma unroll
            for (int mm = 0; mm < 2; ++mm)
#pragma unroll
                for (int bj = 0; bj < 2; ++bj) hv[mm][bj] = *(const u32x4*)((const char*)(pb + (size_t)(ai * 128 + (mh * 2 + mm) * 16) * PITCH + bj * 128) + lp);
#pragma unroll
            for (int mm = 0; mm < 2; ++mm) {
                const int m = mh * 2 + mm; float ss = 0.f;
#pragma unroll
                for (int bj = 0; bj < 2; ++bj) { const size_t ro = (size_t)(ai * 128 + m * 16) * D + bj * 128;
                    const f32x4 v0 = (f32x4){bf_lo(hv[mm][bj].x), bf_hi(hv[mm][bj].x), bf_lo(hv[mm][bj].y), bf_hi(hv[mm][bj].y)} + acc[ai][bj][m][0], v1 = (f32x4){bf_lo(hv[mm][bj].z), bf_hi(hv[mm][bj].z), bf_lo(hv[mm][bj].w), bf_hi(hv[mm][bj].w)} + acc[ai][bj][m][1];
                    ss += (v0[0] * v0[0] + v0[1] * v0[1]) + (v0[2] * v0[2] + v0[3] * v0[3]) + (v1[0] * v1[0] + v1[1] * v1[1]) + (v1[2] * v1[2] + v1[3] * v1[3]);
                    u32x4 w; w.x = cvt_pk_bf16(v0[0], v0[1]); w.y = cvt_pk_bf16(v0[2], v0[3]); w.z = cvt_pk_bf16(v1[0], v1[1]); w.w = cvt_pk_bf16(v1[2], v1[3]);
                    *(u32x4*)((char*)(pb + (size_t)(ai * 128 + m * 16) * PITCH + bj * 128) + lp) = w;
                    *(u32x2*)((xb8 + ux + ro) + l8) = (u32x2){pk4_fp8(v0[0], v0[1], v0[2], v0[3]), pk4_fp8(v1[0], v1[1], v1[2], v1[3])};
 }
                ss += __shfl_xor(ss, 16); ss += __shfl_xor(ss, 32);
                if (fq == 0) *(float*)((char*)(rb + (ai * 128 + m * 16) * 16) + lrow * 64u) = ss;
            }
        }
    }
};

struct EpiP4F {

    const bf16_t* P; float* out; float* rss_out; const float* fg; unsigned* cnt; unsigned* tmo;
    __device__ __forceinline__ void operator()(f32x4 (&acc)[2][2][4][2], const pg8::Unit& u, int wr, int wc, int fr, int fq) const {
        unsigned lrow = (unsigned)(wr * 64 + fr); asm volatile("" : "+v"(lrow));
        const unsigned lc = (unsigned)(wc * 32) + 8u * (unsigned)fq;
        const unsigned lx = (lrow * D + lc) * 4u;
        const unsigned lp = (lrow * PITCH + lc) * 2u, l8 = lrow * D + lc;
        const bf16_t* pxb = P + (size_t)u.pm * 256 * PITCH + (size_t)u.pn * 256 + XB_COL;
        const size_t ux = (size_t)u.pm * 256 * D + (size_t)u.pn * 256;
        float* rb = rss_out + (size_t)u.pm * 256 * 16 + u.pn * 4 + wc;
#pragma unroll
        for (int ai = 0; ai < 2; ++ai)
#pragma unroll
        for (int mh = 0; mh < 2; ++mh) {
            f32x4 xo[2][2][2]; u32x4 hv[2][2];
#pragma unroll
            for (int mm = 0; mm < 2; ++mm)
#pragma unroll
                for (int bj = 0; bj < 2; ++bj) hv[mm][bj] = *(const u32x4*)((const char*)(pxb + (size_t)(ai * 128 + (mh * 2 + mm) * 16) * PITCH + bj * 128) + lp);
#pragma unroll
            for (int mm = 0; mm < 2; ++mm)
#pragma unroll
                for (int bj = 0; bj < 2; ++bj)
#pragma unroll
                    for (int n = 0; n < 2; ++n) xo[mm][bj][n] = (f32x4){bf_lo(hv[mm][bj][2 * n]), bf_hi(hv[mm][bj][2 * n]), bf_lo(hv[mm][bj][2 * n + 1]), bf_hi(hv[mm][bj][2 * n + 1])};
#pragma unroll
            for (int mm = 0; mm < 2; ++mm) {
                const int m = mh * 2 + mm; float ss = 0.f;
#pragma unroll
                for (int bj = 0; bj < 2; ++bj) { const f32x4 v0 = xo[mm][bj][0] + acc[ai][bj][m][0], v1 = xo[mm][bj][1] + acc[ai][bj][m][1];
                    acc[ai][bj][m][0] = v0; acc[ai][bj][m][1] = v1;
                    ss += (v0[0] * v0[0] + v0[1] * v0[1]) + (v0[2] * v0[2] + v0[3] * v0[3]) + (v1[0] * v1[0] + v1[1] * v1[1]) + (v1[2] * v1[2] + v1[3] * v1[3]); }
                ss += __shfl_xor(ss, 16); ss += __shfl_xor(ss, 32);
                if (fq == 0) __hip_atomic_store((float*)((char*)(rb + (ai * 128 + m * 16) * 16) + lrow * 64u), ss, __ATOMIC_RELAXED, __HIP_MEMORY_SCOPE_AGENT);
            }
        }
        asm volatile("s_waitcnt vmcnt(0)" ::: "memory");
        const int lane = (int)(threadIdx.x & 63); const int wid = wr * 4 + wc;
        unsigned* pc = cnt + 64 * u.pm;
        if (lane == 0) __hip_atomic_fetch_add(pc, 1u, __ATOMIC_RELAXED, __HIP_MEMORY_SCOPE_AGENT);
        if (wid == 0) {
            asm volatile("buffer_inv sc1" ::: "memory");
            unsigned sp = 0;
            while ((unsigned)__builtin_amdgcn_readfirstlane(__hip_atomic_load(pc, __ATOMIC_RELAXED, __HIP_MEMORY_SCOPE_AGENT)) < 32u) {
                __builtin_amdgcn_s_sleep(1);
                if ((++sp & 255u) == 0u) { if (__hip_atomic_load(tmo, __ATOMIC_RELAXED, __HIP_MEMORY_SCOPE_AGENT)) break; if (sp > (1u << 20)) { if (lane == 0) atomicAdd(tmo, 1u); break; } } }
            asm volatile("s_waitcnt vmcnt(0)" ::: "memory");
        }
        asm volatile("" ::: "memory"); __builtin_amdgcn_s_barrier(); asm volatile("" ::: "memory");
        const unsigned lr = lrow * 64u;
        const size_t ur = (size_t)u.pm * 256 * 16;
        f32x4 pr[2][4];
#pragma unroll
        for (int ai = 0; ai < 2; ++ai)
#pragma unroll
            for (int m = 0; m < 4; ++m) pr[ai][m] = *(const f32x4*)((const char*)(rss_out + ur + (ai * 128 + m * 16) * 16) + (lr + 16u * fq));
        f32x4 gv[2][2];
#pragma unroll
        for (int bj = 0; bj < 2; ++bj) { const float* gp = (const float*)((const char*)(fg + u.pn * 256 + bj * 128) + lc * 4u); gv[bj][0] = *(const f32x4*)gp; gv[bj][1] = *(const f32x4*)(gp + 4); }
#pragma unroll
        for (int ai = 0; ai < 2; ++ai)
#pragma unroll
            for (int m = 0; m < 4; ++m) { const float rs = rstd_of(pr[ai][m]);
#pragma unroll
                for (int bj = 0; bj < 2; ++bj) { float* xq = (float*)((char*)(out + ux + (size_t)(ai * 128 + m * 16) * D + bj * 128) + lx);
                    *(f32x4*)xq = acc[ai][bj][m][0] * rs * gv[bj][0]; *(f32x4*)(xq + 4) = acc[ai][bj][m][1] * rs * gv[bj][1]; } }
    }
};

#define LDG(T, uptr, lboff) (*(const T*)((const char*)(uptr) + (lboff)))
#define STG(T, uptr, lboff, val) (*(T*)((char*)(uptr) + (lboff)) = (val))
typedef short s16x4 __attribute__((ext_vector_type(4)));
__device__ __forceinline__ s16x4 lds_tr16(const LAS void* p) { return __builtin_amdgcn_ds_read_tr16_b64_v4i16((LAS s16x4*)p); }
template <int TH> __device__ __forceinline__ void mixer_a_body(bf16_t* P, const float* lns, const bf16_t* Wm, const float* ln_g, const float* ln_b, const float* b_s, LAS unsigned char* wl, int n, int g, int lane) {
    constexpr int SLEN = 64 * (TH + 1), NV = SLEN / 8, NKS = 2 * (TH + 1);
    const int T0 = n * 128;
    constexpr int VB = 136;
    constexpr int OB = 272;
    const int ck = lane & 7, rsub = lane >> 3;
    const int fr = lane & 15, fq = lane >> 4;
    const unsigned lv = (unsigned)(rsub * PITCH + ck * 8) * 2u;
    const unsigned lw = (unsigned)(fr * 128 + fq * 8) * 2u;
    const bf16_t* pv = P + (size_t)T0 * PITCH + C_V + g * 64;
    u32x4 raw[NV];
#pragma unroll
    for (int q = 0; q < NV; ++q) raw[q] = LDG(u32x4, pv + (size_t)(q * 8) * PITCH, lv);
    f32x4 st[TH + 1][4];
#pragma unroll
    for (int h = 0; h <= TH; ++h)
#pragma unroll
        for (int j = 0; j < 4; ++j) st[h][j] = LDG(f32x4, lns + (size_t)(T0 + 64 * h) * 16 + 4 * j, (unsigned)lane * 64u);
    float lg[8], lb[8];
    { const f32x4 g0 = LDG(f32x4, ln_g + g * 64, (unsigned)ck * 32u), g1 = LDG(f32x4, ln_g + g * 64 + 4, (unsigned)ck * 32u), b0 = LDG(f32x4, ln_b + g * 64, (unsigned)ck * 32u), b1 = LDG(f32x4, ln_b + g * 64 + 4, (unsigned)ck * 32u);
#pragma unroll
      for (int j = 0; j < 4; ++j) { lg[j] = g0[j]; lg[4 + j] = g1[j]; lb[j] = b0[j]; lb[4 + j] = b1[j]; } }
    float mean[TH + 1], rstd[TH + 1];
#pragma unroll
    for (int h = 0; h <= TH; ++h) { const f32x4 a = st[h][0], b = st[h][1], c = st[h][2], d = st[h][3];
        const float s1 = (a.x + a.z) + (b.x + b.z) + (c.x + c.z) + (d.x + d.z), s2 = (a.y + a.w) + (b.y + b.w) + (c.y + c.w) + (d.y + d.w);
        mean[h] = s1 * (1.f / 512.f); rstd[h] = __builtin_amdgcn_rsqf(fmaxf(s2 * (1.f / 512.f) - mean[h] * mean[h], 0.f) + LN_EPS); }
#pragma unroll
    for (int q = 0; q < NV; ++q) { const int s = q * 8 + rsub;
        const float mu = __shfl(mean[(q * 8) >> 6], s & 63), rs = __shfl(rstd[(q * 8) >> 6], s & 63);
        unsigned pk[4];
#pragma unroll
        for (int j = 0; j < 4; ++j) pk[j] = cvt_pk_bf16((bf_lo(raw[q][j]) - mu) * rs * lg[2 * j] + lb[2 * j], (bf_hi(raw[q][j]) - mu) * rs * lg[2 * j + 1] + lb[2 * j + 1]);
        LAS unsigned char* wp = wl + s * VB + ck * 16;
        *(LAS u32x2*)wp = (u32x2){pk[0], pk[1]}; *(LAS u32x2*)(wp + 8) = (u32x2){pk[2], pk[3]}; }
    LDS_WAIT(); asm volatile("" ::: "memory");
    f32x4 acc[4][4];
#pragma unroll
    for (int ct = 0; ct < 4; ++ct)
#pragma unroll
        for (int tt = 0; tt < 4; ++tt) acc[ct][tt] = (f32x4){0.f, 0.f, 0.f, 0.f};
    const bf16_t* wmg = Wm + (size_t)g * 128 * 128 + (size_t)(64 * TH) * 128;
    const LAS unsigned char* trp = wl + (8 * fq + (fr >> 2)) * VB + (fr & 3) * 8;
#pragma unroll 1
    for (int ks = 0; ks < NKS; ++ks) {
        bf16x8 af[4], bfr[4];
#pragma unroll
        for (int tt = 0; tt < 4; ++tt) bfr[tt] = LDG(bf16x8, wmg + (16 * tt) * 128 + ks * 32, lw);
#pragma unroll
        for (int ct = 0; ct < 4; ++ct) { const s16x4 a0 = lds_tr16(trp + (ks * 32) * VB + ct * 32), a1 = lds_tr16(trp + (ks * 32 + 4) * VB + ct * 32);
            af[ct] = (bf16x8){a0[0], a0[1], a0[2], a0[3], a1[0], a1[1], a1[2], a1[3]}; }
#pragma unroll
        for (int ct = 0; ct < 4; ++ct)
#pragma unroll
            for (int tt = 0; tt < 4; ++tt) acc[ct][tt] = __builtin_amdgcn_mfma_f32_16x16x32_bf16(af[ct], bfr[tt], acc[ct][tt], 0, 0, 0);
    }
    LDS_WAIT(); asm volatile("" ::: "memory");
#pragma unroll
    for (int tt = 0; tt < 4; ++tt)
#pragma unroll
        for (int ct = 0; ct < 4; ++ct) *(LAS f32x4*)(wl + (16 * tt + fr) * OB + (16 * ct + 4 * fq) * 4) = acc[ct][tt];
    LDS_WAIT(); asm volatile("" ::: "memory");
    bf16_t* po = P + (size_t)(T0 + 64 * TH) * PITCH + g * 64;
    const float* bsp = b_s + g * 128 + 64 * TH;
#pragma unroll
    for (int hf = 0; hf < 2; ++hf) {
        u32x4 uu[4], zz[4]; float bs[4];
#pragma unroll
        for (int q = 0; q < 4; ++q) { uu[q] = LDG(u32x4, po + (size_t)((hf * 4 + q) * 8) * PITCH + C_U, lv); zz[q] = LDG(u32x4, po + (size_t)((hf * 4 + q) * 8) * PITCH + C_ZA, lv);
            bs[q] = LDG(float, bsp + (hf * 4 + q) * 8, (unsigned)rsub * 4u); }
#pragma unroll
        for (int q = 0; q < 4; ++q) { const int t = (hf * 4 + q) * 8 + rsub;
            const f32x4 s0 = *(const LAS f32x4*)(wl + t * OB + ck * 32), s1 = *(const LAS f32x4*)(wl + t * OB + ck * 32 + 16);
            u32x4 w;
#pragma unroll
            for (int j = 0; j < 4; ++j) { const f32x2 s2 = (j < 2 ? (f32x2){s0[2 * j], s0[2 * j + 1]} : (f32x2){s1[2 * j - 4], s1[2 * j - 3]}) + bs[q];
                const f32x2 o = gelu2(bf2(uu[q][j])) * s2 * silu2(bf2(zz[q][j]));
                w[j] = cvt_pk_bf16(o.x, o.y); }
            STG(u32x4, po + (size_t)((hf * 4 + q) * 8) * PITCH + C_U, lv, w); }
    }
    LDS_WAIT(); asm volatile("" ::: "memory");
}
__device__ __forceinline__ void mixer_a_item(bf16_t* P, const float* lns, const bf16_t* Wm, const float* ln_g, const float* ln_b, const float* b_s, LAS unsigned char* wl, int item, int lane) {
    const int th = item & 1, g = (item >> 1) & 7, n = item >> 4;
    if (th) mixer_a_body<1>(P, lns, Wm, ln_g, ln_b, b_s, wl, n, g, lane); else mixer_a_body<0>(P, lns, Wm, ln_g, ln_b, b_s, wl, n, g, lane);
}

__device__ __forceinline__ void mixer_b_item(bf16_t* P, const float* conv_w, const float* conv_b, int item, int lane) {
    const int hb = item & 1, t0 = (item >> 1) * 16;
    const bool seq_start = (t0 % SEQ) == 0;
    bf16_t* pbase = P + (size_t)t0 * PITCH + hb * 256;
    const unsigned l8 = (unsigned)lane * 8u, l16 = (unsigned)lane * 16u;
    const f32x4 w0 = LDG(f32x4, conv_w + hb * 256, l16), w1 = LDG(f32x4, conv_w + 512 + hb * 256, l16), w2 = LDG(f32x4, conv_w + 1024 + hb * 256, l16), cb = LDG(f32x4, conv_b + hb * 256, l16);
    f32x4 pm2 = (f32x4){0.f, 0.f, 0.f, 0.f}, pm1 = pm2;
#pragma unroll
    for (int hf = 0; hf < 2; ++hf) {
        u32x2 xx[10], cc[10], bb[8], zz[8];
#pragma unroll
        for (int r = (hf ? 2 : 0); r < 10; ++r) { const int dt = hf * 8 + r - 2; const bool ok = (dt >= 0) || !seq_start;
            xx[r] = ok ? LDG(u32x2, pbase + (ptrdiff_t)dt * PITCH + C_XB, l8) : (u32x2){0u, 0u}; cc[r] = ok ? LDG(u32x2, pbase + (ptrdiff_t)dt * PITCH + C_CG, l8) : (u32x2){0u, 0u}; }
#pragma unroll
        for (int r = 0; r < 8; ++r) { bb[r] = LDG(u32x2, pbase + (size_t)(hf * 8 + r) * PITCH + C_BG, l8); zz[r] = LDG(u32x2, pbase + (size_t)(hf * 8 + r) * PITCH + C_ZB, l8); }
        if (hf == 0) {
            pm2 = (f32x4){bf_lo(xx[0].x) * bf_lo(cc[0].x), bf_hi(xx[0].x) * bf_hi(cc[0].x), bf_lo(xx[0].y) * bf_lo(cc[0].y), bf_hi(xx[0].y) * bf_hi(cc[0].y)};
            pm1 = (f32x4){bf_lo(xx[1].x) * bf_lo(cc[1].x), bf_hi(xx[1].x) * bf_hi(cc[1].x), bf_lo(xx[1].y) * bf_lo(cc[1].y), bf_hi(xx[1].y) * bf_hi(cc[1].y)}; }
#pragma unroll
        for (int r = 0; r < 8; ++r) {
            const f32x4 p0 = (f32x4){bf_lo(xx[r + 2].x) * bf_lo(cc[r + 2].x), bf_hi(xx[r + 2].x) * bf_hi(cc[r + 2].x), bf_lo(xx[r + 2].y) * bf_lo(cc[r + 2].y), bf_hi(xx[r + 2].y) * bf_hi(cc[r + 2].y)};
            const f32x4 y = cb + w0 * pm2 + w1 * pm1 + w2 * p0;
            const f32x4 bg = (f32x4){bf_lo(bb[r].x), bf_hi(bb[r].x), bf_lo(bb[r].y), bf_hi(bb[r].y)};
            const f32x2 zb0 = silu2(bf2(zz[r].x)), zb1 = silu2(bf2(zz[r].y)); const f32x4 zb = (f32x4){zb0.x, zb0.y, zb1.x, zb1.y};
            const f32x4 o = bg * y * zb;
            u32x2 w; w.x = cvt_pk_bf16(o[0], o[1]); w.y = cvt_pk_bf16(o[2], o[3]); STG(u32x2, pbase + (size_t)(hf * 8 + r) * PITCH + C_ZB, l8, w);
            pm2 = pm1; pm1 = p0; }
    }
}

template <int W> __device__ __forceinline__ void mixer_c_pool(const bf16_t* pxc  , LAS bf16_t* pl, int PL_LD, int tseq, int lane) {
    constexpr int NR = 31 + W;
    unsigned xv[NR];
#pragma unroll
    for (int r = 0; r < NR; ++r) { const int dt = r - (W - 1); xv[r] = (dt >= 0 || tseq > 0) ? LDG(unsigned, pxc + (ptrdiff_t)dt * PITCH, (unsigned)lane * 4u) : 0u; }
    float s0 = 0.f, s1 = 0.f;
#pragma unroll
    for (int r = 0; r < NR; ++r) {
        const int dt = r - (W - 1);
        s0 += bf_lo(xv[r]); s1 += bf_hi(xv[r]);
        if (r >= W) { s0 -= bf_lo(xv[r - W]); s1 -= bf_hi(xv[r - W]); }
        if (dt >= 0) { const int pos = tseq + dt; const float inv = 1.0f / (float)((pos + 1 < W) ? (pos + 1) : W);
            *(LAS unsigned*)(pl + dt * PL_LD + 2 * lane) = cvt_pk_bf16(s0 * inv - bf_lo(xv[r]), s1 * inv - bf_hi(xv[r])); }
    }
}
__device__ __forceinline__ void mixer_c_item(bf16_t* P, const bf16_t* WpT, LAS unsigned char* wl, int item, int lane) {
    const int gi = item & 3, t0 = (item >> 2) * 32;
    constexpr int PL_LD = 136;
    constexpr int OB = 528;
    LAS bf16_t* pl = (LAS bf16_t*)wl;
    const bf16_t* pxc = P + (size_t)t0 * PITCH + C_XC + gi * 128; const int tseq = t0 % SEQ;
    if (gi == 0) mixer_c_pool<2>(pxc, pl, PL_LD, tseq, lane);
    else if (gi == 1) mixer_c_pool<4>(pxc, pl, PL_LD, tseq, lane);
    else if (gi == 2) mixer_c_pool<8>(pxc, pl, PL_LD, tseq, lane);
    else mixer_c_pool<16>(pxc, pl, PL_LD, tseq, lane);
    LDS_WAIT(); asm volatile("" ::: "memory");
    const int fr = lane & 15, fq = lane >> 4;
    const unsigned lw = (unsigned)(fr * 128 + fq * 8) * 2u;
    bf16x8 bfr[2][4];
#pragma unroll
    for (int tt = 0; tt < 2; ++tt)
#pragma unroll
        for (int ks = 0; ks < 4; ++ks) bfr[tt][ks] = *(const LAS bf16x8*)(pl + (tt * 16 + fr) * PL_LD + ks * 32 + fq * 8);
    LDS_WAIT(); asm volatile("" ::: "memory");
    const bf16_t* wg = WpT + (size_t)gi * 128 * 128;
    bf16x8 afn[2][4];
#pragma unroll
    for (int d2 = 0; d2 < 2; ++d2)
#pragma unroll
        for (int ks = 0; ks < 4; ++ks) afn[d2][ks] = LDG(bf16x8, wg + (size_t)(d2 * 16) * 128 + ks * 32, lw);
#pragma unroll 1
    for (int dp = 0; dp < 4; ++dp) {
        bf16x8 af[2][4];
#pragma unroll
        for (int d2 = 0; d2 < 2; ++d2)
#pragma unroll
            for (int ks = 0; ks < 4; ++ks) af[d2][ks] = afn[d2][ks];
        if (dp < 3) {
#pragma unroll
            for (int d2 = 0; d2 < 2; ++d2)
#pragma unroll
                for (int ks = 0; ks < 4; ++ks) afn[d2][ks] = LDG(bf16x8, wg + (size_t)(((dp + 1) * 2 + d2) * 16) * 128 + ks * 32, lw); }
#pragma unroll
        for (int d2 = 0; d2 < 2; ++d2) {
            f32x4 a0 = (f32x4){0.f, 0.f, 0.f, 0.f}, a1 = a0;
#pragma unroll
            for (int ks = 0; ks < 4; ++ks) { a0 = __builtin_amdgcn_mfma_f32_16x16x32_bf16(af[d2][ks], bfr[0][ks], a0, 0, 0, 0); a1 = __builtin_amdgcn_mfma_f32_16x16x32_bf16(af[d2][ks], bfr[1][ks], a1, 0, 0, 0); }
            *(LAS f32x4*)(wl + fr * OB + ((dp * 2 + d2) * 16 + 4 * fq) * 4) = a0; *(LAS f32x4*)(wl + (16 + fr) * OB + ((dp * 2 + d2) * 16 + 4 * fq) * 4) = a1; }
    }
    LDS_WAIT(); asm volatile("" ::: "memory");
    bf16_t* pz = P + (size_t)t0 * PITCH + C_ZC + gi * 128;
    const int r4 = lane >> 4, c16 = lane & 15;
    const unsigned lz = (unsigned)(r4 * PITCH + c16 * 8) * 2u;
    u32x4 zv[8];
#pragma unroll
    for (int q = 0; q < 8; ++q) zv[q] = LDG(u32x4, pz + (size_t)(q * 4) * PITCH, lz);
#pragma unroll
    for (int q = 0; q < 8; ++q) { const int t = q * 4 + r4;
        const f32x4 s0 = *(const LAS f32x4*)(wl + t * OB + c16 * 32), s1 = *(const LAS f32x4*)(wl + t * OB + c16 * 32 + 16);
        u32x4 w;
#pragma unroll
        for (int j = 0; j < 4; ++j) { const float sa = (j < 2 ? s0[2 * j] : s1[2 * j - 4]), sb = (j < 2 ? s0[2 * j + 1] : s1[2 * j - 3]);
            { const f32x2 o = (f32x2){sa, sb} * silu2(bf2(zv[q][j])); w[j] = cvt_pk_bf16(o.x, o.y); } }
        STG(u32x4, pz + (size_t)(q * 4) * PITCH, lz, w); }
    LDS_WAIT(); asm volatile("" ::: "memory");
}

__global__ void __launch_bounds__(NWAVES * 64, 2) hybrid_fwd(Args args) {
    extern __shared__ __attribute__((aligned(16))) unsigned char lds_raw[];
    LAS unsigned char* lds = (LAS unsigned char*)lds_raw;
    volatile LAS unsigned* MISC = (volatile LAS unsigned*)(lds + MISC_OFF);
    const int tid = threadIdx.x, lane = tid & 63, wave = __builtin_amdgcn_readfirstlane(tid >> 6);
    const int G = gridDim.x; const int bx = blockIdx.x;
    const int vcu = (G % 8 == 0) ? (bx % 8) * (G / 8) + bx / 8 : bx;
    const int gw = vcu * NWAVES + wave, NGW = G * NWAVES;
    unsigned char* ws = args.ws;
    for (int u = tid; u < (LDS_BYTES - LDSCTL_OFF) / 4; u += NWAVES * 64) ((LAS unsigned*)(lds + LDSCTL_OFF))[u] = 0u;
    __syncthreads();
    const XcdBarrier bar = xcd_barrier_post((unsigned*)(ws + WS_CTL), MISC + 8, (unsigned)G);
    (void)xcd_barrier_post((unsigned*)(ws + WS_CTL) + (1 + (bx & 7)) * XCD_BAR_WORDS, MISC + 10, (unsigned)(G / 8));
    const int lo = args.ph_lo, hi = args.ph_hi;
#define IN(k) (lo <= (k) && (k) < hi)
#define SEAM(k) do { if (IN(k) && IN((k) + 1)) xcd_barrier(bar); } while (0)
#define CW_PROG 47104
#define GSEAM_W(k, nbr, tgt) GSEAM_X(k, nbr, tgt, false)
#define GSEAM_X(k, nbr, tgt, loc) do { if (IN(k) && IN((k) + 1)) { XcdBarrier gb; gb.bar = (unsigned*)(args.ws + WS_CTL) + (1 + ((int)blockIdx.x & 7)) * XCD_BAR_WORDS; gb.x = bar.x; gb.st = MISC + 10; gb.G = gridDim.x / 8; \
        unsigned* pw_ = (unsigned*)(args.ws + WS_CTL) + CW_PROG; const int nb_ = (nbr); \
        xcd_barrier(gb, nb_ >= 0 ? pw_ + 64 * nb_ : nullptr, (unsigned)(tgt), ((int)blockIdx.x >> 3) == 0 ? pw_ + 64 * ((int)blockIdx.x & 7) : nullptr, (loc)); } } while (0)
#define GSEAM(k) GSEAM_X(k, -1, 0, true)

    bf16_t* P = (bf16_t*)(ws + WS_P);
    float* rss = (float*)(ws + WS_RSS);
    float* lns = (float*)(ws + WS_LNS);

    if (IN(0)) { p0_prologue(args, lds, gw, NGW, wave, lane); }
    SEAM(0);

    for (int l = 0; l < DEPTH; ++l) {
        const int pb = 1 + 4 * l;
        const bf16_t* Wmix = (const bf16_t*)(ws + WS_WMIX) + (size_t)l * NMIX * D;
        const bf16_t* W3 = (const bf16_t*)(ws + WS_W3) + (size_t)l * D * K3;
        const bf16_t* WoT = (const bf16_t*)(ws + WS_WO) + (size_t)l * D * D;
        const float* rss_l = rss + (size_t)l * M * 16;
        if (IN(pb)) {
            const int jg = bx >> 3; const bool five = (G == 256) && (bx < 128);
            for (int pass = 0; pass < 2; ++pass) {
                if ((pass == 0) != five) {
                    SchedG S; S.x = bx & 7; S.r = jg & 15; S.n = five ? 1 : 2; S.c0 = five ? 4 : 0; S.sq = five ? 0 : 2;     S.A8 = (const char*)(ws + WS_XB8); S.W8 = (const char*)(ws + WS_WG8 + (size_t)l * 3 * D * D);
                    EpiP3G E{(unsigned char*)args.out, GATE_PLANE_BYTES, (unsigned)D, rss_l};
                    pg8::gemm_phase<EpiP3G, SchedG, true, true>(lds, D, D, S, E);
                } else {
                    SchedP1 S; S.T.init(M, NMIX, G, bx, P1_WGM); S.P = (const char*)P; S.W = (const char*)Wmix;
                    EpiP1 E{P, rss_l, lns};
                    pg8::gemm_phase<EpiP1, SchedP1, true>(lds, PITCH * 2, D * 2, S, E);
                }
            }
        }
        GSEAM_W(pb, (bx & 3) != 0 ? (bx & 7) - 1 : -1, 1 + 4 * l);
        if (IN(pb + 1)) {
            const bf16_t* Wm = (const bf16_t*)(ws + WS_WM) + (size_t)l * 8 * 128 * 128;
            const bf16_t* WpT = (const bf16_t*)(ws + WS_WPOOL) + (size_t)l * 4 * 128 * 128;
            LAS unsigned char* wl = lds + wave * WAVE_LDS;
            int ln = lane; asm volatile("" : "+v"(ln));
            { const int x = bx & 7, e = bx >> 3;
              SchedG S; S.x = x; S.r = e & 15; S.A8 = (const char*)(ws + WS_XB8); S.W8 = (const char*)(ws + WS_WG8 + (size_t)l * 3 * D * D);
              EpiP3G E{(unsigned char*)args.out, GATE_PLANE_BYTES, (unsigned)D, rss_l};
              if (G != 256) { for (int li = e * NWAVES + wave; li < 768; li += (G / 8) * NWAVES) { const int j = 256 * x + (li & 255);
                  if (li < 256) mixer_a_item(P, lns, Wm, args.in[3] + l * 512, args.in[4] + l * 512, args.in[6] + l * 1024, wl, j, ln);
                  else if (li < 512) mixer_b_item(P, args.in[7] + l * 1536, args.in[8] + l * 512, j, ln);
                  else mixer_c_item(P, WpT, wl, j, ln); } }
              else if (e < 16) {
                for (int li = e * 8 + wave; li < 512; li += 128) { const int j = 256 * x + (li & 255);
                  if (li < 256) mixer_a_item(P, lns, Wm, args.in[3] + l * 512, args.in[4] + l * 512, args.in[6] + l * 1024, wl, j, ln);
                  else mixer_b_item(P, args.in[7] + l * 1536, args.in[8] + l * 512, j, ln); }
                __syncthreads();
                S.n = 1; S.c0 = 10; S.sq = 0;
                pg8::gemm_phase<EpiP3G, SchedG, true, true>(lds, D, D, S, E); }
              else {
                S.n = 2; S.c0 = 6; S.sq = 2;
                pg8::gemm_phase<EpiP3G, SchedG, true, true>(lds, D, D, S, E);
                for (int li = 512 + (e - 16) * 8 + wave; li < 768; li += 128) mixer_c_item(P, WpT, wl, 256 * x + (li & 255), ln); } }
        }
        GSEAM(pb + 1);
        if (IN(pb + 2)) {
            pg8::TileOrder T; T.init(M, D, G, bx); int pm3, pn3;
            if (T.tile(0, pm3, pn3)) {
                SchedP3Y S; S.pm = pm3; S.pn = pn3; S.P = (const char*)P; S.W = (const char*)W3; EpiP3Y E{P, (const unsigned char*)args.out, GATE_PLANE_BYTES, (unsigned)D};
                pg8::gemm_phase<EpiP3Y, SchedP3Y, true>(lds, PITCH * 2, K3 * 2, S, E);
            }
        }
        GSEAM(pb + 2);
        if (IN(pb + 3)) {
            SchedP4 S; S.T.init(M, D, G, bx); S.P = (const char*)P; S.W = (const char*)WoT;
            if (l == 0) { EpiP4 E{P, rss + (size_t)(l + 1) * M * 16, ws + WS_XB8};
                pg8::gemm_phase<EpiP4, SchedP4, true>(lds, PITCH * 2, D * 2, S, E); }
            else { EpiP4F E{P, args.out, rss + (size_t)2 * M * 16, args.in[15], (unsigned*)(ws + WS_CTL) + CW_PANEL, (unsigned*)(ws + WS_CTL) + XB_TMO};
                pg8::gemm_phase<EpiP4F, SchedP4, true>(lds, PITCH * 2, D * 2, S, E); }
        }
        if (l + 1 < DEPTH) GSEAM_X(pb + 3, (bx & 3) != 3 ? (bx & 7) + 1 : -1, 2 + 4 * l, true);
    }
#undef IN
#undef SEAM
#undef GSEAM
}

extern "C" void kernel_launch(void* const* d_in, const int* in_sizes, int n_in, void* d_out, int out_size, void* d_ws, size_t ws_size, hipStream_t stream) {
    static int grid = 0;
    if (grid == 0) {
        if (n_in != 16 || in_sizes[0] != M * D || out_size != M * D || ws_size < WS_END) { fprintf(stderr, "kernel_launch: unexpected shapes (n_in %d, in0 %d, out %d, ws %zu); nothing launched\n", n_in, n_in > 0 ? in_sizes[0] : -1, out_size, ws_size); grid = -1; return; }
        int dev = 0, cus = 0, per_cu = 0;
        if (hipGetDevice(&dev) != hipSuccess || hipDeviceGetAttribute(&cus, hipDeviceAttributeMultiprocessorCount, dev) != hipSuccess) { grid = -1; return; }
        if (hipFuncSetAttribute((const void*)hybrid_fwd, hipFuncAttributeMaxDynamicSharedMemorySize, LDS_BYTES) != hipSuccess) { fprintf(stderr, "kernel_launch: hipFuncSetAttribute failed\n"); grid = -1; return; }
        if (hipOccupancyMaxActiveBlocksPerMultiprocessor(&per_cu, (const void*)hybrid_fwd, NWAVES * 64, LDS_BYTES) != hipSuccess || per_cu < 1) { fprintf(stderr, "kernel_launch: occupancy query reports %d blocks per CU\n", per_cu); (void)hipGetLastError(); grid = -1; return; }
        if (cus != 256) { fprintf(stderr, "kernel_launch: built for a 256-CU device (the unit assignment is written for 256 workgroups); this one has %d CUs; nothing launched\n", cus); grid = -1; return; }
        grid = cus;
    }
    if (grid < 0) return;
    if (hipMemsetAsync((char*)d_ws + WS_CTL, 0, CTL_ZERO_BYTES, stream) != hipSuccess) return;
    Args a{};
    for (int i = 0; i < 16; ++i) a.in[i] = (const float*)d_in[i];
    a.out = (float*)d_out; a.ws = (unsigned char*)d_ws;
    a.ph_lo = 0; a.ph_hi = 9;
    hipLaunchKernelGGL(hybrid_fwd, dim3(grid), dim3(NWAVES * 64), LDS_BYTES, stream, a);
}
```
